# Optimizing an MI355X kernel written in HIP

```python
import math
import jax
import jax.numpy as jnp
from jax import lax
import numpy as np

D_MODEL = 1024
BATCH = 4
SEQ = 4096
DEPTH = 4

BRANCH_W = D_MODEL // 2
N_BRANCH = 4
S5_GROUP = 16
S5_GROUPS = BRANCH_W // S5_GROUP
S5_STATE = 64
DIFF_QK_DIM = 64
DIFF_V_DIM = 2 * DIFF_QK_DIM
DIFF_HEADS = BRANCH_W // DIFF_V_DIM
DIFF_ROT = DIFF_QK_DIM // 4
MLA_NOPE = 128
MLA_ROPE = 64
MLA_V_DIM = 128
MLA_HEADS = BRANCH_W // MLA_V_DIM
MLA_Q_RANK = D_MODEL // 4
MLA_KV_RANK = D_MODEL // 8
RWKV_N = 64
RWKV_HEADS = BRANCH_W // RWKV_N
RWKV_DECAY_RANK = 64
RWKV_ICLR_RANK = 64
RWKV_SHIFT_W = 3 * BRANCH_W + 2 * RWKV_DECAY_RANK + 2 * RWKV_ICLR_RANK
RWKV_LN_EPS = 64e-5
ROPE_THETA = 500000.0
MLA_ROPE_THETA = 10000.0
Q_BLOCK = 128
NORM_EPS = 1e-6
PROJ_SIZES = (
    BRANCH_W, BRANCH_W,
    2 * DIFF_HEADS * DIFF_QK_DIM, 2 * DIFF_HEADS * DIFF_QK_DIM,
    DIFF_HEADS * DIFF_V_DIM, BRANCH_W,
    MLA_Q_RANK, MLA_KV_RANK, MLA_ROPE, BRANCH_W,
    RWKV_SHIFT_W, BRANCH_W,
    N_BRANCH * D_MODEL,
)
N_IN = sum(PROJ_SIZES)

kernel_name = 'hybrid_bidir_s5_diffattn_mla_rwkv7'


def split_cols(p, sizes):
    idx, acc = [], 0
    for s in sizes[:-1]:
        acc += s
        idx.append(acc)
    return jnp.split(p, idx, axis=-1)


def rms_norm(x, g, eps=NORM_EPS):
    xf = x.astype(jnp.float32)
    y = xf * lax.rsqrt(jnp.mean(xf * xf, axis=-1, keepdims=True) + eps)
    return y.astype(x.dtype) * g


def rope_tables(seq_len, dim, theta):
    inv = theta ** (-jnp.arange(0, dim, 2, dtype=jnp.float32) / dim)
    ang = jnp.arange(seq_len, dtype=jnp.float32)[:, None] * inv[None, :]
    return jnp.cos(ang), jnp.sin(ang)


def apply_rope(x, cos, sin):
    half = x.shape[-1] // 2
    shape = (cos.shape[0],) + (1,) * (x.ndim - 3) + (half,)
    c, s = cos.reshape(shape), sin.reshape(shape)
    xf = x.astype(jnp.float32)
    x1, x2 = xf[..., :half], xf[..., half:]
    return jnp.concatenate([x1 * c - x2 * s, x1 * s + x2 * c], axis=-1).astype(x.dtype)


def blocked_attention(q, k, v, scale):
    b, s, h, dk = q.shape
    nb = s // Q_BLOCK
    qb = q.reshape(b, nb, Q_BLOCK, h, dk).transpose(1, 0, 2, 3, 4)

    def attend(q_blk):
        logits = jnp.einsum('bqhd,bkhd->bhqk', q_blk, k, preferred_element_type=jnp.float32) * scale
        probs = jax.nn.softmax(logits, axis=-1)
        return jnp.einsum('bhqk,bkhd->bqhd', probs.astype(v.dtype), v)

    out = lax.map(attend, qb)
    return out.transpose(1, 0, 2, 3, 4).reshape(b, s, h, v.shape[-1])


def _complex_affine_combine(first, second):
    a1r, a1i, b1r, b1i = first
    a2r, a2i, b2r, b2i = second
    return (a2r * a1r - a2i * a1i, a2r * a1i + a2i * a1r,
            a2r * b1r - a2i * b1i + b2r, a2r * b1i + a2i * b1r + b2i)


def s5_branch(u, lam_re, lam_im, log_dt, b_re, b_im, c_re, c_im, d_skip, glu_w, glu_b):
    f32 = jnp.float32
    bsz, slen, width = u.shape
    uf = u.astype(f32)
    ug = uf.reshape(bsz, slen, S5_GROUPS, S5_GROUP)
    y = uf * d_skip.astype(f32)
    for d in range(2):
        lr = jnp.minimum(lam_re[d].astype(f32), -1e-4)
        li = lam_im[d].astype(f32)
        dt = jnp.exp(log_dt[d].astype(f32))[:, None]
        mag = jnp.exp(lr * dt)
        ab_re, ab_im = mag * jnp.cos(li * dt), mag * jnp.sin(li * dt)
        den = lr * lr + li * li
        co_re = ((ab_re - 1.0) * lr + ab_im * li) / den
        co_im = (ab_im * lr - (ab_re - 1.0) * li) / den
        br, bi = b_re[d].astype(f32), b_im[d].astype(f32)
        bb_re = co_re[..., None] * br - co_im[..., None] * bi
        bb_im = co_re[..., None] * bi + co_im[..., None] * br
        bu_re = jnp.einsum('gpc,bsgc->bsgp', bb_re, ug)
        bu_im = jnp.einsum('gpc,bsgc->bsgp', bb_im, ug)
        a_re = jnp.broadcast_to(ab_re, (1, slen) + ab_re.shape)
        a_im = jnp.broadcast_to(ab_im, (1, slen) + ab_im.shape)
        _, _, x_re, x_im = lax.associative_scan(
            _complex_affine_combine, (a_re, a_im, bu_re, bu_im), reverse=(d == 1), axis=1)
        y_d = (jnp.einsum('gcp,bsgp->bsgc', c_re[d].astype(f32), x_re)
               - jnp.einsum('gcp,bsgp->bsgc', c_im[d].astype(f32), x_im))
        y = y + y_d.reshape(bsz, slen, width)
    g = jax.nn.gelu(y)
    return g * jax.nn.sigmoid(g @ glu_w.astype(f32) + glu_b.astype(f32))


def diff_attention_branch(q, k, v, q_norm, k_norm, lam, subln, cos, sin, lam_init):
    bsz, slen, _ = q.shape
    q = rms_norm(q.reshape(bsz, slen, DIFF_HEADS, 2, DIFF_QK_DIM), q_norm)
    k = rms_norm(k.reshape(bsz, slen, DIFF_HEADS, 2, DIFF_QK_DIM), k_norm)
    q = jnp.concatenate([apply_rope(q[..., :DIFF_ROT], cos, sin), q[..., DIFF_ROT:]], axis=-1)
    k = jnp.concatenate([apply_rope(k[..., :DIFF_ROT], cos, sin), k[..., DIFF_ROT:]], axis=-1)
    v = v.reshape(bsz, slen, DIFF_HEADS, DIFF_V_DIM)
    scale = DIFF_QK_DIM ** -0.5
    o1 = blocked_attention(q[:, :, :, 0], k[:, :, :, 0], v, scale).astype(jnp.float32)
    o2 = blocked_attention(q[:, :, :, 1], k[:, :, :, 1], v, scale).astype(jnp.float32)
    lf = lam.astype(jnp.float32)
    lam_full = jnp.exp(jnp.sum(lf[0] * lf[1])) - jnp.exp(jnp.sum(lf[2] * lf[3])) + lam_init
    o = rms_norm(o1 - lam_full * o2, subln) * (1.0 - lam_init)
    return o.reshape(bsz, slen, BRANCH_W)


def mla_branch(c_q, c_kv, k_rope, q_lat_norm, kv_lat_norm, w_uq, w_ukv, q_norm, k_norm, cos, sin):
    bsz, slen, _ = c_q.shape
    q = (rms_norm(c_q, q_lat_norm) @ w_uq).reshape(bsz, slen, MLA_HEADS, MLA_NOPE + MLA_ROPE)
    kv = (rms_norm(c_kv, kv_lat_norm) @ w_ukv).reshape(bsz, slen, MLA_HEADS, MLA_NOPE + MLA_V_DIM)
    k_nope, v = kv[..., :MLA_NOPE], kv[..., MLA_NOPE:]
    k_r = jnp.broadcast_to(k_rope[:, :, None, :], (bsz, slen, MLA_HEADS, MLA_ROPE)).astype(k_nope.dtype)
    k = jnp.concatenate([k_nope, k_r], axis=-1)
    q = rms_norm(q, q_norm)
    k = rms_norm(k, k_norm)
    q = jnp.concatenate([q[..., :MLA_NOPE], apply_rope(q[..., MLA_NOPE:], cos, sin)], axis=-1)
    k = jnp.concatenate([k[..., :MLA_NOPE], apply_rope(k[..., MLA_NOPE:], cos, sin)], axis=-1)
    o = blocked_attention(q, k, v, (MLA_NOPE + MLA_ROPE) ** -0.5)
    return o.reshape(bsz, slen, BRANCH_W)


def centred_shift(x, mu):
    prev = jnp.pad(x[:, :-1], ((0, 0), (1, 0), (0, 0)))
    nxt = jnp.pad(x[:, 1:], ((0, 0), (0, 1), (0, 0)))
    return x + mu[0] * (prev - x) + mu[1] * (nxt - x)


def _to_scan(t):
    both = jnp.stack([t[:, :, 0], jnp.flip(t[:, :, 1], axis=1)], axis=0)
    return both.transpose(2, 0, 1, 3, 4)


def rwkv7_step(state, inp):
    r, w, k, v, z, b = inp
    sa = jnp.einsum('dbhvk,dbhk->dbhv', state, z)
    state = state * w[..., None, :] + sa[..., None] * b[..., None, :] + v[..., None] * k[..., None, :]
    y = jnp.einsum('dbhvk,dbhk->dbhv', state, r)
    return state, y


def rwkv7_branch(cols, mu, w0, w_up, a0, a_up, k_k, k_a, r_k, ln_g, ln_b):
    f32 = jnp.float32
    bsz, slen, _ = cols.shape
    H, N = RWKV_HEADS, RWKV_N
    xs = centred_shift(cols, mu).astype(f32)
    r, k, v, wd, ad = split_cols(xs, (BRANCH_W, BRANCH_W, BRANCH_W, 2 * RWKV_DECAY_RANK, 2 * RWKV_ICLR_RANK))
    wd = wd.reshape(bsz, slen, 2, RWKV_DECAY_RANK)
    ad = ad.reshape(bsz, slen, 2, RWKV_ICLR_RANK)
    w_log = -jax.nn.softplus(-(w0 + jnp.einsum('bsdr,drc->bsdc', jnp.tanh(wd), w_up))) - 0.5
    decay = jnp.exp(-jnp.exp(w_log))
    a = jax.nn.sigmoid(a0 + jnp.einsum('bsdr,drc->bsdc', ad, a_up))
    kk = (k * k_k).reshape(bsz, slen, H, N)
    kk = kk / jnp.maximum(jnp.sqrt(jnp.sum(kk * kk, axis=-1, keepdims=True)), 1e-12)
    k_t = k[:, :, None, :] * (1.0 + (a - 1.0) * k_a)
    heads = lambda t: t.reshape(bsz, slen, 2, H, N)
    dirs = lambda t: jnp.broadcast_to(t[:, :, None], (bsz, slen, 2, H, N))
    r_h = r.reshape(bsz, slen, H, N)
    v_h = v.reshape(bsz, slen, H, N)
    a_h, k_th = heads(a), heads(k_t)
    inputs = (_to_scan(dirs(r_h)), _to_scan(heads(decay)), _to_scan(k_th),
              _to_scan(dirs(v_h)), _to_scan(dirs(-kk)), _to_scan(kk[:, :, None] * a_h))
    state0 = jnp.zeros((2, bsz, H, N, N), f32)
    _, ys = lax.scan(rwkv7_step, state0, inputs)
    ys = ys.transpose(1, 2, 0, 3, 4)
    y = ys[0] + jnp.flip(ys[1], axis=1)
    mean = jnp.mean(y, axis=-1, keepdims=True)
    var = jnp.mean((y - mean) ** 2, axis=-1, keepdims=True)
    yn = ((y - mean) * lax.rsqrt(var + RWKV_LN_EPS)).reshape(bsz, slen, BRANCH_W) * ln_g + ln_b
    bonus = jnp.sum(r_h[:, :, None] * k_th * r_k, axis=-1, keepdims=True)
    bonus = jnp.sum(bonus * v_h[:, :, None], axis=2)
    return yn + bonus.reshape(bsz, slen, BRANCH_W)


def setup_inputs(seed: int = 0) -> dict:
    key = jax.random.key(seed)
    keys = iter(jax.random.split(key, 48))
    f32 = jnp.float32

    def normal(shape, std):
        return std * jax.random.normal(next(keys), shape, f32)

    def gain(shape):
        return 1.0 + 0.02 * jax.random.normal(next(keys), shape, f32)

    def uniform(shape, lo, hi):
        return jax.random.uniform(next(keys), shape, f32, minval=lo, maxval=hi)

    L, G, P, C, W = DEPTH, S5_GROUPS, S5_STATE, S5_GROUP, BRANCH_W
    return {
        'x': normal((BATCH, SEQ, D_MODEL), 1.0),
        'norm_g': gain((L, D_MODEL)),
        'w_in': normal((L, D_MODEL, N_IN), D_MODEL ** -0.5),
        'gate_b': normal((L, N_BRANCH, D_MODEL), 0.01),
        's5_lambda_re': -0.5 + normal((L, 2, G, P), 0.01),
        's5_lambda_im': math.pi * jnp.arange(P, dtype=f32) + normal((L, 2, G, P), 0.01),
        's5_log_dt': uniform((L, 2, G), math.log(1e-3), math.log(1e-1)),
        's5_b_re': normal((L, 2, G, P, C), (2 * C) ** -0.5),
        's5_b_im': normal((L, 2, G, P, C), (2 * C) ** -0.5),
        's5_c_re': normal((L, 2, G, C, P), P ** -0.5),
        's5_c_im': normal((L, 2, G, C, P), P ** -0.5),
        's5_d': 1.0 + normal((L, W), 0.1),
        's5_glu_w': normal((L, W, W), W ** -0.5),
        's5_glu_b': normal((L, W), 0.01),
        'diff_q_norm': gain((L, DIFF_QK_DIM)),
        'diff_k_norm': gain((L, DIFF_QK_DIM)),
        'diff_lambda': normal((L, 4, DIFF_QK_DIM), 0.1),
        'diff_subln': gain((L, DIFF_V_DIM)),
        'mla_q_lat_norm': gain((L, MLA_Q_RANK)),
        'mla_kv_lat_norm': gain((L, MLA_KV_RANK)),
        'mla_w_uq': normal((L, MLA_Q_RANK, MLA_HEADS * (MLA_NOPE + MLA_ROPE)), MLA_Q_RANK ** -0.5),
        'mla_w_ukv': normal((L, MLA_KV_RANK, MLA_HEADS * (MLA_NOPE + MLA_V_DIM)), MLA_KV_RANK ** -0.5),
        'mla_q_norm': gain((L, MLA_NOPE + MLA_ROPE)),
        'mla_k_norm': gain((L, MLA_NOPE + MLA_ROPE)),
        'rwkv_mu': uniform((L, 2, RWKV_SHIFT_W), 0.0, 0.5),
        'rwkv_w0': uniform((L, 2, W), -6.0, -1.0),
        'rwkv_w_up': normal((L, 2, RWKV_DECAY_RANK, W), 0.1),
        'rwkv_a0': normal((L, 2, W), 0.1),
        'rwkv_a_up': normal((L, 2, RWKV_ICLR_RANK, W), 0.1),
        'rwkv_k_k': 0.85 + normal((L, W), 0.02),
        'rwkv_k_a': gain((L, W)),
        'rwkv_r_k': normal((L, RWKV_HEADS, RWKV_N), 0.1),
        'rwkv_ln_g': gain((L, W)),
        'rwkv_ln_b': normal((L, W), 0.01),
        'w_branch': normal((L, N_BRANCH, W, D_MODEL), W ** -0.5),
        'w_out': normal((L, D_MODEL, D_MODEL), D_MODEL ** -0.5),
    }


def reference(x, norm_g, w_in, gate_b, s5_lambda_re, s5_lambda_im, s5_log_dt, s5_b_re, s5_b_im,
              s5_c_re, s5_c_im, s5_d, s5_glu_w, s5_glu_b, diff_q_norm, diff_k_norm, diff_lambda,
              diff_subln, mla_q_lat_norm, mla_kv_lat_norm, mla_w_uq, mla_w_ukv, mla_q_norm, mla_k_norm,
              rwkv_mu, rwkv_w0, rwkv_w_up, rwkv_a0, rwkv_a_up, rwkv_k_k, rwkv_k_a, rwkv_r_k,
              rwkv_ln_g, rwkv_ln_b, w_branch, w_out):
    bsz, slen, _ = x.shape
    dt = x.dtype
    cos_d, sin_d = rope_tables(slen, DIFF_ROT, ROPE_THETA)
    cos_m, sin_m = rope_tables(slen, MLA_ROPE, MLA_ROPE_THETA)
    for l in range(DEPTH):
        lam_init = 0.8 - 0.6 * math.exp(-0.3 * l)
        h = rms_norm(x, norm_g[l])
        p = h @ w_in[l]
        (s5_u, s5_z, d_q, d_k, d_v, d_z, m_cq, m_ckv, m_kr, m_z,
         r_cols, r_z, merge) = split_cols(p, PROJ_SIZES)
        o_a = s5_branch(s5_u, s5_lambda_re[l], s5_lambda_im[l], s5_log_dt[l], s5_b_re[l], s5_b_im[l],
                        s5_c_re[l], s5_c_im[l], s5_d[l], s5_glu_w[l], s5_glu_b[l])
        o_b = diff_attention_branch(d_q, d_k, d_v, diff_q_norm[l], diff_k_norm[l], diff_lambda[l],
                                    diff_subln[l], cos_d, sin_d, lam_init)
        o_c = mla_branch(m_cq, m_ckv, m_kr, mla_q_lat_norm[l], mla_kv_lat_norm[l], mla_w_uq[l],
                         mla_w_ukv[l], mla_q_norm[l], mla_k_norm[l], cos_m, sin_m)
        o_d = rwkv7_branch(r_cols, rwkv_mu[l], rwkv_w0[l], rwkv_w_up[l], rwkv_a0[l], rwkv_a_up[l],
                           rwkv_k_k[l], rwkv_k_a[l], rwkv_r_k[l], rwkv_ln_g[l], rwkv_ln_b[l])
        branches = jnp.stack([jax.nn.silu(s5_z) * o_a.astype(dt), jax.nn.silu(d_z) * o_b.astype(dt),
                              jax.nn.silu(m_z) * o_c.astype(dt), jax.nn.silu(r_z) * o_d.astype(dt)],
                             axis=2)
        proj = jnp.einsum('bsnc,ncd->bsnd', branches, w_branch[l])
        gates = jax.nn.sigmoid(merge.reshape(bsz, slen, N_BRANCH, D_MODEL) + gate_b[l])
        x = x + (jnp.sum(gates * proj, axis=2) @ w_out[l]).astype(dt)
    return x
```

```cpp
#define REPMASK 0

#include <hip/hip_runtime.h>
#include <hip/hip_bf16.h>
#include <hip/hip_cooperative_groups.h>
#include <cstdio>
#include <cstdint>
namespace cg = cooperative_groups;

typedef unsigned short u16;
using bf16x8 = __attribute__((ext_vector_type(8))) short;
using s16x4  = __attribute__((ext_vector_type(4))) short;
using f32x4  = __attribute__((ext_vector_type(4))) float;
using f32x16 = __attribute__((ext_vector_type(16))) float;
using u32x4  = __attribute__((ext_vector_type(4))) unsigned;
using f2     = __attribute__((ext_vector_type(2))) float;

constexpr int T = 16384, S = 4096, NB = 4, DM = 1024, NL = 4;
constexpr int NP = 6336;
constexpr int NIN = 10432;
constexpr int C_S5U = 0, C_S5Z = 512, C_DQ = 1024, C_DK = 1536, C_DV = 2048, C_DZ = 2560, C_MCQ = 3072, C_MCKV = 3328,
              C_MKR = 3456, C_MZ = 3520, C_RC = 4032, C_RZ = 5824;
constexpr size_t SZT512 = (size_t)T * 512 * 2;
constexpr size_t O_WIN = 0;
constexpr size_t O_WBR = O_WIN + (size_t)NIN * 1024 * 2;
constexpr size_t O_WOUT = O_WBR + 4194304;
constexpr size_t O_GLU = O_WOUT + 2097152;
constexpr size_t O_UQ = O_GLU + 524288;
constexpr size_t O_UKV = O_UQ + 393216;
constexpr size_t O_WUP = O_UKV + 262144;
constexpr size_t O_AUP = O_WUP + 131072;
constexpr size_t O_CTR = O_AUP + 131072;
constexpr size_t O_H = O_CTR + 4096;
constexpr size_t O_P = O_H + (size_t)T * 1024 * 2;
constexpr size_t O_RW = O_P + (size_t)T * NP * 2;
constexpr size_t RW_R = O_RW, RW_K = O_RW + SZT512, RW_V = O_RW + 2 * SZT512, RW_KK = O_RW + 3 * SZT512,
                 RW_A = O_RW + 4 * SZT512, RW_E = O_RW + 6 * SZT512, RW_BON = O_RW + 8 * SZT512;
constexpr size_t O_M = O_RW;
constexpr size_t O_QK = RW_BON + (size_t)T * 8 * 4;
constexpr size_t QK_DQ = O_QK, QK_DK = O_QK + SZT512, QK_MQ = O_QK + 2 * SZT512, QK_MK = QK_MQ + (size_t)T * 768 * 2,
                 QK_MV = QK_MK + (size_t)T * 768 * 2;
constexpr size_t O_BR = O_QK, O_GS5 = O_QK + 4 * SZT512;
constexpr size_t O_O = QK_MV + SZT512;
constexpr size_t OO_DO = O_O, OO_MO = O_O + 4 * SZT512, OO_YS = OO_MO + SZT512, OO_YR = OO_YS + 2 * SZT512;
constexpr size_t O_END = OO_YR + 2 * SZT512;
constexpr size_t OA_LINW = O_O, OA_LINA = O_O + 4194304, OA_CQN = O_O + 8388608, OA_CKVN = O_O + 16777216,
                 OA_QRAW = O_O + 20971520, OA_KVRAW = OA_QRAW + 25165824, OA_WL = OA_KVRAW + 33554432, OA_AL = OA_WL + 33554432;
static_assert(OA_AL + 33554432 <= O_END, "alias overflow");
static_assert(O_END <= 683000000ull, "ws overflow");
constexpr size_t O_FLAG = O_CTR + 64;
constexpr size_t O_BAR = O_END;
constexpr size_t BAR_BYTES = 3456 * 4;
static_assert(O_BAR + BAR_BYTES <= 683000000ull, "ws overflow");

struct P {
  const float* in[36];
  float* out;
  char* ws;
};
enum { I_X = 0, I_NORMG, I_WIN, I_GATEB, I_LRE, I_LIM, I_LDT, I_BRE, I_BIM, I_CRE, I_CIM, I_S5D, I_GLUW, I_GLUB, I_DQN, I_DKN,
       I_DLAM, I_SUBLN, I_QLN, I_KVLN, I_WUQ, I_WUKV, I_MQN, I_MKN, I_MU, I_W0, I_WUP, I_A0, I_AUP, I_KK, I_KA, I_RK, I_LNG,
       I_LNB, I_WBR, I_WOUT };

extern __shared__ __attribute__((aligned(16))) char smem[];

__device__ __forceinline__ float bf2f(u16 v) { return __uint_as_float(((unsigned)v) << 16); }
__device__ __forceinline__ u16 f2bf(float f) { unsigned u = __float_as_uint(f); u += 0x7fffu + ((u >> 16) & 1u); return (u16)(u >> 16); }
__device__ __forceinline__ unsigned cvtpk_asm(float lo, float hi) {
  unsigned r; asm volatile("v_cvt_pk_bf16_f32 %0, %1, %2" : "=v"(r) : "v"(lo), "v"(hi)); return r;
}
typedef __bf16 bf16v2_t __attribute__((ext_vector_type(2)));
__device__ __forceinline__ unsigned cvtpk(float lo, float hi) {
  f2 v = {lo, hi};
  bf16v2_t r = __builtin_convertvector(v, bf16v2_t);
  return __builtin_bit_cast(unsigned, r);
}
__device__ __forceinline__ float dpp_add_(float x, const int ctrl_unused) { return x; }
#define WS_DPP(x, ctrl) ((x) + __int_as_float(__builtin_amdgcn_update_dpp(0, __float_as_int(x), (ctrl), 0xf, 0xf, true)))
__device__ __forceinline__ float wsum(float v) {
  v = WS_DPP(v, 0xB1);
  v = WS_DPP(v, 0x4E);
  v = WS_DPP(v, 0x141);
  v = WS_DPP(v, 0x140);
  v += __shfl_xor(v, 16);
  v += __shfl_xor(v, 32);
  return v;
}
__device__ __forceinline__ float sigmoidf_(float x) { return 1.f / (1.f + __expf(-x)); }
__device__ __forceinline__ float siluf_(float x) { return x / (1.f + __expf(-x)); }
__device__ __forceinline__ void sincos_rev(float ang, float& sn, float& cs) {
  float rev = ang * 0.15915494309189535f; rev -= rintf(rev);
  sn = __builtin_amdgcn_sinf(rev); cs = __builtin_amdgcn_cosf(rev);
}

__device__ __forceinline__ int opaque_tid() { int t = threadIdx.x; asm volatile("" : "+v"(t)); return t; }
__device__ __forceinline__ int opaque_bid() { int t = blockIdx.x; asm volatile("" : "+s"(t)); return t; }

struct F8 { float v[8]; };
__device__ __forceinline__ F8 ld8bf(const u16* p) {
  const u32x4 w = *reinterpret_cast<const u32x4*>(p); F8 r;
#pragma unroll
  for (int i = 0; i < 4; ++i) { r.v[2 * i] = __uint_as_float(w[i] << 16); r.v[2 * i + 1] = __uint_as_float(w[i] & 0xffff0000u); }
  return r;
}
__device__ __forceinline__ void st8bf(u16* p, const F8& f) {
  u32x4 w; w[0] = cvtpk(f.v[0], f.v[1]); w[1] = cvtpk(f.v[2], f.v[3]); w[2] = cvtpk(f.v[4], f.v[5]); w[3] = cvtpk(f.v[6], f.v[7]);
  *reinterpret_cast<u32x4*>(p) = w;
}
__device__ __forceinline__ F8 ld8f(const float* p) {
  const f32x4 a = *reinterpret_cast<const f32x4*>(p), b = *reinterpret_cast<const f32x4*>(p + 4); F8 r;
  r.v[0] = a[0]; r.v[1] = a[1]; r.v[2] = a[2]; r.v[3] = a[3]; r.v[4] = b[0]; r.v[5] = b[1]; r.v[6] = b[2]; r.v[7] = b[3]; return r;
}
struct F4 { float v[4]; };
__device__ __forceinline__ F4 ld4bf(const u16* p) {
  const uint2 w = *reinterpret_cast<const uint2*>(p); F4 r;
  r.v[0] = __uint_as_float(w.x << 16); r.v[1] = __uint_as_float(w.x & 0xffff0000u); r.v[2] = __uint_as_float(w.y << 16); r.v[3] = __uint_as_float(w.y & 0xffff0000u); return r;
}
__device__ __forceinline__ void st4bf(u16* p, const F4& f) { uint2 w; w.x = cvtpk(f.v[0], f.v[1]); w.y = cvtpk(f.v[2], f.v[3]); *reinterpret_cast<uint2*>(p) = w; }
__device__ __forceinline__ F4 ld4f(const float* p) { const f32x4 a = *reinterpret_cast<const f32x4*>(p); F4 r; r.v[0] = a[0]; r.v[1] = a[1]; r.v[2] = a[2]; r.v[3] = a[3]; return r; }
__device__ __forceinline__ F4 zero4() { F4 r; r.v[0] = r.v[1] = r.v[2] = r.v[3] = 0.f; return r; }
__device__ __forceinline__ F8 zero8() { F8 r;
#pragma unroll
  for (int i = 0; i < 8; ++i) r.v[i] = 0.f; return r; }
__device__ __forceinline__ float grp8sum(float v) { v = WS_DPP(v, 0xB1); v = WS_DPP(v, 0x4E); v = WS_DPP(v, 0x141); return v; }
__device__ __forceinline__ float grp16sum(float v) { v = grp8sum(v); v = WS_DPP(v, 0x140); return v; }
__device__ __forceinline__ float swz_xor4(float v) { return __int_as_float(__builtin_amdgcn_ds_swizzle(__float_as_int(v), 0x101F)); }
__device__ __forceinline__ float dpp_xor1(float v) { return __int_as_float(__builtin_amdgcn_update_dpp(0, __float_as_int(v), 0xB1, 0xf, 0xf, true)); }
__device__ __forceinline__ void tr_tile(const float* __restrict__ src, int ldsrc, u16* __restrict__ dst, int lddst, int k0, int n0, float* lds) {
  const int TIDX = opaque_tid();
  const int tid = TIDX;
  const int kr = tid >> 4, nc = (tid & 15) * 4;
#pragma unroll
  for (int i = 0; i < 2; ++i) {
    int k = kr + 32 * i;
    float4 v = *reinterpret_cast<const float4*>(src + (long)(k0 + k) * ldsrc + n0 + nc);
    float* d = lds + k * 65 + nc; d[0] = v.x; d[1] = v.y; d[2] = v.z; d[3] = v.w;
  }
  __syncthreads();
  const int n = tid >> 3, k8 = (tid & 7) * 8;
  u32x4 w;
  w[0] = cvtpk(lds[(k8 + 0) * 65 + n], lds[(k8 + 1) * 65 + n]);
  w[1] = cvtpk(lds[(k8 + 2) * 65 + n], lds[(k8 + 3) * 65 + n]);
  w[2] = cvtpk(lds[(k8 + 4) * 65 + n], lds[(k8 + 5) * 65 + n]);
  w[3] = cvtpk(lds[(k8 + 6) * 65 + n], lds[(k8 + 7) * 65 + n]);
  *reinterpret_cast<u32x4*>(dst + (long)(n0 + n) * lddst + k0 + k8) = w;
  __syncthreads();
}

__device__ __forceinline__ void phase0(const P& p, int l) {
  const int TIDX = opaque_tid();
  const int BIDX = opaque_bid();
  float* lds = (float*)smem;
  char* ws = p.ws;
  if (BIDX == 0 && TIDX == 0) { ((int*)(ws + O_CTR))[l] = 0; ((int*)(ws + O_CTR))[l + 4] = 0; }
  constexpr int NT_WIN = 16 * 163, NT_WBR = 4 * 128, NT_WOUT = 256, NT_GLU = 64, NT_UQ = 48, NT_UKV = 32, NT_UP = 16, NT_AUP = 16;
  constexpr int NT_ALL = NT_WIN + NT_WBR + NT_WOUT + NT_GLU + NT_UQ + NT_UKV + NT_UP + NT_AUP;
  for (int ti = BIDX; ti < NT_ALL; ti += gridDim.x) {
    int t = ti;
    if (t < NT_WIN) { tr_tile(p.in[I_WIN] + (long)l * 1024 * NIN, NIN, (u16*)(ws + O_WIN), 1024, (t & 15) * 64, (t >> 4) * 64, lds); continue; }
    t -= NT_WIN;
    if (t < NT_WBR) { int nb = t >> 7, r = t & 127;
      tr_tile(p.in[I_WBR] + ((long)l * 4 + nb) * 512 * 1024, 1024, (u16*)(ws + O_WBR) + (long)nb * 1024 * 512, 512, (r & 7) * 64, (r >> 3) * 64, lds); continue; }
    t -= NT_WBR;
    if (t < NT_WOUT) { tr_tile(p.in[I_WOUT] + (long)l * 1024 * 1024, 1024, (u16*)(ws + O_WOUT), 1024, (t & 15) * 64, (t >> 4) * 64, lds); continue; }
    t -= NT_WOUT;
    if (t < NT_GLU) { tr_tile(p.in[I_GLUW] + (long)l * 512 * 512, 512, (u16*)(ws + O_GLU), 512, (t & 7) * 64, (t >> 3) * 64, lds); continue; }
    t -= NT_GLU;
    if (t < NT_UQ) { tr_tile(p.in[I_WUQ] + (long)l * 256 * 768, 768, (u16*)(ws + O_UQ), 256, (t & 3) * 64, (t >> 2) * 64, lds); continue; }
    t -= NT_UQ;
    if (t < NT_UKV) { tr_tile(p.in[I_WUKV] + (long)l * 128 * 1024, 1024, (u16*)(ws + O_UKV), 128, (t & 1) * 64, (t >> 1) * 64, lds); continue; }
    t -= NT_UKV;
    if (t < NT_UP) { int d = t >> 3, r = t & 7;
      tr_tile(p.in[I_WUP] + ((long)l * 2 + d) * 64 * 512, 512, (u16*)(ws + O_WUP) + (long)d * 512 * 64, 64, 0, r * 64, lds); continue; }
    t -= NT_UP;
    { int d = t >> 3, r = t & 7;
      tr_tile(p.in[I_AUP] + ((long)l * 2 + d) * 64 * 512, 512, (u16*)(ws + O_AUP) + (long)d * 512 * 64, 64, 0, r * 64, lds); }
  }
  const float* xin = (l == 0) ? p.in[I_X] : p.out;
  const float* g = p.in[I_NORMG] + l * 1024;
  u16* h = (u16*)(ws + O_H);
  const int wid = TIDX >> 6, lane = TIDX & 63;
  for (int t = BIDX * 8 + wid; t < T; t += gridDim.x * 8) {
    const float* xr = xin + (long)t * 1024;
    float4 v[4]; float ss = 0.f;
#pragma unroll
    for (int i = 0; i < 4; ++i) { v[i] = *reinterpret_cast<const float4*>(xr + i * 256 + lane * 4); ss += v[i].x * v[i].x + v[i].y * v[i].y + v[i].z * v[i].z + v[i].w * v[i].w; }
    ss = wsum(ss);
    float sc = rsqrtf(ss * (1.f / 1024.f) + 1e-6f);
#pragma unroll
    for (int i = 0; i < 4; ++i) {
      float4 gg = *reinterpret_cast<const float4*>(g + i * 256 + lane * 4);
      uint2 o; o.x = cvtpk(v[i].x * sc * gg.x, v[i].y * sc * gg.y); o.y = cvtpk(v[i].z * sc * gg.z, v[i].w * sc * gg.w);
      *reinterpret_cast<uint2*>(h + (long)t * 1024 + i * 256 + lane * 4) = o;
    }
  }
}

template <int MT>
__device__ __forceinline__ void gemm_main(const u16* __restrict__ A, long lda, const u16* __restrict__ Bt, long ldb, int K,
                                          f32x4 (&acc)[MT][4], char* lds) {
  const int TIDX = opaque_tid();
  constexpr int BM = MT * 64;
  constexpr int ASZ = BM * 128, BSZ = 128 * 128, STG = ASZ + BSZ;
  const int tid = TIDX, lane = tid & 63, wid = tid >> 6, wm = wid >> 1, wn = wid & 1, fr = lane & 15, fq = lane >> 4;
  bf16x8 ra[MT], rb[2];
  const int nk = K >> 6;
#define GLOAD(k0) do { _Pragma("unroll") for (int i = 0; i < MT; ++i) { int gi = tid + 512 * i; int row = gi >> 3, g = gi & 7; \
      ra[i] = *reinterpret_cast<const bf16x8*>(A + (long)row * lda + (k0) + g * 8); } \
    _Pragma("unroll") for (int i = 0; i < 2; ++i) { int gi = tid + 512 * i; int row = gi >> 3, g = gi & 7; \
      rb[i] = *reinterpret_cast<const bf16x8*>(Bt + (long)row * ldb + (k0) + g * 8); } } while (0)
#define SWRITE(st) do { char* base_ = lds + (st) * STG; \
    _Pragma("unroll") for (int i = 0; i < MT; ++i) { int gi = tid + 512 * i; int row = gi >> 3, g = gi & 7; \
      *reinterpret_cast<bf16x8*>(base_ + row * 128 + ((g ^ ((row >> 1) & 7)) << 4)) = ra[i]; } \
    _Pragma("unroll") for (int i = 0; i < 2; ++i) { int gi = tid + 512 * i; int row = gi >> 3, g = gi & 7; \
      *reinterpret_cast<bf16x8*>(base_ + ASZ + row * 128 + ((g ^ ((row >> 1) & 7)) << 4)) = rb[i]; } } while (0)
  GLOAD(0); SWRITE(0); __syncthreads();
  for (int kt = 0; kt < nk; ++kt) {
    const int cur = kt & 1;
    if (kt + 1 < nk) GLOAD((kt + 1) * 64);
    const char* sa = lds + cur * STG; const char* sb = sa + ASZ;
#pragma unroll
    for (int kk = 0; kk < 2; ++kk) {
      bf16x8 af[MT], bfr[4];
      const int g = kk * 4 + fq;
#pragma unroll
      for (int i = 0; i < MT; ++i) { int row = wm * (MT * 16) + i * 16 + fr; af[i] = *reinterpret_cast<const bf16x8*>(sa + row * 128 + ((g ^ ((row >> 1) & 7)) << 4)); }
#pragma unroll
      for (int j = 0; j < 4; ++j) { int row = wn * 64 + j * 16 + fr; bfr[j] = *reinterpret_cast<const bf16x8*>(sb + row * 128 + ((g ^ ((row >> 1) & 7)) << 4)); }
#pragma unroll
      for (int i = 0; i < MT; ++i)
#pragma unroll
        for (int j = 0; j < 4; ++j) acc[i][j] = __builtin_amdgcn_mfma_f32_16x16x32_bf16(af[i], bfr[j], acc[i][j], 0, 0, 0);
    }
    if (kt + 1 < nk) SWRITE(cur ^ 1);
    __syncthreads();
  }
#undef GLOAD
#undef SWRITE
}
#define EPI_LOOP(MT_, BODY) do { const int lane_ = TIDX & 63, wid_ = TIDX >> 6, wm_ = wid_ >> 1, wn_ = wid_ & 1, fr_ = lane_ & 15, fq_ = lane_ >> 4; \
  _Pragma("unroll") for (int i = 0; i < MT_; ++i) _Pragma("unroll") for (int j = 0; j < 4; ++j) _Pragma("unroll") for (int jj = 0; jj < 4; ++jj) { \
    const int m = m0 + wm_ * (MT_ * 16) + i * 16 + fq_ * 4 + jj; const int n = n0 + wn_ * 64 + j * 16 + fr_; BODY } } while (0)

template <int MT> __device__ __forceinline__ void zero_acc(f32x4 (&acc)[MT][4]) {
#pragma unroll
  for (int i = 0; i < MT; ++i)
#pragma unroll
    for (int j = 0; j < 4; ++j) acc[i][j] = f32x4{0.f, 0.f, 0.f, 0.f};
}


#define LAS3 __attribute__((address_space(3)))
namespace fg {
constexpr int BM = 256, BK = 64, HALF = 128, HTB = HALF * BK * 2, NXCD = 8, WGM = 8;
__device__ __forceinline__ int lds_byte(int r, int c) { const int st = (r >> 4) * 2 + (c >> 5), rr = r & 15, cc = c & 31, ob = rr * 64 + cc * 2; return st * 1024 + (ob ^ (((ob >> 9) & 1) << 5)); }
__device__ __forceinline__ void stage_rc(int b, int& R, int& C) { const int st = b / 1024, sb = b % 1024, swz = sb ^ (((sb >> 9) & 1) << 5); R = (st >> 1) * 16 + swz / 64; C = (st & 1) * 32 + (swz % 64) / 2; }
struct Unit { int pm, pn; };
struct Order {
  int nM, nN, nwg, G, c;
  __device__ __forceinline__ void init(int M, int N, int G_, int c_) { nM = M / BM; nN = N / BM; nwg = nM * nN; G = G_; c = c_; }
  __device__ __forceinline__ bool next(int i, Unit& u) const {
    const long L = (long)i * G + c; if (L >= nwg) return false;
    int wgid = (int)L; { const int q = nwg / NXCD, r = nwg % NXCD, xcd = wgid % NXCD, off = wgid / NXCD; wgid = (xcd < r ? xcd * (q + 1) : r * (q + 1) + (xcd - r) * q) + off; }
    const int nig = WGM * nN, gid = wgid / nig, fm = gid * WGM, gsz = (nM - fm) < WGM ? (nM - fm) : WGM;
    u.pm = fm + ((wgid % nig) % gsz); u.pn = (wgid % nig) / gsz; return true;
  }
};
__device__ __forceinline__ int perm32(int rho) { const int n = rho >> 4, i = rho & 15; return 8 * (i >> 2) + 4 * n + (i & 3); }
template <class Epi, bool PERM = false>
__device__ __forceinline__ void gemm_phase(LAS3 unsigned char* lds, const u16* A, int lda, const u16* Bt, int ldb, int M, int N, int K, const Epi& E) {
  const int tid = opaque_tid(), wid = __builtin_amdgcn_readfirstlane(tid >> 6), lane = tid & 63, wr = wid >> 2, wc = wid & 3, fr = lane & 15, fq = lane >> 4;
  const int nt = K / BK;
  Order S; S.init(M, N, gridDim.x, opaque_bid());
  unsigned voffA[2], voffB[2];
#pragma unroll
  for (int i = 0; i < 2; ++i) { int R, C; stage_rc(tid * 16 + i * 8192, R, C); const int Rb = PERM ? ((R & ~31) + perm32(R & 31)) : R;
    voffA[i] = (unsigned)(R * lda + C) * 2u; voffB[i] = (unsigned)(Rb * ldb + C) * 2u; }
  const size_t kstep = (size_t)(BK * 2);
  const size_t hstepA = (size_t)HALF * lda * 2, hstepB = (size_t)HALF * ldb * 2;
  const size_t tstepA = 2 * hstepA, tstepB = 2 * hstepB;
  const unsigned ldsw = (unsigned)wid * 1024u;
  const int aoff = lds_byte(wr * 64 + fr, fq * 8), boff = lds_byte(wc * 32 + fr, fq * 8);
#define FG_SA(b, h) (((b) * 2 + (h)) * HTB)
#define FG_SB(b, h) ((4 + (b) * 2 + (h)) * HTB)
#define FG_STAGE(bufoff, gbase, voff) do { _Pragma("unroll") for (int _i = 0; _i < 2; ++_i) \
    __builtin_amdgcn_global_load_lds((const unsigned*)((const char*)(gbase) + (voff)[_i]), (LAS3 unsigned*)(lds + (bufoff) + ldsw + _i * 8192), 16, 0, 0); } while (0)
#define FG_LDA(dst, b, h) do { _Pragma("unroll") for (int m = 0; m < 4; ++m) _Pragma("unroll") for (int k = 0; k < 2; ++k) dst[m][k] = *(const LAS3 bf16x8*)(lds + FG_SA(b, h) + aoff + m * 2048 + k * 1024); } while (0)
#define FG_LDB(dst, b, h) do { _Pragma("unroll") for (int n = 0; n < 2; ++n) _Pragma("unroll") for (int k = 0; k < 2; ++k) dst[n][k] = *(const LAS3 bf16x8*)(lds + FG_SB(b, h) + boff + n * 2048 + k * 1024); } while (0)
#define FG_MMA(ai, bj, At, Bq) do { __builtin_amdgcn_s_setprio(1); _Pragma("unroll") for (int m = 0; m < 4; ++m) _Pragma("unroll") for (int n = 0; n < 2; ++n) _Pragma("unroll") for (int k = 0; k < 2; ++k) \
    acc[ai][bj][m][n] = __builtin_amdgcn_mfma_f32_16x16x32_bf16(Bq[n][k], At[m][k], acc[ai][bj][m][n], 0, 0, 0); __builtin_amdgcn_s_setprio(0); } while (0)
#define FG_WAIT_V(n) asm volatile("s_waitcnt vmcnt(" #n ")" ::: "memory")
#define FG_WAIT_L(n) asm volatile("s_waitcnt lgkmcnt(" #n ")" ::: "memory")
#define FG_BAR __builtin_amdgcn_s_barrier()
#define FG_SCHED __builtin_amdgcn_sched_barrier(0)
  Unit cur, nxt; int ui = 0;
  if (!S.next(0, cur)) return;
  f32x4 acc[2][2][4][2];
#pragma unroll
  for (int a = 0; a < 2; ++a)
#pragma unroll
    for (int b = 0; b < 2; ++b)
#pragma unroll
      for (int m = 0; m < 4; ++m)
#pragma unroll
        for (int n = 0; n < 2; ++n) acc[a][b][m][n] = (f32x4){0.f, 0.f, 0.f, 0.f};
  bf16x8 At[4][2], B0[2][2], B1[2][2];
  const char* cA = (const char*)A + (size_t)cur.pm * tstepA; const char* cB = (const char*)Bt + (size_t)cur.pn * tstepB;
  FG_STAGE(FG_SB(0, 0), cB, voffB); FG_STAGE(FG_SA(0, 0), cA, voffA); FG_STAGE(FG_SB(0, 1), cB + hstepB, voffB); FG_STAGE(FG_SA(0, 1), cA + hstepA, voffA);
  if (wr == 1) FG_BAR;
  FG_WAIT_V(4); FG_BAR;
  FG_STAGE(FG_SB(1, 0), cB + kstep, voffB); FG_STAGE(FG_SA(1, 0), cA + kstep, voffA); FG_STAGE(FG_SB(1, 1), cB + hstepB + kstep, voffB);
  FG_WAIT_V(6); FG_BAR;
  for (;;) {
    const bool has_next = S.next(ui + 1, nxt);
    const char* nA = has_next ? (const char*)A + (size_t)nxt.pm * tstepA : cA; const char* nB = has_next ? (const char*)Bt + (size_t)nxt.pn * tstepB : cB;
    for (int t = 0; t < nt; t += 2) {
      const bool last = (t == nt - 2);
      const char* a1 = cA + (size_t)(t + 1) * kstep;
      const char* a2 = last ? nA : cA + (size_t)(t + 2) * kstep; const char* b2 = last ? nB : cB + (size_t)(t + 2) * kstep;
      const char* a3 = a2 + kstep; const char* b3 = b2 + kstep;
      FG_LDB(B0, 0, 0); FG_SCHED; FG_LDA(At, 0, 0); FG_STAGE(FG_SA(1, 1), a1 + hstepA, voffA);
      FG_WAIT_L(8); FG_BAR; FG_WAIT_L(0); FG_MMA(0, 0, At, B0); FG_BAR; FG_SCHED;
      FG_LDB(B1, 0, 1); FG_STAGE(FG_SB(0, 0), b2, voffB);
      FG_BAR; FG_WAIT_L(0); FG_MMA(0, 1, At, B1); FG_BAR;
      FG_LDA(At, 0, 1); FG_STAGE(FG_SA(0, 0), a2, voffA);
      FG_BAR; FG_WAIT_L(0); FG_MMA(1, 0, At, B0); FG_BAR; FG_SCHED;
      FG_STAGE(FG_SB(0, 1), b2 + hstepB, voffB);
      FG_WAIT_V(6); FG_BAR; FG_MMA(1, 1, At, B1); FG_BAR;
      FG_LDB(B0, 1, 0); FG_SCHED; FG_LDA(At, 1, 0); FG_STAGE(FG_SA(0, 1), a2 + hstepA, voffA);
      FG_WAIT_L(8); FG_BAR; FG_WAIT_L(0); FG_MMA(0, 0, At, B0); FG_BAR; FG_SCHED;
      FG_LDB(B1, 1, 1); FG_STAGE(FG_SB(1, 0), b3, voffB);
      FG_BAR; FG_WAIT_L(0); FG_MMA(0, 1, At, B1); FG_BAR;
      FG_LDA(At, 1, 1); FG_STAGE(FG_SA(1, 0), a3, voffA);
      FG_BAR; FG_WAIT_L(0); FG_MMA(1, 0, At, B0); FG_BAR; FG_SCHED;
      FG_STAGE(FG_SB(1, 1), b3 + hstepB, voffB);
      FG_WAIT_V(6); FG_BAR; FG_MMA(1, 1, At, B1); FG_BAR;
    }
    if constexpr (PERM) {
      const int row0 = cur.pm * BM + wr * 64 + fr, col0 = cur.pn * BM + wc * 32 + 8 * fq;
#pragma unroll
      for (int ai = 0; ai < 2; ++ai)
#pragma unroll
        for (int m = 0; m < 4; ++m)
#pragma unroll
          for (int bj = 0; bj < 2; ++bj) E(row0 + ai * HALF + m * 16, col0 + bj * HALF, acc[ai][bj][m][0], acc[ai][bj][m][1]);
    } else {
      const int row0 = cur.pm * BM + wr * 64 + fr, col0 = cur.pn * BM + wc * 32 + 4 * fq;
#pragma unroll
      for (int ai = 0; ai < 2; ++ai)
#pragma unroll
        for (int m = 0; m < 4; ++m)
#pragma unroll
          for (int bj = 0; bj < 2; ++bj)
#pragma unroll
            for (int n = 0; n < 2; ++n) E(row0 + ai * HALF + m * 16, col0 + bj * HALF + n * 16, acc[ai][bj][m][n]);
    }
    if (!has_next) break;
#pragma unroll
    for (int a = 0; a < 2; ++a)
#pragma unroll
      for (int b = 0; b < 2; ++b)
#pragma unroll
        for (int m = 0; m < 4; ++m)
#pragma unroll
          for (int n = 0; n < 2; ++n) acc[a][b][m][n] = (f32x4){0.f, 0.f, 0.f, 0.f};
    cur = nxt; cA = nA; cB = nB; ++ui;
  }
  FG_WAIT_V(0);
  if (wr == 0) FG_BAR;
  FG_BAR;
#undef FG_SA
#undef FG_SB
#undef FG_STAGE
#undef FG_LDA
#undef FG_LDB
#undef FG_MMA
#undef FG_WAIT_V
#undef FG_WAIT_L
#undef FG_BAR
#undef FG_SCHED
}
}

struct EpiP1 { u16* PB; __device__ __forceinline__ void operator()(int row, int col, f32x4 v0, f32x4 v1) const {
  if (col < NP) { u32x4 o; o[0] = cvtpk(v0[0], v0[1]); o[1] = cvtpk(v0[2], v0[3]); o[2] = cvtpk(v1[0], v1[1]); o[3] = cvtpk(v1[2], v1[3]);
    *reinterpret_cast<u32x4*>(PB + (long)row * NP + col) = o; } } };
struct EpiGate { u16* G; const float* gb; __device__ __forceinline__ void operator()(int row, int col, f32x4 v0, f32x4 v1) const {
  const f32x4 b0 = *reinterpret_cast<const f32x4*>(gb + col), b1 = *reinterpret_cast<const f32x4*>(gb + col + 4);
  u32x4 o; o[0] = cvtpk(sigmoidf_(v0[0] + b0[0]), sigmoidf_(v0[1] + b0[1])); o[1] = cvtpk(sigmoidf_(v0[2] + b0[2]), sigmoidf_(v0[3] + b0[3]));
  o[2] = cvtpk(sigmoidf_(v1[0] + b1[0]), sigmoidf_(v1[1] + b1[1])); o[3] = cvtpk(sigmoidf_(v1[2] + b1[2]), sigmoidf_(v1[3] + b1[3]));
  *reinterpret_cast<u32x4*>(G + (long)row * 4096 + col) = o; } };
struct EpiOut { float* out; const float* xin; __device__ __forceinline__ void operator()(int row, int col, f32x4 v) const {
  const f32x4 x = *reinterpret_cast<const f32x4*>(xin + (long)row * 1024 + col);
  *reinterpret_cast<f32x4*>(out + (long)row * 1024 + col) = x + v; } };

__device__ __forceinline__ void phase1(const P& p) {
  char* ws = p.ws;
  EpiP1 e{(u16*)(ws + O_P)};
  fg::gemm_phase<EpiP1, true>((LAS3 unsigned char*)smem, (const u16*)(ws + O_H), 1024, (const u16*)(ws + O_WIN), 1024, T, 6400, 1024, e);
}

__device__ __forceinline__ void phase2(const P& p, int l) {
  const int TIDX = opaque_tid();
  const int BIDX = opaque_bid();
  char* ws = p.ws;
  const u16* __restrict__ PB = (const u16*)(ws + O_P);
  u16* __restrict__ DQ = (u16*)(ws + QK_DQ); u16* __restrict__ DKb = (u16*)(ws + QK_DK);
  u16* __restrict__ CQN = (u16*)(ws + OA_CQN); u16* __restrict__ CKVN = (u16*)(ws + OA_CKVN);
  u16* __restrict__ LINW = (u16*)(ws + OA_LINW); u16* __restrict__ LINA = (u16*)(ws + OA_LINA);
  const int wid = TIDX >> 6, lane = TIDX & 63, l7 = lane & 7, e0 = l7 * 8, hv = lane >> 3;
  const F8 gq = ld8f(p.in[I_DQN] + l * 64 + e0), gk = ld8f(p.in[I_DKN] + l * 64 + e0);
  float invd[8];
#pragma unroll
  for (int j = 0; j < 8; ++j) invd[j] = exp2f(-(float)j * (1.f / 8.f) * 18.931568569324174f);
  F8 glat = zero8();
  if (lane < 32) glat = ld8f(p.in[I_QLN] + l * 256 + lane * 8); else if (lane < 48) glat = ld8f(p.in[I_KVLN] + l * 128 + (lane - 32) * 8);
  F8 mu0 = zero8(), mu1 = zero8();
  if (lane < 32) { mu0 = ld8f(p.in[I_MU] + (long)l * 2 * 1792 + 1536 + lane * 8); mu1 = ld8f(p.in[I_MU] + (long)l * 2 * 1792 + 1792 + 1536 + lane * 8); }
  for (int t = BIDX * 8 + wid; t < T; t += gridDim.x * 8) {
    const int b = t >> 12, s = t & 4095;
    const u16* pr = PB + (long)t * NP;
    F8 q = ld8bf(pr + C_DQ + lane * 8), k = ld8bf(pr + C_DK + lane * 8);
    F8 lat = zero8(); if (lane < 48) lat = ld8bf(pr + C_MCQ + lane * 8);
    F8 xc = zero8(), xp = zero8(), xn = zero8();
    if (lane < 32) { xc = ld8bf(pr + C_RC + 1536 + lane * 8); if (s > 0) xp = ld8bf(pr - NP + C_RC + 1536 + lane * 8); if (s < S - 1) xn = ld8bf(pr + NP + C_RC + 1536 + lane * 8); }
    float sq = 0.f, sk = 0.f;
#pragma unroll
    for (int j = 0; j < 8; ++j) { sq += q.v[j] * q.v[j]; sk += k.v[j] * k.v[j]; }
    sq = grp8sum(sq); sk = grp8sum(sk);
    const float cq_ = rsqrtf(sq * (1.f / 64.f) + 1e-6f), ck_ = rsqrtf(sk * (1.f / 64.f) + 1e-6f);
#pragma unroll
    for (int j = 0; j < 8; ++j) {
      float yq = q.v[j] * cq_ * gq.v[j], yk = k.v[j] * ck_ * gk.v[j];
      const float pq = dpp_xor1(yq), pk = dpp_xor1(yk);
      float sn, cs; sincos_rev((float)s * invd[j], sn, cs);
      if (l7 == 0) { yq = yq * cs - pq * sn; yk = yk * cs - pk * sn; }
      else if (l7 == 1) { yq = pq * sn + yq * cs; yk = pk * sn + yk * cs; }
      q.v[j] = yq; k.v[j] = yk;
    }
    st8bf(DQ + ((long)(b * 8 + hv) * S + s) * 64 + e0, q);
    st8bf(DKb + ((long)(b * 8 + hv) * S + s) * 64 + e0, k);
    {
      float ss = 0.f;
#pragma unroll
      for (int j = 0; j < 8; ++j) ss += lat.v[j] * lat.v[j];
      const float s1 = wsum(lane < 32 ? ss : 0.f), s2 = wsum((lane >= 32 && lane < 48) ? ss : 0.f);
      const float sc = (lane < 32) ? rsqrtf(s1 * (1.f / 256.f) + 1e-6f) : rsqrtf(s2 * (1.f / 128.f) + 1e-6f);
#pragma unroll
      for (int j = 0; j < 8; ++j) lat.v[j] = lat.v[j] * sc * glat.v[j];
      if (lane < 32) st8bf(CQN + (long)t * 256 + lane * 8, lat); else if (lane < 48) st8bf(CKVN + (long)t * 128 + (lane - 32) * 8, lat);
    }
    if (lane < 32) {
      F8 o;
#pragma unroll
      for (int j = 0; j < 8; ++j) {
        const float xs = xc.v[j] + mu0.v[j] * (xp.v[j] - xc.v[j]) + mu1.v[j] * (xn.v[j] - xc.v[j]);
        if (lane < 16) { const float e2 = __expf(2.f * xs); o.v[j] = 1.f - 2.f / (e2 + 1.f); } else o.v[j] = xs;
      }
      if (lane < 16) st8bf(LINW + (long)t * 128 + lane * 8, o); else st8bf(LINA + (long)t * 128 + (lane - 16) * 8, o);
    }
  }
}

__device__ __forceinline__ void phase3(const P& p) {
  const int TIDX = opaque_tid();
  const int BIDX = opaque_bid();
  char* ws = p.ws;
  for (int ti = BIDX; ti < 30 * 64; ti += gridDim.x) {
    const int ng = ti % 30, mt = ti / 30; const int m0 = mt * 256;
    const u16* A; long lda; const u16* Bt; long ldb; int K; u16* C; long ldc; int n0;
    if (ng < 6) { A = (const u16*)(ws + OA_CQN); lda = 256; K = 256; n0 = ng * 128; Bt = (const u16*)(ws + O_UQ) + (long)n0 * 256; ldb = 256; C = (u16*)(ws + OA_QRAW); ldc = 768; }
    else if (ng < 14) { A = (const u16*)(ws + OA_CKVN); lda = 128; K = 128; n0 = (ng - 6) * 128; Bt = (const u16*)(ws + O_UKV) + (long)n0 * 128; ldb = 128; C = (u16*)(ws + OA_KVRAW); ldc = 1024; }
    else { const int q = ng - 14; const int isA = q >> 3, d = (q >> 2) & 1; n0 = (q & 3) * 128;
      A = (const u16*)(ws + (isA ? OA_LINA : OA_LINW)) + d * 64; lda = 128; K = 64;
      Bt = (const u16*)(ws + (isA ? O_AUP : O_WUP)) + (long)d * 512 * 64 + (long)n0 * 64; ldb = 64;
      C = (u16*)(ws + (isA ? OA_AL : OA_WL)) + d * 512; ldc = 1024; }
    f32x4 acc[4][4]; zero_acc<4>(acc);
    gemm_main<4>(A + (long)m0 * lda, lda, Bt, ldb, K, acc, smem);
    EPI_LOOP(4, { C[(long)m * ldc + n] = f2bf(acc[i][j][jj]); });
  }
}

__device__ __forceinline__ void phase4(const P& p, int l) {
  const int TIDX = opaque_tid();
  const int BIDX = opaque_bid();
  char* ws = p.ws;
  const u16* __restrict__ PB = (const u16*)(ws + O_P);
  const u16* __restrict__ QRAW = (const u16*)(ws + OA_QRAW); const u16* __restrict__ KVRAW = (const u16*)(ws + OA_KVRAW);
  const u16* __restrict__ WL = (const u16*)(ws + OA_WL); const u16* __restrict__ AL = (const u16*)(ws + OA_AL);
  u16* __restrict__ MQ = (u16*)(ws + QK_MQ); u16* __restrict__ MK = (u16*)(ws + QK_MK); u16* __restrict__ MV = (u16*)(ws + QK_MV);
  u16* __restrict__ RR = (u16*)(ws + RW_R); u16* __restrict__ RK = (u16*)(ws + RW_K); u16* __restrict__ RV = (u16*)(ws + RW_V); u16* __restrict__ RKK = (u16*)(ws + RW_KK);
  u16* __restrict__ RA = (u16*)(ws + RW_A); u16* __restrict__ RE = (u16*)(ws + RW_E); float* __restrict__ BON = (float*)(ws + RW_BON);
  const int wid = TIDX >> 6, lane = TIDX & 63;
  float* lp = (float*)smem;
  {
    const float* mu = p.in[I_MU] + (long)l * 2 * 1792;
    for (int i = TIDX; i < 13 * 512; i += 512) {
      const int a = i >> 9, c = i & 511; float v;
      if (a < 3) v = mu[a * 512 + c]; else if (a < 6) v = mu[1792 + (a - 3) * 512 + c];
      else if (a == 6) v = p.in[I_KK][l * 512 + c]; else if (a == 7) v = p.in[I_KA][l * 512 + c]; else if (a == 8) v = p.in[I_RK][l * 512 + c];
      else if (a < 11) v = p.in[I_W0][(l * 2 + (a - 9)) * 512 + c]; else v = p.in[I_A0][(l * 2 + (a - 11)) * 512 + c];
      lp[i] = v;
    }
  }
  __syncthreads();
  const int hA = lane >> 4, eA = (lane & 15) * 8, hB = (lane >> 3) & 3, eB = (lane & 7) * 8;
  const F8 qnA = ld8f(p.in[I_MQN] + l * 192 + eA), qnB = ld8f(p.in[I_MQN] + l * 192 + 128 + eB);
  const F8 knA = ld8f(p.in[I_MKN] + l * 192 + eA), knB = ld8f(p.in[I_MKN] + l * 192 + 128 + eB);
  float invm[8];
#pragma unroll
  for (int j = 0; j < 8; ++j) invm[j] = exp2f(-(float)((lane & 3) * 8 + j) * (1.f / 32.f) * 13.287712379549449f);
  const bool lowhalf = (lane & 4) == 0;
  for (int t = BIDX * 8 + wid; t < T; t += gridDim.x * 8) {
    const int b = t >> 12, s = t & 4095;
    const u16* pr = PB + (long)t * NP;
    F8 qA = ld8bf(QRAW + (long)t * 768 + hA * 192 + eA), qB = ld8bf(QRAW + (long)t * 768 + hB * 192 + 128 + eB);
    F8 kA = ld8bf(KVRAW + (long)t * 1024 + hA * 256 + eA), vA = ld8bf(KVRAW + (long)t * 1024 + hA * 256 + 128 + eA);
    F8 kB = ld8bf(pr + C_MKR + eB);
    {
      float sqA = 0.f, sqB = 0.f, skA = 0.f, skB = 0.f;
#pragma unroll
      for (int j = 0; j < 8; ++j) { sqA += qA.v[j] * qA.v[j]; sqB += qB.v[j] * qB.v[j]; skA += kA.v[j] * kA.v[j]; skB += kB.v[j] * kB.v[j]; }
      sqA = grp16sum(sqA); skA = grp16sum(skA); sqB = grp8sum(sqB); skB = grp8sum(skB);
      const float sqB_forA = __shfl(sqB, 8 * hA), sqA_forB = __shfl(sqA, 16 * hB);
      const float skA_forB = __shfl(skA, 16 * hB);
      const float scqA = rsqrtf((sqA + sqB_forA) * (1.f / 192.f) + 1e-6f), scqB = rsqrtf((sqA_forB + sqB) * (1.f / 192.f) + 1e-6f);
      const float sckA = rsqrtf((skA + skB) * (1.f / 192.f) + 1e-6f), sckB = rsqrtf((skA_forB + skB) * (1.f / 192.f) + 1e-6f);
#pragma unroll
      for (int j = 0; j < 8; ++j) {
        qA.v[j] *= scqA * qnA.v[j]; kA.v[j] *= sckA * knA.v[j];
        float yq = qB.v[j] * scqB * qnB.v[j], yk = kB.v[j] * sckB * knB.v[j];
        const float pq = swz_xor4(yq), pk = swz_xor4(yk);
        float sn, cs; sincos_rev((float)s * invm[j], sn, cs);
        qB.v[j] = lowhalf ? (yq * cs - pq * sn) : (pq * sn + yq * cs);
        kB.v[j] = lowhalf ? (yk * cs - pk * sn) : (pk * sn + yk * cs);
      }
      u16* mq = MQ + ((long)(b * 4 + hA) * S + s) * 192; u16* mk = MK + ((long)(b * 4 + hA) * S + s) * 192;
      st8bf(mq + eA, qA); st8bf(mk + eA, kA);
      st8bf(MV + ((long)(b * 4 + hA) * S + s) * 128 + eA, vA);
      if (lane < 32) { st8bf(MQ + ((long)(b * 4 + hB) * S + s) * 192 + 128 + eB, qB); st8bf(MK + ((long)(b * 4 + hB) * S + s) * 192 + 128 + eB, kB); }
    }
#pragma unroll 1
    for (int hf = 0; hf < 2; ++hf) {
      const int c0 = hf * 256 + lane * 4;
      const F4 xr = ld4bf(pr + C_RC + c0), xk = ld4bf(pr + C_RC + 512 + c0), xv = ld4bf(pr + C_RC + 1024 + c0);
      F4 pr_ = zero4(), pk_ = zero4(), pv_ = zero4(), nr_ = zero4(), nk_ = zero4(), nv_ = zero4();
      if (s > 0) { pr_ = ld4bf(pr - NP + C_RC + c0); pk_ = ld4bf(pr - NP + C_RC + 512 + c0); pv_ = ld4bf(pr - NP + C_RC + 1024 + c0); }
      if (s < S - 1) { nr_ = ld4bf(pr + NP + C_RC + c0); nk_ = ld4bf(pr + NP + C_RC + 512 + c0); nv_ = ld4bf(pr + NP + C_RC + 1024 + c0); }
      const F4 wl0 = ld4bf(WL + ((long)t * 2) * 512 + c0), wl1 = ld4bf(WL + ((long)t * 2 + 1) * 512 + c0);
      const F4 al0 = ld4bf(AL + ((long)t * 2) * 512 + c0), al1 = ld4bf(AL + ((long)t * 2 + 1) * 512 + c0);
      const F4 m0r = ld4f(lp + 0 * 512 + c0), m0k = ld4f(lp + 1 * 512 + c0), m0v = ld4f(lp + 2 * 512 + c0);
      const F4 m1r = ld4f(lp + 3 * 512 + c0), m1k = ld4f(lp + 4 * 512 + c0), m1v = ld4f(lp + 5 * 512 + c0);
      const F4 kkp = ld4f(lp + 6 * 512 + c0), kap = ld4f(lp + 7 * 512 + c0), rkp = ld4f(lp + 8 * 512 + c0);
      const F4 w00 = ld4f(lp + 9 * 512 + c0), w01 = ld4f(lp + 10 * 512 + c0), a00 = ld4f(lp + 11 * 512 + c0), a01 = ld4f(lp + 12 * 512 + c0);
      F4 r, k, v, kk, e0_, e1_, a0_, a1_; float ss = 0.f, bon = 0.f;
#pragma unroll
      for (int j = 0; j < 4; ++j) {
        r.v[j] = xr.v[j] + m0r.v[j] * (pr_.v[j] - xr.v[j]) + m1r.v[j] * (nr_.v[j] - xr.v[j]);
        k.v[j] = xk.v[j] + m0k.v[j] * (pk_.v[j] - xk.v[j]) + m1k.v[j] * (nk_.v[j] - xk.v[j]);
        v.v[j] = xv.v[j] + m0v.v[j] * (pv_.v[j] - xv.v[j]) + m1v.v[j] * (nv_.v[j] - xv.v[j]);
        kk.v[j] = k.v[j] * kkp.v[j]; ss += kk.v[j] * kk.v[j];
      }
      ss = grp16sum(ss);
      const float inrm = 1.f / fmaxf(sqrtf(ss), 1e-12f);
#pragma unroll
      for (int j = 0; j < 4; ++j) {
        kk.v[j] *= inrm;
        {
          const float nx = -(w00.v[j] + wl0.v[j]);
          const float sp = fmaxf(nx, 0.f) + __logf(1.f + __expf(-fabsf(nx)));
          e0_.v[j] = __expf(-sp - 0.5f);
          const float a = sigmoidf_(a00.v[j] + al0.v[j]); a0_.v[j] = a;
          bon += r.v[j] * k.v[j] * (1.f + (a - 1.f) * kap.v[j]) * rkp.v[j];
        }
        {
          const float nx = -(w01.v[j] + wl1.v[j]);
          const float sp = fmaxf(nx, 0.f) + __logf(1.f + __expf(-fabsf(nx)));
          e1_.v[j] = __expf(-sp - 0.5f);
          const float a = sigmoidf_(a01.v[j] + al1.v[j]); a1_.v[j] = a;
          bon += r.v[j] * k.v[j] * (1.f + (a - 1.f) * kap.v[j]) * rkp.v[j];
        }
      }
      bon = grp16sum(bon);
      if ((lane & 15) == 0) BON[(long)t * 8 + hf * 4 + (lane >> 4)] = bon;
      const long o = (long)t * 512 + c0;
      st4bf(RR + o, r); st4bf(RK + o, k); st4bf(RV + o, v); st4bf(RKK + o, kk);
      st4bf(RE + o, e0_); st4bf(RE + (long)T * 512 + o, e1_); st4bf(RA + o, a0_); st4bf(RA + (long)T * 512 + o, a1_);
    }
  }
  __syncthreads();
}

#define SBAR() __builtin_amdgcn_sched_barrier(0)
__device__ __forceinline__ int crow(int r, int hi) { return (r & 3) + 8 * (r >> 2) + 4 * hi; }
template <int DK> struct AC {
  static constexpr float SCALE = (DK == 64) ? 0.125f : 0.07216878364870323f;
  static constexpr float THR = 8.f;
  static constexpr int NKG = DK / 64;
  static constexpr int SHM_K = 64 * DK * 2, SHM_V = 64 * 128 * 2;
};
template <int DK>
__device__ __forceinline__ void partialSM(f32x16& p0, f32x16& p1, float& m_reg, float& mn, float& alpha) {
  constexpr float C = AC<DK>::SCALE * 1.4426950408889634f;
  float pmax = p0[0];
#pragma unroll
  for (int r = 1; r < 16; ++r) pmax = fmaxf(pmax, p0[r]);
#pragma unroll
  for (int r = 0; r < 16; ++r) pmax = fmaxf(pmax, p1[r]);
  { auto rr = __builtin_amdgcn_permlane32_swap(__float_as_uint(pmax), __float_as_uint(pmax), false, false);
    pmax = fmaxf(__uint_as_float(rr[0]), __uint_as_float(rr[1])); }
  if (__builtin_expect(__all(pmax - m_reg <= AC<DK>::THR / AC<DK>::SCALE), 1)) { mn = m_reg; alpha = 1.f; }
  else { mn = fmaxf(m_reg, pmax); alpha = __builtin_amdgcn_exp2f((m_reg - mn) * C); m_reg = mn; }
  float mnC = -mn * C;
#pragma unroll
  for (int r = 0; r < 16; ++r) p0[r] = fmaf(p0[r], C, mnC);
#pragma unroll
  for (int r = 0; r < 16; ++r) p1[r] = fmaf(p1[r], C, mnC);
#pragma unroll
  for (int r = 0; r < 16; ++r) p0[r] = __builtin_amdgcn_exp2f(p0[r]);
}
__device__ __forceinline__ void finishSM(f32x16& p0, f32x16& p1, float alpha, float& l_reg, bf16x8& pa0, bf16x8& pa1, bf16x8& pa2, bf16x8& pa3) {
#pragma unroll
  for (int r = 0; r < 16; ++r) p1[r] = __builtin_amdgcn_exp2f(p1[r]);
  float ps = 0;
#pragma unroll
  for (int r = 0; r < 16; ++r) ps += p0[r];
#pragma unroll
  for (int r = 0; r < 16; ++r) ps += p1[r];
  { auto rr = __builtin_amdgcn_permlane32_swap(__float_as_uint(ps), __float_as_uint(ps), false, false);
    ps = __uint_as_float(rr[0]) + __uint_as_float(rr[1]); }
  l_reg = l_reg * alpha + ps;
#define PK4(Pv, BASE, OUT) do { unsigned a0 = cvtpk_asm(Pv[BASE + 0], Pv[BASE + 1]), a1 = cvtpk_asm(Pv[BASE + 2], Pv[BASE + 3]);   \
    unsigned b0 = cvtpk_asm(Pv[BASE + 4], Pv[BASE + 5]), b1 = cvtpk_asm(Pv[BASE + 6], Pv[BASE + 7]);                              \
    auto r0 = __builtin_amdgcn_permlane32_swap(a0, b0, false, false); auto r1 = __builtin_amdgcn_permlane32_swap(a1, b1, false, false); \
    u32x4 w = {r0[0], r1[0], r0[1], r1[1]}; OUT = *reinterpret_cast<bf16x8*>(&w); } while (0)
  PK4(p0, 0, pa0); PK4(p0, 8, pa1); PK4(p1, 0, pa2); PK4(p1, 8, pa3);
#undef PK4
}
template <int DK>
__device__ __forceinline__ void qkt(f32x16& p0, f32x16& p1, const char* Ks, const bf16x8* qr, int r32, int hi) {
  p0 = f32x16{}; p1 = f32x16{};
  const int sw = (r32 & 7) << 4;
  const char* kb[4];
#pragma unroll
  for (int q = 0; q < 4; ++q) kb[q] = Ks + r32 * (DK * 2) + ((q * 32 + hi * 16) ^ sw);
#pragma unroll
  for (int d0 = 0; d0 < DK / 16; ++d0) {
    bf16x8 b0 = *reinterpret_cast<const bf16x8*>(kb[d0 & 3] + (d0 >> 2) * 128);
    bf16x8 b1 = *reinterpret_cast<const bf16x8*>(kb[d0 & 3] + (d0 >> 2) * 128 + 32 * (DK * 2));
    p0 = __builtin_amdgcn_mfma_f32_32x32x16_bf16(b0, qr[d0], p0, 0, 0, 0);
    p1 = __builtin_amdgcn_mfma_f32_32x32x16_bf16(b1, qr[d0], p1, 0, 0, 0); }
}
__device__ __forceinline__ int v_st(int k, int c) { const int kk = (k & ~0xC) | ((k & 4) << 1) | ((k & 8) >> 1); return ((kk >> 3) * 4 + (c >> 5)) * 512 + ((kk & 7) * 32 + (c & 31)) * 2; }
__device__ __forceinline__ int v_rd_base(int lane) { return ((lane & 3) << 3) | (((lane >> 2) & 3) << 6) | (((lane >> 4) & 1) << 5) | (((lane >> 5) & 1) << 8); }
constexpr int v_rd_off(int d0, int ks, int half) { return d0 * 512 + ks * 4096 + half * 2048; }
template <int OFF> __device__ __forceinline__ s16x4 tr_read(int vb) {
  s16x4 r; asm volatile("ds_read_b64_tr_b16 %0, %1 offset:%2" : "=&v"(r) : "v"(vb), "i"(OFF) : "memory"); return r;
}
template <int D0> __device__ __forceinline__ void pv_one(f32x16& od, int vb, bf16x8 pa0, bf16x8 pa1, bf16x8 pa2, bf16x8 pa3) {
  const s16x4 l0 = tr_read<v_rd_off(D0, 0, 0)>(vb), h0 = tr_read<v_rd_off(D0, 0, 1)>(vb), l1 = tr_read<v_rd_off(D0, 1, 0)>(vb), h1 = tr_read<v_rd_off(D0, 1, 1)>(vb);
  const s16x4 l2 = tr_read<v_rd_off(D0, 2, 0)>(vb), h2 = tr_read<v_rd_off(D0, 2, 1)>(vb), l3 = tr_read<v_rd_off(D0, 3, 0)>(vb), h3 = tr_read<v_rd_off(D0, 3, 1)>(vb);
  asm volatile("s_waitcnt lgkmcnt(0)" ::: "memory"); SBAR();
#define PKV(L, H) (bf16x8){L[0], L[1], L[2], L[3], H[0], H[1], H[2], H[3]}
  od = __builtin_amdgcn_mfma_f32_32x32x16_bf16(pa0, PKV(l0, h0), od, 0, 0, 0);
  od = __builtin_amdgcn_mfma_f32_32x32x16_bf16(pa1, PKV(l1, h1), od, 0, 0, 0);
  od = __builtin_amdgcn_mfma_f32_32x32x16_bf16(pa2, PKV(l2, h2), od, 0, 0, 0);
  od = __builtin_amdgcn_mfma_f32_32x32x16_bf16(pa3, PKV(l3, h3), od, 0, 0, 0);
#undef PKV
}
__device__ __forceinline__ void pv_d0(f32x16* o, int vb, bf16x8 pa0, bf16x8 pa1, bf16x8 pa2, bf16x8 pa3) {
  pv_one<0>(o[0], vb, pa0, pa1, pa2, pa3); pv_one<1>(o[1], vb, pa0, pa1, pa2, pa3); pv_one<2>(o[2], vb, pa0, pa1, pa2, pa3); pv_one<3>(o[3], vb, pa0, pa1, pa2, pa3);
}
__device__ __forceinline__ void ostore(float* p, float v) { *p = v; }
__device__ __forceinline__ void ostore(u16* p, float v) { *p = f2bf(v); }

template <int DK, int SD, int LDQ, int LDK, int LDV, int LDO, typename TO>
__device__ __forceinline__ void attn_body(const u16* __restrict__ Qb, const u16* __restrict__ Kh, const u16* __restrict__ Vh,
                                          TO* __restrict__ Ob, int seq, char* lds) {
  const int TIDX = opaque_tid();
  constexpr int SHM_V = AC<DK>::SHM_V, SHM_K = AC<DK>::SHM_K, NKG = AC<DK>::NKG, KG = DK / 8;
  const int tid = TIDX, wid = tid >> 6, lane = tid & 63, r32 = lane & 31, hi = lane >> 5;
  char* V_lds = lds; char* K_lds = lds + 2 * SHM_V;
  float* wsl = (float*)(lds + 2 * SHM_V + 2 * SHM_K) + wid * 64; float* li_l = wsl; float* al_l = wsl + 32;
  float m_reg = -1e30f, l_reg = 0; f32x16 o[4] = {}; bf16x8 qr[DK / 16];
  const u16* Qw = Qb + (long)(wid * 32 + r32) * LDQ + hi * 8;
#pragma unroll
  for (int d0 = 0; d0 < DK / 16; ++d0) qr[d0] = *reinterpret_cast<const bf16x8*>(Qw + d0 * 16);
  const int sr = tid >> 4, sc = (tid & 15) * 8, vst0 = v_st(sr, sc), vst1 = v_st(32 + sr, sc);
  const int vb0 = (int)(uintptr_t)V_lds + v_rd_base(lane);
  struct { bf16x8 vs0, vs1, ks[NKG]; } sr_[SD];
#define SLOAD(i, k0) do { sr_[i].vs0 = *reinterpret_cast<const bf16x8*>(&Vh[(long)((k0) + sr) * LDV + sc]); \
    sr_[i].vs1 = *reinterpret_cast<const bf16x8*>(&Vh[(long)((k0) + 32 + sr) * LDV + sc]); \
    _Pragma("unroll") for (int g_ = 0; g_ < NKG; ++g_) { const int gi_ = tid + 512 * g_; const int kr_ = gi_ / KG, kc_ = (gi_ % KG) * 8; \
      sr_[i].ks[g_] = *reinterpret_cast<const bf16x8*>(&Kh[(long)((k0) + kr_) * LDK + kc_]); } } while (0)
#define SWRITE(b, i) do { *(bf16x8*)(V_lds + (b) * SHM_V + vst0) = sr_[i].vs0; *(bf16x8*)(V_lds + (b) * SHM_V + vst1) = sr_[i].vs1; \
    _Pragma("unroll") for (int g_ = 0; g_ < NKG; ++g_) { const int gi_ = tid + 512 * g_; const int kr_ = gi_ / KG, kc_ = (gi_ % KG) * 16; \
      *(bf16x8*)(K_lds + (b) * SHM_K + kr_ * (DK * 2) + (kc_ ^ ((kr_ & 7) << 4))) = sr_[i].ks[g_]; } } while (0)
#define SWAIT() do { if constexpr (SD == 2) { if constexpr (NKG == 1) asm volatile("s_waitcnt vmcnt(3)" ::: "memory"); else asm volatile("s_waitcnt vmcnt(5)" ::: "memory"); } \
    else asm volatile("s_waitcnt vmcnt(0)" ::: "memory"); } while (0)
#define RESC(a) do { if (__any((a) < 1.f)) { if (hi == 0) al_l[r32] = (a); asm volatile("s_waitcnt lgkmcnt(0)" ::: "memory"); \
    _Pragma("unroll") for (int d = 0; d < 4; ++d) _Pragma("unroll") for (int r = 0; r < 16; ++r) o[d][r] *= al_l[crow(r, hi)]; } } while (0)
  f32x16 pA0, pA1, pB0, pB1; float mnA, mnB, alA, alB; bf16x8 pa0, pa1, pa2, pa3; const int NT = seq / 64;
  constexpr int SE = 0, SO = SD - 1;
  SLOAD(SE, 0); asm volatile("s_waitcnt vmcnt(0)" ::: "memory"); SWRITE(0, SE); __syncthreads();
  qkt<DK>(pA0, pA1, K_lds, qr, r32, hi); partialSM<DK>(pA0, pA1, m_reg, mnA, alA);
  SLOAD(SO, 64); if constexpr (SD == 2) { if (2 < NT) SLOAD(SE, 2 * 64); }
  SWAIT(); SWRITE(1, SO); __syncthreads();
  for (int j = 1; j + 1 < NT; j += 2) {
    SBAR(); qkt<DK>(pB0, pB1, K_lds + SHM_K, qr, r32, hi);
    finishSM(pA0, pA1, alA, l_reg, pa0, pa1, pa2, pa3); SBAR();
    SLOAD(SO, (j + SD) * 64); SBAR();
    pv_d0(o, vb0, pa0, pa1, pa2, pa3); partialSM<DK>(pB0, pB1, m_reg, mnB, alB);
    __syncthreads(); SWAIT(); SWRITE(0, SE);
    RESC(alB); __syncthreads();
    SBAR(); qkt<DK>(pA0, pA1, K_lds, qr, r32, hi);
    finishSM(pB0, pB1, alB, l_reg, pa0, pa1, pa2, pa3); SBAR();
    if (SD == 1 || j + 3 < NT) SLOAD(SE, (j + 1 + SD) * 64); SBAR();
    pv_d0(o, vb0 + SHM_V, pa0, pa1, pa2, pa3); partialSM<DK>(pA0, pA1, m_reg, mnA, alA);
    __syncthreads(); SWAIT(); SWRITE(1, SO);
    RESC(alA); __syncthreads();
  }
  SBAR(); qkt<DK>(pB0, pB1, K_lds + SHM_K, qr, r32, hi);
  finishSM(pA0, pA1, alA, l_reg, pa0, pa1, pa2, pa3); SBAR();
  pv_d0(o, vb0, pa0, pa1, pa2, pa3); partialSM<DK>(pB0, pB1, m_reg, mnB, alB);
  __syncthreads(); RESC(alB);
  finishSM(pB0, pB1, alB, l_reg, pa0, pa1, pa2, pa3); SBAR();
  pv_d0(o, vb0 + SHM_V, pa0, pa1, pa2, pa3);
  if (hi == 0) li_l[r32] = l_reg; asm volatile("s_waitcnt lgkmcnt(0)" ::: "memory");
  float rli[16];
#pragma unroll
  for (int r = 0; r < 16; ++r) rli[r] = __builtin_amdgcn_rcpf(li_l[crow(r, hi)]);
  TO* Ow = Ob + (long)(wid * 32) * LDO;
#pragma unroll
  for (int r = 0; r < 16; ++r) { const int orow = crow(r, hi);
#pragma unroll
    for (int d0 = 0; d0 < 4; ++d0) ostore(&Ow[(long)orow * LDO + d0 * 32 + r32], o[d0][r] * rli[r]); }
#undef SLOAD
#undef SWRITE
#undef SWAIT
#undef RESC
}

template <int DK, int LDQ, int LDK, int LDV, int LDO, typename TO>
__device__ __forceinline__ void attn_body_simple(const u16* __restrict__ Qb, const u16* __restrict__ Kh, const u16* __restrict__ Vh,
                                                 TO* __restrict__ Ob, int seq, char* lds) {
  const int TIDX = opaque_tid();
  constexpr int SHM_V = AC<DK>::SHM_V, SHM_K = AC<DK>::SHM_K, NKG = AC<DK>::NKG, KG = DK / 8;
  const int tid = TIDX, wid = tid >> 6, lane = tid & 63, r32 = lane & 31, hi = lane >> 5;
  char* V_lds = lds; char* K_lds = lds + 2 * SHM_V;
  float* wsl = (float*)(lds + 2 * SHM_V + 2 * SHM_K) + wid * 64; float* li_l = wsl; float* al_l = wsl + 32;
  float m_reg = -1e30f, l_reg = 0; f32x16 o[4] = {}; bf16x8 qr[DK / 16];
  const u16* Qw = Qb + (long)(wid * 32 + r32) * LDQ + hi * 8;
#pragma unroll
  for (int d0 = 0; d0 < DK / 16; ++d0) qr[d0] = *reinterpret_cast<const bf16x8*>(Qw + d0 * 16);
  const int sr = tid >> 4, sc = (tid & 15) * 8, vst0 = v_st(sr, sc), vst1 = v_st(32 + sr, sc);
  const int vb0 = (int)(uintptr_t)V_lds + v_rd_base(lane);
  bf16x8 vs0, vs1, ks[NKG];
#define SLOAD(k0) do { vs0 = *reinterpret_cast<const bf16x8*>(&Vh[(long)((k0) + sr) * LDV + sc]); \
    vs1 = *reinterpret_cast<const bf16x8*>(&Vh[(long)((k0) + 32 + sr) * LDV + sc]); \
    _Pragma("unroll") for (int g_ = 0; g_ < NKG; ++g_) { const int gi_ = tid + 512 * g_; const int kr_ = gi_ / KG, kc_ = (gi_ % KG) * 8; \
      ks[g_] = *reinterpret_cast<const bf16x8*>(&Kh[(long)((k0) + kr_) * LDK + kc_]); } } while (0)
#define SWRITE(b) do { *(bf16x8*)(V_lds + (b) * SHM_V + vst0) = vs0; *(bf16x8*)(V_lds + (b) * SHM_V + vst1) = vs1; \
    _Pragma("unroll") for (int g_ = 0; g_ < NKG; ++g_) { const int gi_ = tid + 512 * g_; const int kr_ = gi_ / KG, kc_ = (gi_ % KG) * 16; \
      *(bf16x8*)(K_lds + (b) * SHM_K + kr_ * (DK * 2) + (kc_ ^ ((kr_ & 7) << 4))) = ks[g_]; } } while (0)
  const int NT = seq / 64;
  SLOAD(0); SWRITE(0); __syncthreads();
#pragma unroll 1
  for (int j = 0; j < NT; ++j) {
    const int cur = j & 1;
    if (j + 1 < NT) SLOAD((j + 1) * 64);
    f32x16 p0, p1; float mn, al; bf16x8 pa0, pa1, pa2, pa3;
    qkt<DK>(p0, p1, K_lds + cur * SHM_K, qr, r32, hi);
    partialSM<DK>(p0, p1, m_reg, mn, al);
    if (__any(al < 1.f)) { if (hi == 0) al_l[r32] = al; asm volatile("s_waitcnt lgkmcnt(0)" ::: "memory");
#pragma unroll
      for (int d = 0; d < 4; ++d)
#pragma unroll
        for (int r = 0; r < 16; ++r) o[d][r] *= al_l[crow(r, hi)]; }
    finishSM(p0, p1, al, l_reg, pa0, pa1, pa2, pa3); SBAR();
    pv_d0(o, vb0 + cur * SHM_V, pa0, pa1, pa2, pa3);
    if (j + 1 < NT) SWRITE(cur ^ 1);
    __syncthreads();
  }
  if (hi == 0) li_l[r32] = l_reg; asm volatile("s_waitcnt lgkmcnt(0)" ::: "memory");
  float rli[16];
#pragma unroll
  for (int r = 0; r < 16; ++r) rli[r] = __builtin_amdgcn_rcpf(li_l[crow(r, hi)]);
  TO* Ow = Ob + (long)(wid * 32) * LDO;
#pragma unroll
  for (int r = 0; r < 16; ++r) { const int orow = crow(r, hi);
#pragma unroll
    for (int d0 = 0; d0 < 4; ++d0) ostore(&Ow[(long)orow * LDO + d0 * 32 + r32], o[d0][r] * rli[r]); }
#undef SLOAD
#undef SWRITE
}

__device__ __forceinline__ void rwkv_item(const P& p, int l, int item, char* lds) {
  const int TIDX = opaque_tid();
  char* ws = p.ws;
  const int d = item & 1, b = (item >> 1) & 3, h = item >> 3;
  constexpr int CM = 16, REC = 584, BUF = CM * REC, NCH = S / (2 * CM), OFF_SC = 448, OFF_D = 456;
  float* buf0 = (float*)lds; float* buf1 = buf0 + BUF; float* yout = buf1 + BUF;
  const int tid = TIDX, wid = tid >> 6, lane = tid & 63;
  const bool consumer = wid < 4;
  const u16* RR = (const u16*)(ws + RW_R); const u16* RK = (const u16*)(ws + RW_K); const u16* RV = (const u16*)(ws + RW_V); const u16* RKK = (const u16*)(ws + RW_KK);
  const u16* RA = (const u16*)(ws + RW_A) + (long)d * T * 512; const u16* RE = (const u16*)(ws + RW_E) + (long)d * T * 512;
  u16* YR = (u16*)(ws + OO_YR) + (long)d * T * 512;
  const int sg = wid & 3;
  struct PR { uint2 r[2], k[2], v[2], kk[2], a[2], e[2]; };
  const int pm = sg * 4 + (lane >> 4), pk0 = (lane & 15) * 4;
  const F4 ka4 = ld4f(p.in[I_KA] + l * 512 + h * 64 + pk0);
  auto pload = [&](int c) {
    PR x;
#pragma unroll
    for (int q = 0; q < 2; ++q) {
      const int sidx = c * (2 * CM) + pm * 2 + q, t = d ? (S - 1 - sidx) : sidx;
      const long off = ((long)(b * S + t)) * 512 + h * 64 + pk0;
      x.r[q] = *reinterpret_cast<const uint2*>(RR + off); x.k[q] = *reinterpret_cast<const uint2*>(RK + off); x.v[q] = *reinterpret_cast<const uint2*>(RV + off);
      x.kk[q] = *reinterpret_cast<const uint2*>(RKK + off); x.a[q] = *reinterpret_cast<const uint2*>(RA + off); x.e[q] = *reinterpret_cast<const uint2*>(RE + off);
    }
    return x;
  };
  auto unp = [](const uint2& u, int j) { const unsigned w = (j < 2) ? u.x : u.y; return (j & 1) ? __uint_as_float(w & 0xffff0000u) : __uint_as_float(w << 16); };
  auto pfinish = [&](const PR& x, float* buf) {
    float* rec = buf + pm * REC;
    f32x4 ww, bw, kw, b2v, k2v, v1v, v2v; float d1[4], d2[4], d3[4], d4[4];
    float c1 = 0.f, c2 = 0.f, c3 = 0.f, c4 = 0.f, c5 = 0.f, c6 = 0.f, c7 = 0.f, c8 = 0.f;
#pragma unroll
    for (int j = 0; j < 4; ++j) {
      const float r1 = unp(x.r[0], j), k1r = unp(x.k[0], j), v1 = unp(x.v[0], j), kk1 = unp(x.kk[0], j), a1 = unp(x.a[0], j), e1 = unp(x.e[0], j);
      const float r2 = unp(x.r[1], j), k2r = unp(x.k[1], j), v2 = unp(x.v[1], j), kk2 = unp(x.kk[1], j), a2 = unp(x.a[1], j), e2 = unp(x.e[1], j);
      const float w1 = __expf(-e1), w2 = __expf(-e2);
      const float z1 = -kk1, z2 = -kk2, b1 = kk1 * a1, b2 = kk2 * a2;
      const float k1 = k1r * (1.f + (a1 - 1.f) * ka4.v[j]), k2 = k2r * (1.f + (a2 - 1.f) * ka4.v[j]);
      const float w2r2 = w2 * r2;
      ww[j] = w1 * w2; bw[j] = b1 * w2; kw[j] = k1 * w2; b2v[j] = b2; k2v[j] = k2; v1v[j] = v1; v2v[j] = v2;
      d1[j] = z1; d2[j] = w1 * z2; d3[j] = w1 * r1; d4[j] = w1 * w2r2;
      c1 += b1 * z2; c2 += k1 * z2; c3 += b1 * r1; c4 += k1 * r1; c5 += b1 * w2r2; c6 += k1 * w2r2; c7 += b2 * r2; c8 += k2 * r2;
    }
    *reinterpret_cast<f32x4*>(rec + pk0) = ww;        *reinterpret_cast<f32x4*>(rec + 64 + pk0) = bw;   *reinterpret_cast<f32x4*>(rec + 128 + pk0) = kw;
    *reinterpret_cast<f32x4*>(rec + 192 + pk0) = b2v; *reinterpret_cast<f32x4*>(rec + 256 + pk0) = k2v;
    *reinterpret_cast<f32x4*>(rec + 320 + pk0) = v1v; *reinterpret_cast<f32x4*>(rec + 384 + pk0) = v2v;
    { uint2 q;
      q.x = cvtpk(d1[0], d1[1]); q.y = cvtpk(d1[2], d1[3]); *reinterpret_cast<uint2*>(rec + OFF_D + 0 * 32 + (lane & 15) * 2) = q;
      q.x = cvtpk(d2[0], d2[1]); q.y = cvtpk(d2[2], d2[3]); *reinterpret_cast<uint2*>(rec + OFF_D + 1 * 32 + (lane & 15) * 2) = q;
      q.x = cvtpk(d3[0], d3[1]); q.y = cvtpk(d3[2], d3[3]); *reinterpret_cast<uint2*>(rec + OFF_D + 2 * 32 + (lane & 15) * 2) = q;
      q.x = cvtpk(d4[0], d4[1]); q.y = cvtpk(d4[2], d4[3]); *reinterpret_cast<uint2*>(rec + OFF_D + 3 * 32 + (lane & 15) * 2) = q; }
    c1 = grp16sum(c1); c2 = grp16sum(c2); c3 = grp16sum(c3); c4 = grp16sum(c4); c5 = grp16sum(c5); c6 = grp16sum(c6); c7 = grp16sum(c7); c8 = grp16sum(c8);
    if ((lane & 15) == 0) { *reinterpret_cast<f32x4*>(rec + OFF_SC) = f32x4{c1, c2, c3, c4}; *reinterpret_cast<f32x4*>(rec + OFF_SC + 4) = f32x4{c5, c6, c7, c8}; }
  };
  auto store_y = [&](int c) {
    const float* yo = yout + (c & 1) * (32 * 64);
#pragma unroll
    for (int i = 0; i < 8; ++i) {
      const int s = sg + 4 * i, sidx = c * 32 + s, t = d ? (S - 1 - sidx) : sidx;
      YR[((long)(b * S + t)) * 512 + h * 64 + lane] = f2bf(yo[s * 64 + lane]);
    }
  };
  const int j16 = lane & 15, g = lane >> 4, row = (wid & 3) * 16 + j16;
  const int aoff = OFF_D + (j16 & 3) * 32;
  f2 st[8];
#pragma unroll
  for (int i = 0; i < 8; ++i) st[i] = f2{0.f, 0.f};
  struct Ops { bf16x8 a0, a1; f2 v; f32x4 s0, s1; };
  auto ldops = [&](const float* rec) {
    Ops o;
    o.a0 = *reinterpret_cast<const bf16x8*>(rec + aoff + g * 4);
    o.a1 = *reinterpret_cast<const bf16x8*>(rec + aoff + 16 + g * 4);
    o.v = f2{rec[320 + row], rec[384 + row]};
    o.s0 = *reinterpret_cast<const f32x4*>(rec + OFF_SC); o.s1 = *reinterpret_cast<const f32x4*>(rec + OFF_SC + 4);
    return o;
  };
  PR pnx;
  if (!consumer) { PR p0 = pload(0); pfinish(p0, buf0); pnx = pload(1); }
  __syncthreads();
  for (int c = 0; c < NCH; ++c) {
    float* buf = (c & 1) ? buf1 : buf0;
    if (consumer) {
      float* yo = yout + (c & 1) * (32 * 64);
      auto step = [&](const Ops& cur, int ms) {
        const float* rec = buf + ms * REC;
        f32x4 ww[4], bw[4], kw[4], b2[4], k2[4];
#pragma unroll
        for (int m = 0; m < 2; ++m)
#pragma unroll
          for (int hq = 0; hq < 2; ++hq) {
            const int o = m * 32 + g * 8 + hq * 4;
            ww[m * 2 + hq] = *reinterpret_cast<const f32x4*>(rec + o);        bw[m * 2 + hq] = *reinterpret_cast<const f32x4*>(rec + 64 + o);
            kw[m * 2 + hq] = *reinterpret_cast<const f32x4*>(rec + 128 + o);  b2[m * 2 + hq] = *reinterpret_cast<const f32x4*>(rec + 192 + o);
            k2[m * 2 + hq] = *reinterpret_cast<const f32x4*>(rec + 256 + o);
          }
        u32x4 q0, q1;
        q0[0] = cvtpk(st[0][0], st[0][1]); q0[1] = cvtpk(st[1][0], st[1][1]); q0[2] = cvtpk(st[2][0], st[2][1]); q0[3] = cvtpk(st[3][0], st[3][1]);
        q1[0] = cvtpk(st[4][0], st[4][1]); q1[1] = cvtpk(st[5][0], st[5][1]); q1[2] = cvtpk(st[6][0], st[6][1]); q1[3] = cvtpk(st[7][0], st[7][1]);
        f32x4 dd = f32x4{0.f, 0.f, 0.f, 0.f};
        dd = __builtin_amdgcn_mfma_f32_16x16x32_bf16(cur.a0, __builtin_bit_cast(bf16x8, q0), dd, 0, 0, 0);
        dd = __builtin_amdgcn_mfma_f32_16x16x32_bf16(cur.a1, __builtin_bit_cast(bf16x8, q1), dd, 0, 0, 0);
        const float v1 = cur.v[0], v2 = cur.v[1];
        const float sa1 = dd[0];
        const float sa2 = dd[1] + sa1 * cur.s0[0] + v1 * cur.s0[1];
        const float y1 = dd[2] + sa1 * cur.s0[2] + v1 * cur.s0[3];
        const float y2 = dd[3] + sa1 * cur.s1[0] + v1 * cur.s1[1] + sa2 * cur.s1[2] + v2 * cur.s1[3];
        const f2 sa1v = f2{sa1, sa1}, v1v = f2{v1, v1}, sa2v = f2{sa2, sa2}, v2v = f2{v2, v2};
#pragma unroll
        for (int q = 0; q < 4; ++q) {
#pragma unroll
          for (int hh = 0; hh < 2; ++hh) {
            const f2 w_ = f2{ww[q][2 * hh], ww[q][2 * hh + 1]}, bw_ = f2{bw[q][2 * hh], bw[q][2 * hh + 1]}, kw_ = f2{kw[q][2 * hh], kw[q][2 * hh + 1]};
            const f2 b2_ = f2{b2[q][2 * hh], b2[q][2 * hh + 1]}, k2_ = f2{k2[q][2 * hh], k2[q][2 * hh + 1]};
            st[q * 2 + hh] = st[q * 2 + hh] * w_ + ((sa1v * bw_ + v1v * kw_) + (sa2v * b2_ + v2v * k2_));
          }
        }
        if (g == 0) { yo[(2 * ms) * 64 + row] = y1; yo[(2 * ms + 1) * 64 + row] = y2; }
      };
      Ops oa = ldops(buf);
#pragma unroll 1
      for (int ms = 0; ms < CM; ms += 2) {
        const Ops ob = ldops(buf + (ms + 1) * REC);
        step(oa, ms);
        if (ms + 2 < CM) oa = ldops(buf + (ms + 2) * REC);
        step(ob, ms + 1);
      }
    } else {
      if (c + 1 < NCH) { pfinish(pnx, (c & 1) ? buf0 : buf1); if (c + 2 < NCH) pnx = pload(c + 2); }
      if (c >= 1) store_y(c - 1);
    }
    __syncthreads();
  }
  if (!consumer) store_y(NCH - 1);
  __syncthreads();
}

__device__ __forceinline__ bf16x8 pad8(s16x4 v) { return bf16x8{v[0], v[1], v[2], v[3], 0, 0, 0, 0}; }
__device__ __forceinline__ void cmul(float ar, float ai, float br, float bi, float& cr, float& ci) { cr = ar * br - ai * bi; ci = ar * bi + ai * br; }
__device__ __forceinline__ void s5_item(const P& p, int l, int item, char* lds) {
  const int TIDX = opaque_tid();
  char* ws = p.ws;
  const int d = item & 1, g = (item >> 1) & 31, b = item >> 6;
  const int tid = TIDX, wv = tid >> 6, lane = tid & 63, jj = lane & 15, gq = lane >> 4;
  const long pg = ((long)(l * 2 + d) * 32 + g);
  const float* lre = p.in[I_LRE] + pg * 64; const float* lim = p.in[I_LIM] + pg * 64;
  const float dt = __expf(p.in[I_LDT][pg]);
  const float* bre = p.in[I_BRE] + pg * 64 * 16; const float* bim = p.in[I_BIM] + pg * 64 * 16;
  const float* cre = p.in[I_CRE] + pg * 16 * 64; const float* cim = p.in[I_CIM] + pg * 16 * 64;
  const u16* PB = (const u16*)(ws + O_P);
  u16* YS = (u16*)(ws + OO_YS) + (long)d * T * 512;
  float ar[16], ai[16];
  s16x4 Bop[8], Cop[8];
#pragma unroll
  for (int tl = 0; tl < 8; ++tl) {
#pragma unroll
    for (int e = 0; e < 2; ++e) {
      const int stt = tl * 8 + gq * 2 + e;
      const float lr = fminf(lre[stt], -1e-4f), li = lim[stt];
      const float mag = __expf(lr * dt); float sn, cs; sincos_rev(li * dt, sn, cs);
      ar[tl * 2 + e] = mag * cs; ai[tl * 2 + e] = mag * sn;
    }
    {
      const int i = lane & 15; const int stt = tl * 8 + (i >> 2) * 2 + (i & 1), part = (i >> 1) & 1;
      const float lr = fminf(lre[stt], -1e-4f), li = lim[stt];
      const float mag = __expf(lr * dt); float sn, cs; sincos_rev(li * dt, sn, cs);
      const float abr = mag * cs, abi = mag * sn, den = lr * lr + li * li;
      const float cor = ((abr - 1.f) * lr + abi * li) / den, coi = (abi * lr - (abr - 1.f) * li) / den;
      float vals[4];
#pragma unroll
      for (int c = 0; c < 4; ++c) {
        const float br_ = bre[stt * 16 + gq * 4 + c], bi_ = bim[stt * 16 + gq * 4 + c];
        vals[c] = part ? (cor * bi_ + coi * br_) : (cor * br_ - coi * bi_);
      }
      Bop[tl] = s16x4{(short)f2bf(vals[0]), (short)f2bf(vals[1]), (short)f2bf(vals[2]), (short)f2bf(vals[3])};
      float cv[4];
#pragma unroll
      for (int j = 0; j < 4; ++j) {
        const int st2 = tl * 8 + gq * 2 + (j & 1);
        cv[j] = (j >> 1) ? -cim[i * 64 + st2] : cre[i * 64 + st2];
      }
      Cop[tl] = s16x4{(short)f2bf(cv[0]), (short)f2bf(cv[1]), (short)f2bf(cv[2]), (short)f2bf(cv[3])};
    }
  }
  int bad_ = 9999;
#define UPD(v, code, th) do { } while (0)
#pragma unroll
  for (int k = 0; k < 16; ++k) { UPD(ar[k] * ar[k] + ai[k] * ai[k], 30, 1.0f); }
#pragma unroll
  for (int tl = 0; tl < 8; ++tl)
#pragma unroll
    for (int c = 0; c < 4; ++c) { UPD(bf2f((u16)Bop[tl][c]), 31, 2.f); UPD(bf2f((u16)Cop[tl][c]), 32, 2.f); }
  float* aval = (float*)lds + 1024 + 32 * 512;
  if (wv == 0 && jj == 0) {
#pragma unroll
    for (int tl = 0; tl < 8; ++tl)
#pragma unroll
      for (int e = 0; e < 2; ++e) { const int stt = tl * 8 + gq * 2 + e; aval[stt * 2] = ar[tl * 2 + e]; aval[stt * 2 + 1] = ai[tl * 2 + e]; }
  }
  const int chunk = wv * 16 + jj;
  const long pcol = C_S5U + g * 16 + gq * 4;
  f32x4 x[8];
#pragma unroll
  for (int tl = 0; tl < 8; ++tl) x[tl] = f32x4{0.f, 0.f, 0.f, 0.f};
  auto tok_of = [&](int stp) { const int sidx = chunk * 32 + stp; const int t = d ? (S - 1 - sidx) : sidx; return (long)(b * S + t); };
  auto step_state = [&](s16x4 uf) {
#pragma unroll
    for (int tl = 0; tl < 8; ++tl) {
      const float xr0 = x[tl][0], xr1 = x[tl][1], xi0 = x[tl][2], xi1 = x[tl][3];
      f32x4 nx;
      nx[0] = ar[tl * 2] * xr0 - ai[tl * 2] * xi0; nx[2] = ar[tl * 2] * xi0 + ai[tl * 2] * xr0;
      nx[1] = ar[tl * 2 + 1] * xr1 - ai[tl * 2 + 1] * xi1; nx[3] = ar[tl * 2 + 1] * xi1 + ai[tl * 2 + 1] * xr1;
      x[tl] = __builtin_amdgcn_mfma_f32_16x16x16bf16_1k(Bop[tl], uf, nx, 0, 0, 0);
    }
  };
  {
    s16x4 ua[8], ub[8];
#pragma unroll
    for (int i = 0; i < 8; ++i) ua[i] = *reinterpret_cast<const s16x4*>(PB + tok_of(i) * NP + pcol);
#pragma unroll 1
    for (int g8 = 0; g8 < 4; g8 += 2) {
#pragma unroll
      for (int i = 0; i < 8; ++i) ub[i] = *reinterpret_cast<const s16x4*>(PB + tok_of((g8 + 1) * 8 + i) * NP + pcol);
#pragma unroll
      for (int i = 0; i < 8; ++i) step_state(ua[i]);
      if (g8 + 2 < 4) {
#pragma unroll
        for (int i = 0; i < 8; ++i) ua[i] = *reinterpret_cast<const s16x4*>(PB + tok_of((g8 + 2) * 8 + i) * NP + pcol);
      }
#pragma unroll
      for (int i = 0; i < 8; ++i) step_state(ub[i]);
    }
  }
#pragma unroll
  for (int tl = 0; tl < 8; ++tl)
#pragma unroll
    for (int r = 0; r < 4; ++r) UPD(x[tl][r], 34, 50.f);
  __syncthreads();
  float* tot = (float*)lds;
  float* xs = (float*)lds + 1024;
#pragma unroll
  for (int tl = 0; tl < 8; ++tl)
#pragma unroll
    for (int r = 0; r < 4; ++r) xs[(tl * 4 + r) * 512 + tid] = x[tl][r];
#pragma unroll 1
  for (int tl = 0; tl < 8; ++tl) {
#pragma unroll
    for (int e = 0; e < 2; ++e) {
      const int stt = tl * 8 + gq * 2 + e;
      float pr_ = aval[stt * 2], pi_ = aval[stt * 2 + 1];
#pragma unroll
      for (int sq = 0; sq < 5; ++sq) { float nr, ni; cmul(pr_, pi_, pr_, pi_, nr, ni); pr_ = nr; pi_ = ni; }
      float xr = xs[(tl * 4 + e) * 512 + tid], xi = xs[(tl * 4 + 2 + e) * 512 + tid];
#pragma unroll
      for (int stg = 0; stg < 4; ++stg) {
        const int off = 1 << stg;
        const float or_ = __shfl_up(xr, off, 16), oi_ = __shfl_up(xi, off, 16);
        if (jj >= off) { float cr, ci; cmul(pr_, pi_, or_, oi_, cr, ci); xr += cr; xi += ci; }
        float nr, ni; cmul(pr_, pi_, pr_, pi_, nr, ni); pr_ = nr; pi_ = ni;
      }
      xs[(tl * 4 + e) * 512 + tid] = xr; xs[(tl * 4 + 2 + e) * 512 + tid] = xi;
      if (jj == 15) { float* tp = tot + (wv * 4 + gq) * 32 + tl * 4; tp[e] = xr; tp[2 + e] = xi; }
      UPD(xr, 35, 200.f); UPD(xi, 35, 200.f);
    }
  }
  __syncthreads();
#pragma unroll 1
  for (int tl = 0; tl < 8; ++tl) {
#pragma unroll
    for (int e = 0; e < 2; ++e) {
      const int stt = tl * 8 + gq * 2 + e;
      float pr_ = aval[stt * 2], pi_ = aval[stt * 2 + 1];
#pragma unroll
      for (int sq = 0; sq < 5; ++sq) { float nr, ni; cmul(pr_, pi_, pr_, pi_, nr, ni); pr_ = nr; pi_ = ni; }
      float qr_ = 1.f, qi_ = 0.f;
#pragma unroll
      for (int stg = 0; stg < 4; ++stg) {
        if (jj & (1 << stg)) { float cr, ci; cmul(qr_, qi_, pr_, pi_, cr, ci); qr_ = cr; qi_ = ci; }
        float nr, ni; cmul(pr_, pi_, pr_, pi_, nr, ni); pr_ = nr; pi_ = ni;
      }
      float Wr = 0.f, Wi = 0.f;
      for (int w2 = 0; w2 < wv; ++w2) {
        const float* tp = tot + (w2 * 4 + gq) * 32 + tl * 4;
        float cr, ci; cmul(pr_, pi_, Wr, Wi, cr, ci); Wr = cr + tp[e]; Wi = ci + tp[2 + e];
      }
      const float xr = xs[(tl * 4 + e) * 512 + tid], xi = xs[(tl * 4 + 2 + e) * 512 + tid];
      float er = __shfl_up(xr, 1, 16), ei = __shfl_up(xi, 1, 16);
      if (jj == 0) { er = 0.f; ei = 0.f; }
      float cr, ci; cmul(qr_, qi_, Wr, Wi, cr, ci);
      UPD(Wr, 36, 500.f); UPD(Wi, 36, 500.f); UPD(er + cr, 37, 500.f); UPD(ei + ci, 37, 500.f);
      xs[(tl * 4 + e) * 512 + tid] = er + cr; xs[(tl * 4 + 2 + e) * 512 + tid] = ei + ci;
    }
  }
#pragma unroll
  for (int tl = 0; tl < 8; ++tl)
#pragma unroll
    for (int r = 0; r < 4; ++r) x[tl][r] = xs[(tl * 4 + r) * 512 + tid];
  __syncthreads();
#pragma unroll 1
  for (int g8 = 0; g8 < 4; ++g8) {
    s16x4 uf[8];
#pragma unroll
    for (int i = 0; i < 8; ++i) uf[i] = *reinterpret_cast<const s16x4*>(PB + tok_of(g8 * 8 + i) * NP + pcol);
#pragma unroll
    for (int i = 0; i < 8; ++i) {
      step_state(uf[i]);
      f32x4 y = f32x4{0.f, 0.f, 0.f, 0.f};
#pragma unroll
      for (int tl = 0; tl < 8; ++tl) {
        const unsigned lo = cvtpk(x[tl][0], x[tl][1]), hi2 = cvtpk(x[tl][2], x[tl][3]);
        const s16x4 xb = s16x4{(short)(lo & 0xffffu), (short)(lo >> 16), (short)(hi2 & 0xffffu), (short)(hi2 >> 16)};
        y = __builtin_amdgcn_mfma_f32_16x16x16bf16_1k(Cop[tl], xb, y, 0, 0, 0);
      }
#pragma unroll
      for (int tl = 0; tl < 8; ++tl) { UPD(x[tl][0], 38, 500.f); UPD(x[tl][1], 38, 500.f); UPD(x[tl][2], 38, 500.f); UPD(x[tl][3], 38, 500.f); }
      UPD(y[0], 39, 100.f); UPD(y[1], 39, 100.f); UPD(y[2], 39, 100.f); UPD(y[3], 39, 100.f);
      uint2 oo; oo.x = cvtpk(y[0], y[1]); oo.y = cvtpk(y[2], y[3]);
      *reinterpret_cast<uint2*>(YS + tok_of(g8 * 8 + i) * 512 + g * 16 + gq * 4) = oo;
    }
  }
  (void)bad_;
  __syncthreads();
}

__device__ __forceinline__ void phase5(const P& p, int l, int coff, int tmask = 15) {
  const int TIDX = opaque_tid();
  const int BIDX = opaque_bid();
  char* ws = p.ws;
  __shared__ int s_item;
  int* ctr = (int*)(ws + O_CTR) + l + coff;
  constexpr int N_RW = 64, N_S5 = 256, N_MLA = 256, N_DIFF = 512, N_ALL = N_RW + N_S5 + N_MLA + N_DIFF;
  for (;;) {
    __syncthreads();
    if (TIDX == 0) s_item = atomicAdd(ctr, 1);
    __syncthreads();
    int it = s_item;
    if (it >= N_ALL) break;
    if (it < N_RW) { if (tmask & 1) rwkv_item(p, l, it, smem); continue; }
    it -= N_RW;
    if (it < N_MLA) {
      const int qb = it & 15, hh = (it >> 4) & 3, b = it >> 6;
      const long bh = (long)(b * 4 + hh);
      if (tmask & 4) attn_body_simple<192, 192, 192, 128, 512, u16>((const u16*)(ws + QK_MQ) + (bh * S + qb * 256) * 192, (const u16*)(ws + QK_MK) + bh * S * 192,
                                                 (const u16*)(ws + QK_MV) + bh * S * 128, (u16*)(ws + OO_MO) + ((long)(b * S + qb * 256)) * 512 + hh * 128, S, smem);
      continue;
    }
    it -= N_MLA;
    if (it < N_DIFF) {
      const int qb = it & 15, h2 = (it >> 4) & 7, b = it >> 7;
      const long bh = (long)(b * 8 + h2);
      if (tmask & 8) attn_body<64, 2, 64, 64, NP, 1024, u16>((const u16*)(ws + QK_DQ) + (bh * S + qb * 256) * 64, (const u16*)(ws + QK_DK) + bh * S * 64,
                                                (const u16*)(ws + O_P) + (long)b * S * NP + C_DV + (h2 >> 1) * 128,
                                                (u16*)(ws + OO_DO) + ((long)(b * S + qb * 256)) * 1024 + h2 * 128, S, smem);
      continue;
    }
    it -= N_DIFF;
    if (tmask & 2) s5_item(p, l, it, smem);
  }
}

__device__ __forceinline__ void phase6(const P& p, int l) {
  const int TIDX = opaque_tid();
  const int BIDX = opaque_bid();
  char* ws = p.ws;
  const u16* __restrict__ PB = (const u16*)(ws + O_P);
  const u16* __restrict__ YS0 = (const u16*)(ws + OO_YS); const u16* __restrict__ YS1 = YS0 + (long)T * 512;
  const u16* __restrict__ YR0 = (const u16*)(ws + OO_YR); const u16* __restrict__ YR1 = YR0 + (long)T * 512;
  const u16* __restrict__ DO_ = (const u16*)(ws + OO_DO); const u16* __restrict__ MO = (const u16*)(ws + OO_MO);
  const u16* __restrict__ RV = (const u16*)(ws + RW_V); const float* __restrict__ BON = (const float*)(ws + RW_BON);
  u16* __restrict__ BR = (u16*)(ws + O_BR); u16* __restrict__ GS5 = (u16*)(ws + O_GS5);
  const int wid = TIDX >> 6, lane = TIDX & 63, c0 = lane * 8;
  const float lam_init = 0.8f - 0.6f * expf(-0.3f * (float)l);
  const float* dl = p.in[I_DLAM] + l * 256;
  const float lam_full = expf(wsum(dl[lane] * dl[64 + lane])) - expf(wsum(dl[128 + lane] * dl[192 + lane])) + lam_init;
  const F8 dsk = ld8f(p.in[I_S5D] + l * 512 + c0);
  const F8 sub = ld8f(p.in[I_SUBLN] + l * 128 + (lane & 15) * 8);
  const F8 lng = ld8f(p.in[I_LNG] + l * 512 + c0), lnb = ld8f(p.in[I_LNB] + l * 512 + c0);
  const int hD = lane >> 4, eD = (lane & 15) * 8;
  for (int t = BIDX * 8 + wid; t < T; t += gridDim.x * 8) {
    const u16* pr = PB + (long)t * NP;
    u16* br = BR + (long)t * 2048;
    const F8 u = ld8bf(pr + C_S5U + c0), ys0 = ld8bf(YS0 + (long)t * 512 + c0), ys1 = ld8bf(YS1 + (long)t * 512 + c0);
    const F8 o1 = ld8bf(DO_ + (long)t * 1024 + (hD * 2) * 128 + eD), o2 = ld8bf(DO_ + (long)t * 1024 + (hD * 2 + 1) * 128 + eD);
    const F8 zd = ld8bf(pr + C_DZ + c0), zm = ld8bf(pr + C_MZ + c0), zr = ld8bf(pr + C_RZ + c0);
    const F8 mo = ld8bf(MO + (long)t * 512 + c0);
    const F8 y0 = ld8bf(YR0 + (long)t * 512 + c0), y1 = ld8bf(YR1 + (long)t * 512 + c0), rv = ld8bf(RV + (long)t * 512 + c0);
    const float bon = BON[(long)t * 8 + (lane >> 3)];
    {
      F8 g;
#pragma unroll
      for (int j = 0; j < 8; ++j) {
        const float y = dsk.v[j] * u.v[j] + ys0.v[j] + ys1.v[j];
        const float uu = 0.7978845608028654f * (y + 0.044715f * y * y * y);
        const float e2 = __expf(2.f * uu); const float th = 1.f - 2.f / (e2 + 1.f);
        g.v[j] = 0.5f * y * (1.f + th);
      }
      st8bf(GS5 + (long)t * 512 + c0, g);
    }
    {
      F8 a; float ss = 0.f;
#pragma unroll
      for (int j = 0; j < 8; ++j) { a.v[j] = o1.v[j] - lam_full * o2.v[j]; ss += a.v[j] * a.v[j]; }
      ss = grp16sum(ss);
      const float sc = rsqrtf(ss * (1.f / 128.f) + 1e-6f) * (1.f - lam_init);
#pragma unroll
      for (int j = 0; j < 8; ++j) a.v[j] = siluf_(zd.v[j]) * a.v[j] * sc * sub.v[j];
      st8bf(br + 512 + c0, a);
    }
    {
      F8 a;
#pragma unroll
      for (int j = 0; j < 8; ++j) a.v[j] = siluf_(zm.v[j]) * mo.v[j];
      st8bf(br + 1024 + c0, a);
    }
    {
      F8 y; float sm = 0.f;
#pragma unroll
      for (int j = 0; j < 8; ++j) { y.v[j] = y0.v[j] + y1.v[j]; sm += y.v[j]; }
      const float mean = grp8sum(sm) * (1.f / 64.f);
      float sv = 0.f;
#pragma unroll
      for (int j = 0; j < 8; ++j) { y.v[j] -= mean; sv += y.v[j] * y.v[j]; }
      const float rs = rsqrtf(grp8sum(sv) * (1.f / 64.f) + 64e-5f);
#pragma unroll
      for (int j = 0; j < 8; ++j) { const float yn = y.v[j] * rs * lng.v[j] + lnb.v[j] + bon * rv.v[j]; y.v[j] = siluf_(zr.v[j]) * yn; }
      st8bf(br + 1536 + c0, y);
    }
  }
}

struct EpiGlu { u16* BR; const u16* GS5; const u16* PB; const float* gb; __device__ __forceinline__ void operator()(int row, int col, f32x4 v0, f32x4 v1) const {
  const f32x4 b0 = *reinterpret_cast<const f32x4*>(gb + col), b1 = *reinterpret_cast<const f32x4*>(gb + col + 4);
  const F8 g = ld8bf(GS5 + (long)row * 512 + col), z = ld8bf(PB + (long)row * NP + C_S5Z + col);
  F8 o;
#pragma unroll
  for (int j = 0; j < 4; ++j) { o.v[j] = siluf_(z.v[j]) * g.v[j] * sigmoidf_(v0[j] + b0[j]); o.v[4 + j] = siluf_(z.v[4 + j]) * g.v[4 + j] * sigmoidf_(v1[j] + b1[j]); }
  st8bf(BR + (long)row * 2048 + col, o); } };
__device__ __forceinline__ void phase7(const P& p, int l) {
  char* ws = p.ws;
  EpiGlu e{(u16*)(ws + O_BR), (const u16*)(ws + O_GS5), (const u16*)(ws + O_P), p.in[I_GLUB] + l * 512};
  fg::gemm_phase<EpiGlu, true>((LAS3 unsigned char*)smem, (const u16*)(ws + O_GS5), 512, (const u16*)(ws + O_GLU), 512, T, 512, 512, e);
}

constexpr size_t O_GATES = O_O;
__device__ __forceinline__ void phase8a(const P& p, int l) {
  char* ws = p.ws;
  EpiGate e{(u16*)(ws + O_GATES), p.in[I_GATEB] + (long)l * 4 * 1024};
  fg::gemm_phase<EpiGate, true>((LAS3 unsigned char*)smem, (const u16*)(ws + O_H), 1024, (const u16*)(ws + O_WIN) + (long)NP * 1024, 1024, T, 4096, 1024, e);
}
__device__ __forceinline__ void phase8(const P& p, int l) {
  const int TIDX = opaque_tid();
  const int BIDX = opaque_bid();
  char* ws = p.ws;
  const u16* BR = (const u16*)(ws + O_BR); u16* M = (u16*)(ws + O_M);
  const u16* WBR = (const u16*)(ws + O_WBR); const u16* GT = (const u16*)(ws + O_GATES);
  for (int ti = BIDX; ti < 8 * 64; ti += gridDim.x) {
    const int nt = ti & 7, mt = ti >> 3; const int m0 = mt * 256, n0 = nt * 128;
    f32x4 tot[4][4]; zero_acc<4>(tot);
#pragma unroll 1
    for (int nb = 0; nb < 4; ++nb) {
      f32x4 ap[4][4]; zero_acc<4>(ap);
      gemm_main<4>(BR + (long)m0 * 2048 + nb * 512, 2048, WBR + ((long)nb * 1024 + n0) * 512, 512, 512, ap, smem);
      EPI_LOOP(4, { tot[i][j][jj] += bf2f(GT[(long)m * 4096 + nb * 1024 + n]) * ap[i][j][jj]; });
    }
    EPI_LOOP(4, { M[(long)m * 1024 + n] = f2bf(tot[i][j][jj]); });
  }
}

__device__ __forceinline__ void phase9(const P& p, int l) {
  char* ws = p.ws;
  EpiOut e{p.out, (l == 0) ? p.in[I_X] : p.out};
  fg::gemm_phase((LAS3 unsigned char*)smem, (const u16*)(ws + O_M), 1024, (const u16*)(ws + O_WOUT), 1024, T, 1024, 1024, e);
}

#define XB_TMO      128
#define XB_XCNT(j)  (256  + 64 * (j))
#define XB_XSUB(j)  (1280 + 64 * (j))
#define XB_XGEN(j)  (2304 + 64 * (j))
#define XB_TOP      3328
#define XB_TOPGEN   3392
#define XB_SPIN_CAP (1u << 18)
__device__ __forceinline__ unsigned xb_ld(unsigned* p) { return __hip_atomic_load(p, __ATOMIC_RELAXED, __HIP_MEMORY_SCOPE_AGENT); }
__device__ __forceinline__ unsigned xb_add(unsigned* p, unsigned v) { return __hip_atomic_fetch_add(p, v, __ATOMIC_RELAXED, __HIP_MEMORY_SCOPE_AGENT); }
__device__ __forceinline__ unsigned xb_xcc_id() { return (unsigned)__builtin_amdgcn_s_getreg((3 << 11) | 20) & 0xFu; }
#define XB_SPIN(cond, bar) do { unsigned _sp = 0; while (cond) { __builtin_amdgcn_s_sleep(1); \
    if ((++_sp & 255u) == 0u) { if (xb_ld(&(bar)[XB_TMO])) break; if (_sp > XB_SPIN_CAP) { atomicAdd(&(bar)[XB_TMO], 1u); break; } } } } while (0)
struct XcdBarrier { unsigned* bar; unsigned x; volatile LAS3 unsigned* st; };
__device__ __forceinline__ XcdBarrier xcd_barrier_post(unsigned* bar, volatile LAS3 unsigned* st) {
  XcdBarrier b; b.bar = bar; b.x = xb_xcc_id(); b.st = st;
  if (threadIdx.x == 0) (void)xb_add(&bar[XB_XCNT(b.x)], 1u);
  return b;
}
__device__ __forceinline__ void xcd_barrier_complete(unsigned* bar, unsigned x, unsigned& nloc, unsigned& nx) {
  const unsigned G = gridDim.x * gridDim.y * gridDim.z;
  unsigned sum, cnt, mine, sp = 0u;
  for (;;) {
    sum = 0u; cnt = 0u; mine = 0u;
#pragma unroll
    for (unsigned j = 0; j < 16; ++j) { const unsigned c = xb_ld(&bar[XB_XCNT(j)]); sum += c; cnt += (c > 0u) ? 1u : 0u; mine = (j == x) ? c : mine; }
    if (sum == G) break;
    __builtin_amdgcn_s_sleep(1);
    if ((++sp & 255u) == 0u) { if (xb_ld(&bar[XB_TMO])) break; if (sp > XB_SPIN_CAP) { atomicAdd(&bar[XB_TMO], 1u); break; } }
  }
  nloc = mine > 0u ? mine : 1u; nx = cnt > 0u ? cnt : 1u;
}
__device__ __forceinline__ void xcd_barrier(const XcdBarrier& b) {
  asm volatile("s_waitcnt vmcnt(0)" ::: "memory");
  __syncthreads();
  if (threadIdx.x == 0) {
    unsigned* bar = b.bar;
    __builtin_amdgcn_s_waitcnt(0);
    unsigned nloc = b.st[0], nx = b.st[1];
    if (nloc == 0u) { xcd_barrier_complete(bar, b.x, nloc, nx); b.st[0] = nloc; b.st[1] = nx; }
    const unsigned old = xb_add(&bar[XB_XSUB(b.x)], 1u);
    const unsigned gen = old / nloc;
    if (old + 1u == (gen + 1u) * nloc) {
      __builtin_amdgcn_fence(__ATOMIC_RELEASE, "agent");
      asm volatile("s_waitcnt vmcnt(0)" ::: "memory");
      const unsigned og = xb_add(&bar[XB_TOP], 1u);
      const unsigned tg = og / nx;
      if (og + 1u == (tg + 1u) * nx) xb_add(&bar[XB_TOPGEN], 1u);
      else XB_SPIN(xb_ld(&bar[XB_TOPGEN]) == tg, bar);
      __builtin_amdgcn_fence(__ATOMIC_ACQUIRE, "agent");
      xb_add(&bar[XB_XGEN(b.x)], 1u);
      asm volatile("s_waitcnt vmcnt(0)" ::: "memory");
    } else {
      XB_SPIN(xb_ld(&bar[XB_XGEN(b.x)]) == gen, bar);
      __builtin_amdgcn_fence(__ATOMIC_ACQUIRE, "agent");
      asm volatile("s_waitcnt vmcnt(0)" ::: "memory");
    }
  }
  __syncthreads();
}

__device__ __forceinline__ void gsync_cg(cg::grid_group& grid) {
  asm volatile("s_waitcnt vmcnt(0) lgkmcnt(0)" ::: "memory");
  grid.sync();
  __builtin_amdgcn_fence(__ATOMIC_ACQUIRE, "agent");
  asm volatile("s_waitcnt vmcnt(0)" ::: "memory");
}
#define gsync(g_) xcd_barrier(xbar)
#ifdef DBG
template <typename TT> __device__ __forceinline__ bool badv(TT v);
template <> __device__ __forceinline__ bool badv<u16>(u16 v) { float f = bf2f(v); return !(fabsf(f) < 1e5f); }
template <> __device__ __forceinline__ bool badv<float>(float f) { return !(fabsf(f) < 1e5f); }
template <typename TT>
__device__ __forceinline__ void chk(const P& p, size_t off, size_t n, int code) {
  const TT* q = (const TT*)(p.ws + off);
  bool bad = false;
  const int TIDX = opaque_tid(); const int BIDX = opaque_bid();
  for (size_t i = (size_t)BIDX * 512 + TIDX; i < n; i += (size_t)gridDim.x * 512) bad |= badv<TT>(q[i]);
  if (bad) atomicMin((int*)(p.ws + O_FLAG), code);
}
__device__ __forceinline__ void chko(const P& p, int code) {
  bool bad = false;
  const int TIDX = opaque_tid(); const int BIDX = opaque_bid();
  for (size_t i = (size_t)BIDX * 512 + TIDX; i < (size_t)T * 1024; i += (size_t)gridDim.x * 512) bad |= badv<float>(p.out[i]);
  if (bad) atomicMin((int*)(p.ws + O_FLAG), code);
}
#define CHK(...) do { if (l == 0) { __VA_ARGS__ } } while (0)
#else
#define CHK(...) do {} while (0)
#endif
__global__ void __launch_bounds__(512) mega(P p) {
  cg::grid_group grid = cg::this_grid();
  __shared__ uint4 xb_words;
  if (threadIdx.x == 0) xb_words = make_uint4(0u, 0u, 0u, 0u);
  __syncthreads();
  XcdBarrier xbar = xcd_barrier_post((unsigned*)(p.ws + O_BAR), (volatile LAS3 unsigned*)&xb_words);
  gsync_cg(grid);
#ifdef DBG
  if (blockIdx.x == 0 && threadIdx.x == 0) *(int*)(p.ws + O_FLAG) = 9999;
#endif
  for (int l = 0; l < NL; ++l) {
#ifndef ONLY
#define ONLY -1
#endif
#ifndef REPMASK
#define REPMASK 0
#endif
#define RUNP(k, call) do { call; gsync(grid); if (REPMASK & (1 << (k))) { call; gsync(grid); } } while (0)
    RUNP(0, phase0(p, l));
    CHK(chk<u16>(p, O_H, (size_t)T * 1024, 10); chk<u16>(p, O_WIN, (size_t)NIN * 1024, 11););
    RUNP(1, phase1(p));
    RUNP(2, phase2(p, l));
    RUNP(3, phase3(p));
    RUNP(4, phase4(p, l));
    phase5(p, l, 0); gsync(grid);
#ifndef REP5MASK
#define REP5MASK 15
#endif
    if (REPMASK & (1 << 5)) { phase5(p, l, 4, REP5MASK); gsync(grid); }
    RUNP(6, phase6(p, l));
    RUNP(7, phase7(p, l); phase8a(p, l));
    RUNP(9, phase8(p, l));
    phase9(p, l); gsync(grid);
    if (REPMASK & (1 << 10)) { gsync(grid); gsync(grid); gsync(grid); gsync(grid); gsync(grid); }
#ifdef DBG
    if (l > 0) chko(p, 90 + l);
#endif
  }
#ifdef DBG
  gsync(grid);
  {
    const int flag = *(volatile int*)(p.ws + O_FLAG);
    if (flag < 9999) {
      const int TIDX = opaque_tid(); const int BIDX = opaque_bid();
      for (size_t i = (size_t)BIDX * 512 + TIDX; i < (size_t)T * 1024; i += (size_t)gridDim.x * 512)
        p.out[i] = (i == 0) ? (float)(flag * 10) : p.in[I_X][i];
    }
  }
#endif
}

extern "C" void kernel_launch(void* const* d_in, const int* in_sizes, int n_in,
                              void* d_out, int out_size, void* d_ws, size_t ws_size,
                              hipStream_t stream) {
  constexpr size_t kDynLds = 128 * 1024;
  static int grid_blocks = 0;
  if (!grid_blocks) {
    int dev = 0, cus = 0, per_cu = 0;
    (void)hipGetDevice(&dev);
    (void)hipDeviceGetAttribute(&cus, hipDeviceAttributeMultiprocessorCount, dev);
    (void)hipFuncSetAttribute((const void*)mega, hipFuncAttributeMaxDynamicSharedMemorySize, (int)kDynLds);
    (void)hipOccupancyMaxActiveBlocksPerMultiprocessor(&per_cu, mega, 512, kDynLds);
    if (per_cu < 1) per_cu = 1;
    if (per_cu > 1) per_cu = 1;
    grid_blocks = cus * per_cu;
  }
  if (n_in < 36 || ws_size < O_BAR + BAR_BYTES) { fprintf(stderr, "bad args: n_in %d ws %zu need %zu\n", n_in, ws_size, (size_t)O_END); return; }
  P p{};
  for (int i = 0; i < 36; ++i) p.in[i] = (const float*)d_in[i];
  p.out = (float*)d_out; p.ws = (char*)d_ws;
  (void)hipMemsetAsync((char*)d_ws + O_BAR, 0, BAR_BYTES, stream);
  void* args[] = {&p};
  hipError_t e = hipLaunchCooperativeKernel((void*)mega, dim3(grid_blocks), dim3(512), args, kDynLds, stream);
  if (e != hipSuccess) fprintf(stderr, "coop launch failed: %s\n", hipGetErrorString(e));
}
```

```cpp
#define REPMASK 0

#include <hip/hip_runtime.h>
#include <hip/hip_bf16.h>
#include <hip/hip_cooperative_groups.h>
#include <cstdio>
#include <cstdint>
namespace cg = cooperative_groups;

typedef unsigned short u16;
using bf16x8 = __attribute__((ext_vector_type(8))) short;
using s16x4  = __attribute__((ext_vector_type(4))) short;
using f32x4  = __attribute__((ext_vector_type(4))) float;
using f32x16 = __attribute__((ext_vector_type(16))) float;
using u32x4  = __attribute__((ext_vector_type(4))) unsigned;
using f2     = __attribute__((ext_vector_type(2))) float;

constexpr int T = 16384, S = 4096, NB = 4, DM = 1024, NL = 4;
constexpr int NP = 6336;
constexpr int NIN = 10432;
constexpr int C_S5U = 0, C_S5Z = 512, C_DQ = 1024, C_DK = 1536, C_DV = 2048, C_DZ = 2560, C_MCQ = 3072, C_MCKV = 3328,
              C_MKR = 3456, C_MZ = 3520, C_RC = 4032, C_RZ = 5824;
constexpr size_t SZT512 = (size_t)T * 512 * 2;
constexpr size_t O_WIN = 0;
constexpr size_t O_WBR = O_WIN + (size_t)NIN * 1024 * 2;
constexpr size_t O_WOUT = O_WBR + 4194304;
constexpr size_t O_GLU = O_WOUT + 2097152;
constexpr size_t O_UQ = O_GLU + 524288;
constexpr size_t O_UKV = O_UQ + 393216;
constexpr size_t O_WUP = O_UKV + 262144;
constexpr size_t O_AUP = O_WUP + 131072;
constexpr size_t O_CTR = O_AUP + 131072;
constexpr size_t O_H = O_CTR + 4096;
constexpr size_t O_P = O_H + (size_t)T * 1024 * 2;
constexpr size_t O_RW = O_P + (size_t)T * NP * 2;
constexpr size_t RW_R = O_RW, RW_K = O_RW + SZT512, RW_V = O_RW + 2 * SZT512, RW_KK = O_RW + 3 * SZT512,
                 RW_A = O_RW + 4 * SZT512, RW_E = O_RW + 6 * SZT512, RW_BON = O_RW + 8 * SZT512;
constexpr size_t O_M = O_RW;
constexpr size_t O_QK = RW_BON + (size_t)T * 8 * 4;
constexpr size_t QK_DQ = O_QK, QK_DK = O_QK + SZT512, QK_MQ = O_QK + 2 * SZT512, QK_MK = QK_MQ + (size_t)T * 768 * 2,
                 QK_MV = QK_MK + (size_t)T * 768 * 2;
constexpr size_t O_BR = O_QK, O_GS5 = O_QK + 4 * SZT512;
constexpr size_t O_O = QK_MV + SZT512;
constexpr size_t OO_DO = O_O, OO_MO = O_O + 4 * SZT512, OO_YS = OO_MO + SZT512, OO_YR = OO_YS + 2 * SZT512;
constexpr size_t O_END = OO_YR + 2 * SZT512;
constexpr size_t OA_LINW = O_O, OA_LINA = O_O + 4194304, OA_CQN = O_O + 8388608, OA_CKVN = O_O + 16777216,
                 OA_QRAW = O_O + 20971520, OA_KVRAW = OA_QRAW + 25165824, OA_WL = OA_KVRAW + 33554432, OA_AL = OA_WL + 33554432;
static_assert(OA_AL + 33554432 <= O_END, "alias overflow");
static_assert(O_END <= 683000000ull, "ws overflow");
constexpr size_t O_FLAG = O_CTR + 64;
constexpr size_t O_BAR = O_END;
constexpr size_t BAR_BYTES = 3456 * 4;
static_assert(O_BAR + BAR_BYTES <= 683000000ull, "ws overflow");

struct P {
  const float* in[36];
  float* out;
  char* ws;
};
enum { I_X = 0, I_NORMG, I_WIN, I_GATEB, I_LRE, I_LIM, I_LDT, I_BRE, I_BIM, I_CRE, I_CIM, I_S5D, I_GLUW, I_GLUB, I_DQN, I_DKN,
       I_DLAM, I_SUBLN, I_QLN, I_KVLN, I_WUQ, I_WUKV, I_MQN, I_MKN, I_MU, I_W0, I_WUP, I_A0, I_AUP, I_KK, I_KA, I_RK, I_LNG,
       I_LNB, I_WBR, I_WOUT };

extern __shared__ __attribute__((aligned(16))) char smem[];

__device__ __forceinline__ float bf2f(u16 v) { return __uint_as_float(((unsigned)v) << 16); }
__device__ __forceinline__ u16 f2bf(float f) { unsigned u = __float_as_uint(f); u += 0x7fffu + ((u >> 16) & 1u); return (u16)(u >> 16); }
__device__ __forceinline__ unsigned cvtpk_asm(float lo, float hi) {
  unsigned r; asm volatile("v_cvt_pk_bf16_f32 %0, %1, %2" : "=v"(r) : "v"(lo), "v"(hi)); return r;
}
typedef __bf16 bf16v2_t __attribute__((ext_vector_type(2)));
__device__ __forceinline__ unsigned cvtpk(float lo, float hi) {
  f2 v = {lo, hi};
  bf16v2_t r = __builtin_convertvector(v, bf16v2_t);
  return __builtin_bit_cast(unsigned, r);
}
__device__ __forceinline__ float dpp_add_(float x, const int ctrl_unused) { return x; }
#define WS_DPP(x, ctrl) ((x) + __int_as_float(__builtin_amdgcn_update_dpp(0, __float_as_int(x), (ctrl), 0xf, 0xf, true)))
__device__ __forceinline__ float wsum(float v) {
  v = WS_DPP(v, 0xB1);
  v = WS_DPP(v, 0x4E);
  v = WS_DPP(v, 0x141);
  v = WS_DPP(v, 0x140);
  v += __shfl_xor(v, 16);
  v += __shfl_xor(v, 32);
  return v;
}
__device__ __forceinline__ float sigmoidf_(float x) { return __builtin_amdgcn_rcpf(1.f + __expf(-x)); }
__device__ __forceinline__ float siluf_(float x) { return x * __builtin_amdgcn_rcpf(1.f + __expf(-x)); }
__device__ __forceinline__ void sincos_rev(float ang, float& sn, float& cs) {
  float rev = ang * 0.15915494309189535f; rev -= rintf(rev);
  sn = __builtin_amdgcn_sinf(rev); cs = __builtin_amdgcn_cosf(rev);
}

__device__ __forceinline__ int opaque_tid() { int t = threadIdx.x; asm volatile("" : "+v"(t)); return t; }
__device__ __forceinline__ int opaque_bid() { int t = blockIdx.x; asm volatile("" : "+s"(t)); return t; }

struct F8 { float v[8]; };
__device__ __forceinline__ F8 ld8bf(const u16* p) {
  const u32x4 w = *reinterpret_cast<const u32x4*>(p); F8 r;
#pragma unroll
  for (int i = 0; i < 4; ++i) { r.v[2 * i] = __uint_as_float(w[i] << 16); r.v[2 * i + 1] = __uint_as_float(w[i] & 0xffff0000u); }
  return r;
}
__device__ __forceinline__ void st8bf(u16* p, const F8& f) {
  u32x4 w; w[0] = cvtpk(f.v[0], f.v[1]); w[1] = cvtpk(f.v[2], f.v[3]); w[2] = cvtpk(f.v[4], f.v[5]); w[3] = cvtpk(f.v[6], f.v[7]);
  *reinterpret_cast<u32x4*>(p) = w;
}
__device__ __forceinline__ F8 ld8f(const float* p) {
  const f32x4 a = *reinterpret_cast<const f32x4*>(p), b = *reinterpret_cast<const f32x4*>(p + 4); F8 r;
  r.v[0] = a[0]; r.v[1] = a[1]; r.v[2] = a[2]; r.v[3] = a[3]; r.v[4] = b[0]; r.v[5] = b[1]; r.v[6] = b[2]; r.v[7] = b[3]; return r;
}
struct F4 { float v[4]; };
__device__ __forceinline__ F4 ld4bf(const u16* p) {
  const uint2 w = *reinterpret_cast<const uint2*>(p); F4 r;
  r.v[0] = __uint_as_float(w.x << 16); r.v[1] = __uint_as_float(w.x & 0xffff0000u); r.v[2] = __uint_as_float(w.y << 16); r.v[3] = __uint_as_float(w.y & 0xffff0000u); return r;
}
__device__ __forceinline__ void st4bf(u16* p, const F4& f) { uint2 w; w.x = cvtpk(f.v[0], f.v[1]); w.y = cvtpk(f.v[2], f.v[3]); *reinterpret_cast<uint2*>(p) = w; }
__device__ __forceinline__ F4 ld4f(const float* p) { const f32x4 a = *reinterpret_cast<const f32x4*>(p); F4 r; r.v[0] = a[0]; r.v[1] = a[1]; r.v[2] = a[2]; r.v[3] = a[3]; return r; }
__device__ __forceinline__ F4 zero4() { F4 r; r.v[0] = r.v[1] = r.v[2] = r.v[3] = 0.f; return r; }
__device__ __forceinline__ F8 zero8() { F8 r;
#pragma unroll
  for (int i = 0; i < 8; ++i) r.v[i] = 0.f; return r; }
__device__ __forceinline__ float grp8sum(float v) { v = WS_DPP(v, 0xB1); v = WS_DPP(v, 0x4E); v = WS_DPP(v, 0x141); return v; }
__device__ __forceinline__ float grp16sum(float v) { v = grp8sum(v); v = WS_DPP(v, 0x140); return v; }
__device__ __forceinline__ float swz_xor4(float v) { return __int_as_float(__builtin_amdgcn_ds_swizzle(__float_as_int(v), 0x101F)); }
__device__ __forceinline__ float dpp_xor1(float v) { return __int_as_float(__builtin_amdgcn_update_dpp(0, __float_as_int(v), 0xB1, 0xf, 0xf, true)); }
__device__ __forceinline__ void tr_tile(const float* __restrict__ src, int ldsrc, u16* __restrict__ dst, int lddst, int k0, int n0, float* lds) {
  const int TIDX = opaque_tid();
  const int tid = TIDX;
  const int kr = tid >> 4, nc = (tid & 15) * 4;
#pragma unroll
  for (int i = 0; i < 2; ++i) {
    int k = kr + 32 * i;
    float4 v = *reinterpret_cast<const float4*>(src + (long)(k0 + k) * ldsrc + n0 + nc);
    float* d = lds + k * 65 + nc; d[0] = v.x; d[1] = v.y; d[2] = v.z; d[3] = v.w;
  }
  __syncthreads();
  const int n = tid >> 3, k8 = (tid & 7) * 8;
  u32x4 w;
  w[0] = cvtpk(lds[(k8 + 0) * 65 + n], lds[(k8 + 1) * 65 + n]);
  w[1] = cvtpk(lds[(k8 + 2) * 65 + n], lds[(k8 + 3) * 65 + n]);
  w[2] = cvtpk(lds[(k8 + 4) * 65 + n], lds[(k8 + 5) * 65 + n]);
  w[3] = cvtpk(lds[(k8 + 6) * 65 + n], lds[(k8 + 7) * 65 + n]);
  *reinterpret_cast<u32x4*>(dst + (long)(n0 + n) * lddst + k0 + k8) = w;
  __syncthreads();
}

__device__ __forceinline__ void phase0(const P& p, int l) {
  const int TIDX = opaque_tid();
  const int BIDX = opaque_bid();
  float* lds = (float*)smem;
  char* ws = p.ws;
  if (BIDX == 0 && TIDX == 0) { ((int*)(ws + O_CTR))[l] = 0; ((int*)(ws + O_CTR))[l + 4] = 0; }
  constexpr int NT_WIN = 16 * 163, NT_WBR = 4 * 128, NT_WOUT = 256, NT_GLU = 64, NT_UQ = 48, NT_UKV = 32, NT_UP = 16, NT_AUP = 16;
  constexpr int NT_ALL = NT_WIN + NT_WBR + NT_WOUT + NT_GLU + NT_UQ + NT_UKV + NT_UP + NT_AUP;
  for (int ti = BIDX; ti < NT_ALL; ti += gridDim.x) {
    int t = ti;
    if (t < NT_WIN) { tr_tile(p.in[I_WIN] + (long)l * 1024 * NIN, NIN, (u16*)(ws + O_WIN), 1024, (t & 15) * 64, (t >> 4) * 64, lds); continue; }
    t -= NT_WIN;
    if (t < NT_WBR) { int nb = t >> 7, r = t & 127;
      tr_tile(p.in[I_WBR] + ((long)l * 4 + nb) * 512 * 1024, 1024, (u16*)(ws + O_WBR) + (long)nb * 1024 * 512, 512, (r & 7) * 64, (r >> 3) * 64, lds); continue; }
    t -= NT_WBR;
    if (t < NT_WOUT) { tr_tile(p.in[I_WOUT] + (long)l * 1024 * 1024, 1024, (u16*)(ws + O_WOUT), 1024, (t & 15) * 64, (t >> 4) * 64, lds); continue; }
    t -= NT_WOUT;
    if (t < NT_GLU) { tr_tile(p.in[I_GLUW] + (long)l * 512 * 512, 512, (u16*)(ws + O_GLU), 512, (t & 7) * 64, (t >> 3) * 64, lds); continue; }
    t -= NT_GLU;
    if (t < NT_UQ) { tr_tile(p.in[I_WUQ] + (long)l * 256 * 768, 768, (u16*)(ws + O_UQ), 256, (t & 3) * 64, (t >> 2) * 64, lds); continue; }
    t -= NT_UQ;
    if (t < NT_UKV) { tr_tile(p.in[I_WUKV] + (long)l * 128 * 1024, 1024, (u16*)(ws + O_UKV), 128, (t & 1) * 64, (t >> 1) * 64, lds); continue; }
    t -= NT_UKV;
    if (t < NT_UP) { int d = t >> 3, r = t & 7;
      tr_tile(p.in[I_WUP] + ((long)l * 2 + d) * 64 * 512, 512, (u16*)(ws + O_WUP) + (long)d * 512 * 64, 64, 0, r * 64, lds); continue; }
    t -= NT_UP;
    { int d = t >> 3, r = t & 7;
      tr_tile(p.in[I_AUP] + ((long)l * 2 + d) * 64 * 512, 512, (u16*)(ws + O_AUP) + (long)d * 512 * 64, 64, 0, r * 64, lds); }
  }
  const float* xin = (l == 0) ? p.in[I_X] : p.out;
  const float* g = p.in[I_NORMG] + l * 1024;
  u16* h = (u16*)(ws + O_H);
  const int wid = TIDX >> 6, lane = TIDX & 63;
  for (int t = BIDX * 8 + wid; t < T; t += gridDim.x * 8) {
    const float* xr = xin + (long)t * 1024;
    float4 v[4]; float ss = 0.f;
#pragma unroll
    for (int i = 0; i < 4; ++i) { v[i] = *reinterpret_cast<const float4*>(xr + i * 256 + lane * 4); ss += v[i].x * v[i].x + v[i].y * v[i].y + v[i].z * v[i].z + v[i].w * v[i].w; }
    ss = wsum(ss);
    float sc = rsqrtf(ss * (1.f / 1024.f) + 1e-6f);
#pragma unroll
    for (int i = 0; i < 4; ++i) {
      float4 gg = *reinterpret_cast<const float4*>(g + i * 256 + lane * 4);
      uint2 o; o.x = cvtpk(v[i].x * sc * gg.x, v[i].y * sc * gg.y); o.y = cvtpk(v[i].z * sc * gg.z, v[i].w * sc * gg.w);
      *reinterpret_cast<uint2*>(h + (long)t * 1024 + i * 256 + lane * 4) = o;
    }
  }
}

template <int MT>
__device__ __forceinline__ void gemm_main(const u16* __restrict__ A, long lda, const u16* __restrict__ Bt, long ldb, int K,
                                          f32x4 (&acc)[MT][4], char* lds) {
  const int TIDX = opaque_tid();
  constexpr int BM = MT * 64;
  constexpr int ASZ = BM * 128, BSZ = 128 * 128, STG = ASZ + BSZ;
  const int tid = TIDX, lane = tid & 63, wid = tid >> 6, wm = wid >> 1, wn = wid & 1, fr = lane & 15, fq = lane >> 4;
  bf16x8 ra[MT], rb[2];
  const int nk = K >> 6;
#define GLOAD(k0) do { _Pragma("unroll") for (int i = 0; i < MT; ++i) { int gi = tid + 512 * i; int row = gi >> 3, g = gi & 7; \
      ra[i] = *reinterpret_cast<const bf16x8*>(A + (long)row * lda + (k0) + g * 8); } \
    _Pragma("unroll") for (int i = 0; i < 2; ++i) { int gi = tid + 512 * i; int row = gi >> 3, g = gi & 7; \
      rb[i] = *reinterpret_cast<const bf16x8*>(Bt + (long)row * ldb + (k0) + g * 8); } } while (0)
#define SWRITE(st) do { char* base_ = lds + (st) * STG; \
    _Pragma("unroll") for (int i = 0; i < MT; ++i) { int gi = tid + 512 * i; int row = gi >> 3, g = gi & 7; \
      *reinterpret_cast<bf16x8*>(base_ + row * 128 + ((g ^ ((row >> 1) & 7)) << 4)) = ra[i]; } \
    _Pragma("unroll") for (int i = 0; i < 2; ++i) { int gi = tid + 512 * i; int row = gi >> 3, g = gi & 7; \
      *reinterpret_cast<bf16x8*>(base_ + ASZ + row * 128 + ((g ^ ((row >> 1) & 7)) << 4)) = rb[i]; } } while (0)
  GLOAD(0); SWRITE(0); __syncthreads();
  for (int kt = 0; kt < nk; ++kt) {
    const int cur = kt & 1;
    if (kt + 1 < nk) GLOAD((kt + 1) * 64);
    const char* sa = lds + cur * STG; const char* sb = sa + ASZ;
#pragma unroll
    for (int kk = 0; kk < 2; ++kk) {
      bf16x8 af[MT], bfr[4];
      const int g = kk * 4 + fq;
#pragma unroll
      for (int i = 0; i < MT; ++i) { int row = wm * (MT * 16) + i * 16 + fr; af[i] = *reinterpret_cast<const bf16x8*>(sa + row * 128 + ((g ^ ((row >> 1) & 7)) << 4)); }
#pragma unroll
      for (int j = 0; j < 4; ++j) { int row = wn * 64 + j * 16 + fr; bfr[j] = *reinterpret_cast<const bf16x8*>(sb + row * 128 + ((g ^ ((row >> 1) & 7)) << 4)); }
#pragma unroll
      for (int i = 0; i < MT; ++i)
#pragma unroll
        for (int j = 0; j < 4; ++j) acc[i][j] = __builtin_amdgcn_mfma_f32_16x16x32_bf16(af[i], bfr[j], acc[i][j], 0, 0, 0);
    }
    if (kt + 1 < nk) SWRITE(cur ^ 1);
    __syncthreads();
  }
#undef GLOAD
#undef SWRITE
}
#define EPI_LOOP(MT_, BODY) do { const int lane_ = TIDX & 63, wid_ = TIDX >> 6, wm_ = wid_ >> 1, wn_ = wid_ & 1, fr_ = lane_ & 15, fq_ = lane_ >> 4; \
  _Pragma("unroll") for (int i = 0; i < MT_; ++i) _Pragma("unroll") for (int j = 0; j < 4; ++j) _Pragma("unroll") for (int jj = 0; jj < 4; ++jj) { \
    const int m = m0 + wm_ * (MT_ * 16) + i * 16 + fq_ * 4 + jj; const int n = n0 + wn_ * 64 + j * 16 + fr_; BODY } } while (0)

template <int MT> __device__ __forceinline__ void zero_acc(f32x4 (&acc)[MT][4]) {
#pragma unroll
  for (int i = 0; i < MT; ++i)
#pragma unroll
    for (int j = 0; j < 4; ++j) acc[i][j] = f32x4{0.f, 0.f, 0.f, 0.f};
}


#define LAS3 __attribute__((address_space(3)))
namespace fg {
constexpr int BM = 256, BK = 64, HALF = 128, HTB = HALF * BK * 2, NXCD = 8, WGM = 8;
__device__ __forceinline__ int lds_byte(int r, int c) { const int st = (r >> 4) * 2 + (c >> 5), rr = r & 15, cc = c & 31, ob = rr * 64 + cc * 2; return st * 1024 + (ob ^ (((ob >> 9) & 1) << 5)); }
__device__ __forceinline__ void stage_rc(int b, int& R, int& C) { const int st = b / 1024, sb = b % 1024, swz = sb ^ (((sb >> 9) & 1) << 5); R = (st >> 1) * 16 + swz / 64; C = (st & 1) * 32 + (swz % 64) / 2; }
struct Unit { int pm, pn; };
struct Order {
  int nM, nN, nwg, G, c;
  __device__ __forceinline__ void init(int M, int N, int G_, int c_) { nM = M / BM; nN = N / BM; nwg = nM * nN; G = G_; c = c_; }
  __device__ __forceinline__ bool next(int i, Unit& u) const {
    const long L = (long)i * G + c; if (L >= nwg) return false;
    int wgid = (int)L; { const int q = nwg / NXCD, r = nwg % NXCD, xcd = wgid % NXCD, off = wgid / NXCD; wgid = (xcd < r ? xcd * (q + 1) : r * (q + 1) + (xcd - r) * q) + off; }
    const int nig = WGM * nN, gid = wgid / nig, fm = gid * WGM, gsz = (nM - fm) < WGM ? (nM - fm) : WGM;
    u.pm = fm + ((wgid % nig) % gsz); u.pn = (wgid % nig) / gsz; return true;
  }
};
__device__ __forceinline__ int perm32(int rho) { const int n = rho >> 4, i = rho & 15; return 8 * (i >> 2) + 4 * n + (i & 3); }
template <class Epi, bool PERM = false>
__device__ __forceinline__ void gemm_phase(LAS3 unsigned char* lds, const u16* A, int lda, const u16* Bt, int ldb, int M, int N, int K, const Epi& E) {
  const int tid = opaque_tid(), wid = __builtin_amdgcn_readfirstlane(tid >> 6), lane = tid & 63, wr = wid >> 2, wc = wid & 3, fr = lane & 15, fq = lane >> 4;
  const int nt = K / BK;
  Order S; S.init(M, N, gridDim.x, opaque_bid());
  unsigned voffA[2], voffB[2];
#pragma unroll
  for (int i = 0; i < 2; ++i) { int R, C; stage_rc(tid * 16 + i * 8192, R, C); const int Rb = PERM ? ((R & ~31) + perm32(R & 31)) : R;
    voffA[i] = (unsigned)(R * lda + C) * 2u; voffB[i] = (unsigned)(Rb * ldb + C) * 2u; }
  const size_t kstep = (size_t)(BK * 2);
  const size_t hstepA = (size_t)HALF * lda * 2, hstepB = (size_t)HALF * ldb * 2;
  const size_t tstepA = 2 * hstepA, tstepB = 2 * hstepB;
  const unsigned ldsw = (unsigned)wid * 1024u;
  const int aoff = lds_byte(wr * 64 + fr, fq * 8), boff = lds_byte(wc * 32 + fr, fq * 8);
#define FG_SA(b, h) (((b) * 2 + (h)) * HTB)
#define FG_SB(b, h) ((4 + (b) * 2 + (h)) * HTB)
#define FG_STAGE(bufoff, gbase, voff) do { _Pragma("unroll") for (int _i = 0; _i < 2; ++_i) \
    __builtin_amdgcn_global_load_lds((const unsigned*)((const char*)(gbase) + (voff)[_i]), (LAS3 unsigned*)(lds + (bufoff) + ldsw + _i * 8192), 16, 0, 0); } while (0)
#define FG_LDA(dst, b, h) do { _Pragma("unroll") for (int m = 0; m < 4; ++m) _Pragma("unroll") for (int k = 0; k < 2; ++k) dst[m][k] = *(const LAS3 bf16x8*)(lds + FG_SA(b, h) + aoff + m * 2048 + k * 1024); } while (0)
#define FG_LDB(dst, b, h) do { _Pragma("unroll") for (int n = 0; n < 2; ++n) _Pragma("unroll") for (int k = 0; k < 2; ++k) dst[n][k] = *(const LAS3 bf16x8*)(lds + FG_SB(b, h) + boff + n * 2048 + k * 1024); } while (0)
#define FG_MMA(ai, bj, At, Bq) do { __builtin_amdgcn_s_setprio(1); _Pragma("unroll") for (int m = 0; m < 4; ++m) _Pragma("unroll") for (int n = 0; n < 2; ++n) _Pragma("unroll") for (int k = 0; k < 2; ++k) \
    acc[ai][bj][m][n] = __builtin_amdgcn_mfma_f32_16x16x32_bf16(Bq[n][k], At[m][k], acc[ai][bj][m][n], 0, 0, 0); __builtin_amdgcn_s_setprio(0); } while (0)
#define FG_WAIT_V(n) asm volatile("s_waitcnt vmcnt(" #n ")" ::: "memory")
#define FG_WAIT_L(n) asm volatile("s_waitcnt lgkmcnt(" #n ")" ::: "memory")
#define FG_BAR __builtin_amdgcn_s_barrier()
#define FG_SCHED __builtin_amdgcn_sched_barrier(0)
  Unit cur, nxt; int ui = 0;
  if (!S.next(0, cur)) return;
  f32x4 acc[2][2][4][2];
#pragma unroll
  for (int a = 0; a < 2; ++a)
#pragma unroll
    for (int b = 0; b < 2; ++b)
#pragma unroll
      for (int m = 0; m < 4; ++m)
#pragma unroll
        for (int n = 0; n < 2; ++n) acc[a][b][m][n] = (f32x4){0.f, 0.f, 0.f, 0.f};
  bf16x8 At[4][2], B0[2][2], B1[2][2];
  const char* cA = (const char*)A + (size_t)cur.pm * tstepA; const char* cB = (const char*)Bt + (size_t)cur.pn * tstepB;
  FG_STAGE(FG_SB(0, 0), cB, voffB); FG_STAGE(FG_SA(0, 0), cA, voffA); FG_STAGE(FG_SB(0, 1), cB + hstepB, voffB); FG_STAGE(FG_SA(0, 1), cA + hstepA, voffA);
  if (wr == 1) FG_BAR;
  FG_WAIT_V(4); FG_BAR;
  FG_STAGE(FG_SB(1, 0), cB + kstep, voffB); FG_STAGE(FG_SA(1, 0), cA + kstep, voffA); FG_STAGE(FG_SB(1, 1), cB + hstepB + kstep, voffB);
  FG_WAIT_V(6); FG_BAR;
  for (;;) {
    const bool has_next = S.next(ui + 1, nxt);
    const char* nA = has_next ? (const char*)A + (size_t)nxt.pm * tstepA : cA; const char* nB = has_next ? (const char*)Bt + (size_t)nxt.pn * tstepB : cB;
    for (int t = 0; t < nt; t += 2) {
      const bool last = (t == nt - 2);
      const char* a1 = cA + (size_t)(t + 1) * kstep;
      const char* a2 = last ? nA : cA + (size_t)(t + 2) * kstep; const char* b2 = last ? nB : cB + (size_t)(t + 2) * kstep;
      const char* a3 = a2 + kstep; const char* b3 = b2 + kstep;
      FG_LDB(B0, 0, 0); FG_SCHED; FG_LDA(At, 0, 0); FG_STAGE(FG_SA(1, 1), a1 + hstepA, voffA);
      FG_WAIT_L(8); FG_BAR; FG_WAIT_L(0); FG_MMA(0, 0, At, B0); FG_BAR; FG_SCHED;
      FG_LDB(B1, 0, 1); FG_STAGE(FG_SB(0, 0), b2, voffB);
      FG_BAR; FG_WAIT_L(0); FG_MMA(0, 1, At, B1); FG_BAR;
      FG_LDA(At, 0, 1); FG_STAGE(FG_SA(0, 0), a2, voffA);
      FG_BAR; FG_WAIT_L(0); FG_MMA(1, 0, At, B0); FG_BAR; FG_SCHED;
      FG_STAGE(FG_SB(0, 1), b2 + hstepB, voffB);
      FG_WAIT_V(6); FG_BAR; FG_MMA(1, 1, At, B1); FG_BAR;
      FG_LDB(B0, 1, 0); FG_SCHED; FG_LDA(At, 1, 0); FG_STAGE(FG_SA(0, 1), a2 + hstepA, voffA);
      FG_WAIT_L(8); FG_BAR; FG_WAIT_L(0); FG_MMA(0, 0, At, B0); FG_BAR; FG_SCHED;
      FG_LDB(B1, 1, 1); FG_STAGE(FG_SB(1, 0), b3, voffB);
      FG_BAR; FG_WAIT_L(0); FG_MMA(0, 1, At, B1); FG_BAR;
      FG_LDA(At, 1, 1); FG_STAGE(FG_SA(1, 0), a3, voffA);
      FG_BAR; FG_WAIT_L(0); FG_MMA(1, 0, At, B0); FG_BAR; FG_SCHED;
      FG_STAGE(FG_SB(1, 1), b3 + hstepB, voffB);
      FG_WAIT_V(6); FG_BAR; FG_MMA(1, 1, At, B1); FG_BAR;
    }
    if constexpr (PERM) {
      const int row0 = cur.pm * BM + wr * 64 + fr, col0 = cur.pn * BM + wc * 32 + 8 * fq;
#pragma unroll
      for (int ai = 0; ai < 2; ++ai)
#pragma unroll
        for (int m = 0; m < 4; ++m)
#pragma unroll
          for (int bj = 0; bj < 2; ++bj) E(row0 + ai * HALF + m * 16, col0 + bj * HALF, acc[ai][bj][m][0], acc[ai][bj][m][1]);
    } else {
      const int row0 = cur.pm * BM + wr * 64 + fr, col0 = cur.pn * BM + wc * 32 + 4 * fq;
#pragma unroll
      for (int ai = 0; ai < 2; ++ai)
#pragma unroll
        for (int m = 0; m < 4; ++m)
#pragma unroll
          for (int bj = 0; bj < 2; ++bj)
#pragma unroll
            for (int n = 0; n < 2; ++n) E(row0 + ai * HALF + m * 16, col0 + bj * HALF + n * 16, acc[ai][bj][m][n]);
    }
    if (!has_next) break;
#pragma unroll
    for (int a = 0; a < 2; ++a)
#pragma unroll
      for (int b = 0; b < 2; ++b)
#pragma unroll
        for (int m = 0; m < 4; ++m)
#pragma unroll
          for (int n = 0; n < 2; ++n) acc[a][b][m][n] = (f32x4){0.f, 0.f, 0.f, 0.f};
    cur = nxt; cA = nA; cB = nB; ++ui;
  }
  FG_WAIT_V(0);
  if (wr == 0) FG_BAR;
  FG_BAR;
#undef FG_SA
#undef FG_SB
#undef FG_STAGE
#undef FG_LDA
#undef FG_LDB
#undef FG_MMA
#undef FG_WAIT_V
#undef FG_WAIT_L
#undef FG_BAR
#undef FG_SCHED
}
}

struct EpiP1 { u16* PB; __device__ __forceinline__ void operator()(int row, int col, f32x4 v0, f32x4 v1) const {
  if (col < NP) { u32x4 o; o[0] = cvtpk(v0[0], v0[1]); o[1] = cvtpk(v0[2], v0[3]); o[2] = cvtpk(v1[0], v1[1]); o[3] = cvtpk(v1[2], v1[3]);
    *reinterpret_cast<u32x4*>(PB + (long)row * NP + col) = o; } } };
struct EpiGate { u16* G; const float* gb; __device__ __forceinline__ void operator()(int row, int col, f32x4 v0, f32x4 v1) const {
  const f32x4 b0 = *reinterpret_cast<const f32x4*>(gb + col), b1 = *reinterpret_cast<const f32x4*>(gb + col + 4);
  u32x4 o; o[0] = cvtpk(sigmoidf_(v0[0] + b0[0]), sigmoidf_(v0[1] + b0[1])); o[1] = cvtpk(sigmoidf_(v0[2] + b0[2]), sigmoidf_(v0[3] + b0[3]));
  o[2] = cvtpk(sigmoidf_(v1[0] + b1[0]), sigmoidf_(v1[1] + b1[1])); o[3] = cvtpk(sigmoidf_(v1[2] + b1[2]), sigmoidf_(v1[3] + b1[3]));
  *reinterpret_cast<u32x4*>(G + (long)row * 4096 + col) = o; } };
struct EpiOut { float* out; const float* xin; __device__ __forceinline__ void operator()(int row, int col, f32x4 v) const {
  const f32x4 x = *reinterpret_cast<const f32x4*>(xin + (long)row * 1024 + col);
  *reinterpret_cast<f32x4*>(out + (long)row * 1024 + col) = x + v; } };

__device__ __forceinline__ void phase1(const P& p) {
  char* ws = p.ws;
  EpiP1 e{(u16*)(ws + O_P)};
  fg::gemm_phase<EpiP1, true>((LAS3 unsigned char*)smem, (const u16*)(ws + O_H), 1024, (const u16*)(ws + O_WIN), 1024, T, 6400, 1024, e);
}

__device__ __forceinline__ void phase2(const P& p, int l) {
  const int TIDX = opaque_tid();
  const int BIDX = opaque_bid();
  char* ws = p.ws;
  const u16* __restrict__ PB = (const u16*)(ws + O_P);
  u16* __restrict__ DQ = (u16*)(ws + QK_DQ); u16* __restrict__ DKb = (u16*)(ws + QK_DK);
  u16* __restrict__ CQN = (u16*)(ws + OA_CQN); u16* __restrict__ CKVN = (u16*)(ws + OA_CKVN);
  u16* __restrict__ LINW = (u16*)(ws + OA_LINW); u16* __restrict__ LINA = (u16*)(ws + OA_LINA);
  const int wid = TIDX >> 6, lane = TIDX & 63, l7 = lane & 7, e0 = l7 * 8, hv = lane >> 3;
  const F8 gq = ld8f(p.in[I_DQN] + l * 64 + e0), gk = ld8f(p.in[I_DKN] + l * 64 + e0);
  float invd[8];
#pragma unroll
  for (int j = 0; j < 8; ++j) invd[j] = exp2f(-(float)j * (1.f / 8.f) * 18.931568569324174f);
  F8 glat = zero8();
  if (lane < 32) glat = ld8f(p.in[I_QLN] + l * 256 + lane * 8); else if (lane < 48) glat = ld8f(p.in[I_KVLN] + l * 128 + (lane - 32) * 8);
  F8 mu0 = zero8(), mu1 = zero8();
  if (lane < 32) { mu0 = ld8f(p.in[I_MU] + (long)l * 2 * 1792 + 1536 + lane * 8); mu1 = ld8f(p.in[I_MU] + (long)l * 2 * 1792 + 1792 + 1536 + lane * 8); }
  for (int t = BIDX * 8 + wid; t < T; t += gridDim.x * 8) {
    const int b = t >> 12, s = t & 4095;
    const u16* pr = PB + (long)t * NP;
    F8 q = ld8bf(pr + C_DQ + lane * 8), k = ld8bf(pr + C_DK + lane * 8);
    F8 lat = zero8(); if (lane < 48) lat = ld8bf(pr + C_MCQ + lane * 8);
    F8 xc = zero8(), xp = zero8(), xn = zero8();
    if (lane < 32) { xc = ld8bf(pr + C_RC + 1536 + lane * 8); if (s > 0) xp = ld8bf(pr - NP + C_RC + 1536 + lane * 8); if (s < S - 1) xn = ld8bf(pr + NP + C_RC + 1536 + lane * 8); }
    float sq = 0.f, sk = 0.f;
#pragma unroll
    for (int j = 0; j < 8; ++j) { sq += q.v[j] * q.v[j]; sk += k.v[j] * k.v[j]; }
    sq = grp8sum(sq); sk = grp8sum(sk);
    const float cq_ = rsqrtf(sq * (1.f / 64.f) + 1e-6f), ck_ = rsqrtf(sk * (1.f / 64.f) + 1e-6f);
#pragma unroll
    for (int j = 0; j < 8; ++j) {
      float yq = q.v[j] * cq_ * gq.v[j], yk = k.v[j] * ck_ * gk.v[j];
      const float pq = dpp_xor1(yq), pk = dpp_xor1(yk);
      float sn, cs; sincos_rev((float)s * invd[j], sn, cs);
      if (l7 == 0) { yq = yq * cs - pq * sn; yk = yk * cs - pk * sn; }
      else if (l7 == 1) { yq = pq * sn + yq * cs; yk = pk * sn + yk * cs; }
      q.v[j] = yq; k.v[j] = yk;
    }
    st8bf(DQ + ((long)(b * 8 + hv) * S + s) * 64 + e0, q);
    st8bf(DKb + ((long)(b * 8 + hv) * S + s) * 64 + e0, k);
    {
      float ss = 0.f;
#pragma unroll
      for (int j = 0; j < 8; ++j) ss += lat.v[j] * lat.v[j];
      const float s1 = wsum(lane < 32 ? ss : 0.f), s2 = wsum((lane >= 32 && lane < 48) ? ss : 0.f);
      const float sc = (lane < 32) ? rsqrtf(s1 * (1.f / 256.f) + 1e-6f) : rsqrtf(s2 * (1.f / 128.f) + 1e-6f);
#pragma unroll
      for (int j = 0; j < 8; ++j) lat.v[j] = lat.v[j] * sc * glat.v[j];
      if (lane < 32) st8bf(CQN + (long)t * 256 + lane * 8, lat); else if (lane < 48) st8bf(CKVN + (long)t * 128 + (lane - 32) * 8, lat);
    }
    if (lane < 32) {
      F8 o;
#pragma unroll
      for (int j = 0; j < 8; ++j) {
        const float xs = xc.v[j] + mu0.v[j] * (xp.v[j] - xc.v[j]) + mu1.v[j] * (xn.v[j] - xc.v[j]);
        if (lane < 16) { const float e2 = __expf(2.f * xs); o.v[j] = 1.f - 2.f * __builtin_amdgcn_rcpf(e2 + 1.f); } else o.v[j] = xs;
      }
      if (lane < 16) st8bf(LINW + (long)t * 128 + lane * 8, o); else st8bf(LINA + (long)t * 128 + (lane - 16) * 8, o);
    }
  }
}

__device__ __forceinline__ void phase3(const P& p) {
  const int TIDX = opaque_tid();
  const int BIDX = opaque_bid();
  char* ws = p.ws;
  for (int ti = BIDX; ti < 30 * 64; ti += gridDim.x) {
    const int ng = ti % 30, mt = ti / 30; const int m0 = mt * 256;
    const u16* A; long lda; const u16* Bt; long ldb; int K; u16* C; long ldc; int n0;
    if (ng < 6) { A = (const u16*)(ws + OA_CQN); lda = 256; K = 256; n0 = ng * 128; Bt = (const u16*)(ws + O_UQ) + (long)n0 * 256; ldb = 256; C = (u16*)(ws + OA_QRAW); ldc = 768; }
    else if (ng < 14) { A = (const u16*)(ws + OA_CKVN); lda = 128; K = 128; n0 = (ng - 6) * 128; Bt = (const u16*)(ws + O_UKV) + (long)n0 * 128; ldb = 128; C = (u16*)(ws + OA_KVRAW); ldc = 1024; }
    else { const int q = ng - 14; const int isA = q >> 3, d = (q >> 2) & 1; n0 = (q & 3) * 128;
      A = (const u16*)(ws + (isA ? OA_LINA : OA_LINW)) + d * 64; lda = 128; K = 64;
      Bt = (const u16*)(ws + (isA ? O_AUP : O_WUP)) + (long)d * 512 * 64 + (long)n0 * 64; ldb = 64;
      C = (u16*)(ws + (isA ? OA_AL : OA_WL)) + d * 512; ldc = 1024; }
    f32x4 acc[4][4]; zero_acc<4>(acc);
    gemm_main<4>(A + (long)m0 * lda, lda, Bt, ldb, K, acc, smem);
    EPI_LOOP(4, { C[(long)m * ldc + n] = f2bf(acc[i][j][jj]); });
  }
}

__device__ __forceinline__ void phase4(const P& p, int l) {
  const int TIDX = opaque_tid();
  const int BIDX = opaque_bid();
  char* ws = p.ws;
  const u16* __restrict__ PB = (const u16*)(ws + O_P);
  const u16* __restrict__ QRAW = (const u16*)(ws + OA_QRAW); const u16* __restrict__ KVRAW = (const u16*)(ws + OA_KVRAW);
  const u16* __restrict__ WL = (const u16*)(ws + OA_WL); const u16* __restrict__ AL = (const u16*)(ws + OA_AL);
  u16* __restrict__ MQ = (u16*)(ws + QK_MQ); u16* __restrict__ MK = (u16*)(ws + QK_MK); u16* __restrict__ MV = (u16*)(ws + QK_MV);
  u16* __restrict__ RR = (u16*)(ws + RW_R); u16* __restrict__ RK = (u16*)(ws + RW_K); u16* __restrict__ RV = (u16*)(ws + RW_V); u16* __restrict__ RKK = (u16*)(ws + RW_KK);
  u16* __restrict__ RA = (u16*)(ws + RW_A); u16* __restrict__ RE = (u16*)(ws + RW_E); float* __restrict__ BON = (float*)(ws + RW_BON);
  const int wid = TIDX >> 6, lane = TIDX & 63;
  float* lp = (float*)smem;
  {
    const float* mu = p.in[I_MU] + (long)l * 2 * 1792;
    for (int i = TIDX; i < 13 * 512; i += 512) {
      const int a = i >> 9, c = i & 511; float v;
      if (a < 3) v = mu[a * 512 + c]; else if (a < 6) v = mu[1792 + (a - 3) * 512 + c];
      else if (a == 6) v = p.in[I_KK][l * 512 + c]; else if (a == 7) v = p.in[I_KA][l * 512 + c]; else if (a == 8) v = p.in[I_RK][l * 512 + c];
      else if (a < 11) v = p.in[I_W0][(l * 2 + (a - 9)) * 512 + c]; else v = p.in[I_A0][(l * 2 + (a - 11)) * 512 + c];
      lp[i] = v;
    }
  }
  __syncthreads();
  const int hA = lane >> 4, eA = (lane & 15) * 8, hB = (lane >> 3) & 3, eB = (lane & 7) * 8;
  const F8 qnA = ld8f(p.in[I_MQN] + l * 192 + eA), qnB = ld8f(p.in[I_MQN] + l * 192 + 128 + eB);
  const F8 knA = ld8f(p.in[I_MKN] + l * 192 + eA), knB = ld8f(p.in[I_MKN] + l * 192 + 128 + eB);
  float invm[8];
#pragma unroll
  for (int j = 0; j < 8; ++j) invm[j] = exp2f(-(float)((lane & 3) * 8 + j) * (1.f / 32.f) * 13.287712379549449f);
  const bool lowhalf = (lane & 4) == 0;
  for (int t = BIDX * 8 + wid; t < T; t += gridDim.x * 8) {
    const int b = t >> 12, s = t & 4095;
    const u16* pr = PB + (long)t * NP;
    F8 qA = ld8bf(QRAW + (long)t * 768 + hA * 192 + eA), qB = ld8bf(QRAW + (long)t * 768 + hB * 192 + 128 + eB);
    F8 kA = ld8bf(KVRAW + (long)t * 1024 + hA * 256 + eA), vA = ld8bf(KVRAW + (long)t * 1024 + hA * 256 + 128 + eA);
    F8 kB = ld8bf(pr + C_MKR + eB);
    {
      float sqA = 0.f, sqB = 0.f, skA = 0.f, skB = 0.f;
#pragma unroll
      for (int j = 0; j < 8; ++j) { sqA += qA.v[j] * qA.v[j]; sqB += qB.v[j] * qB.v[j]; skA += kA.v[j] * kA.v[j]; skB += kB.v[j] * kB.v[j]; }
      sqA = grp16sum(sqA); skA = grp16sum(skA); sqB = grp8sum(sqB); skB = grp8sum(skB);
      const float sqB_forA = __shfl(sqB, 8 * hA), sqA_forB = __shfl(sqA, 16 * hB);
      const float skA_forB = __shfl(skA, 16 * hB);
      const float scqA = rsqrtf((sqA + sqB_forA) * (1.f / 192.f) + 1e-6f), scqB = rsqrtf((sqA_forB + sqB) * (1.f / 192.f) + 1e-6f);
      const float sckA = rsqrtf((skA + skB) * (1.f / 192.f) + 1e-6f), sckB = rsqrtf((skA_forB + skB) * (1.f / 192.f) + 1e-6f);
#pragma unroll
      for (int j = 0; j < 8; ++j) {
        qA.v[j] *= scqA * qnA.v[j]; kA.v[j] *= sckA * knA.v[j];
        float yq = qB.v[j] * scqB * qnB.v[j], yk = kB.v[j] * sckB * knB.v[j];
        const float pq = swz_xor4(yq), pk = swz_xor4(yk);
        float sn, cs; sincos_rev((float)s * invm[j], sn, cs);
        qB.v[j] = lowhalf ? (yq * cs - pq * sn) : (pq * sn + yq * cs);
        kB.v[j] = lowhalf ? (yk * cs - pk * sn) : (pk * sn + yk * cs);
      }
      u16* mq = MQ + ((long)(b * 4 + hA) * S + s) * 192; u16* mk = MK + ((long)(b * 4 + hA) * S + s) * 192;
      st8bf(mq + eA, qA); st8bf(mk + eA, kA);
      st8bf(MV + ((long)(b * 4 + hA) * S + s) * 128 + eA, vA);
      if (lane < 32) { st8bf(MQ + ((long)(b * 4 + hB) * S + s) * 192 + 128 + eB, qB); st8bf(MK + ((long)(b * 4 + hB) * S + s) * 192 + 128 + eB, kB); }
    }
#pragma unroll 1
    for (int hf = 0; hf < 2; ++hf) {
      const int c0 = hf * 256 + lane * 4;
      const F4 xr = ld4bf(pr + C_RC + c0), xk = ld4bf(pr + C_RC + 512 + c0), xv = ld4bf(pr + C_RC + 1024 + c0);
      F4 pr_ = zero4(), pk_ = zero4(), pv_ = zero4(), nr_ = zero4(), nk_ = zero4(), nv_ = zero4();
      if (s > 0) { pr_ = ld4bf(pr - NP + C_RC + c0); pk_ = ld4bf(pr - NP + C_RC + 512 + c0); pv_ = ld4bf(pr - NP + C_RC + 1024 + c0); }
      if (s < S - 1) { nr_ = ld4bf(pr + NP + C_RC + c0); nk_ = ld4bf(pr + NP + C_RC + 512 + c0); nv_ = ld4bf(pr + NP + C_RC + 1024 + c0); }
      const F4 wl0 = ld4bf(WL + ((long)t * 2) * 512 + c0), wl1 = ld4bf(WL + ((long)t * 2 + 1) * 512 + c0);
      const F4 al0 = ld4bf(AL + ((long)t * 2) * 512 + c0), al1 = ld4bf(AL + ((long)t * 2 + 1) * 512 + c0);
      const F4 m0r = ld4f(lp + 0 * 512 + c0), m0k = ld4f(lp + 1 * 512 + c0), m0v = ld4f(lp + 2 * 512 + c0);
      const F4 m1r = ld4f(lp + 3 * 512 + c0), m1k = ld4f(lp + 4 * 512 + c0), m1v = ld4f(lp + 5 * 512 + c0);
      const F4 kkp = ld4f(lp + 6 * 512 + c0), kap = ld4f(lp + 7 * 512 + c0), rkp = ld4f(lp + 8 * 512 + c0);
      const F4 w00 = ld4f(lp + 9 * 512 + c0), w01 = ld4f(lp + 10 * 512 + c0), a00 = ld4f(lp + 11 * 512 + c0), a01 = ld4f(lp + 12 * 512 + c0);
      F4 r, k, v, kk, e0_, e1_, a0_, a1_; float ss = 0.f, bon = 0.f;
#pragma unroll
      for (int j = 0; j < 4; ++j) {
        r.v[j] = xr.v[j] + m0r.v[j] * (pr_.v[j] - xr.v[j]) + m1r.v[j] * (nr_.v[j] - xr.v[j]);
        k.v[j] = xk.v[j] + m0k.v[j] * (pk_.v[j] - xk.v[j]) + m1k.v[j] * (nk_.v[j] - xk.v[j]);
        v.v[j] = xv.v[j] + m0v.v[j] * (pv_.v[j] - xv.v[j]) + m1v.v[j] * (nv_.v[j] - xv.v[j]);
        kk.v[j] = k.v[j] * kkp.v[j]; ss += kk.v[j] * kk.v[j];
      }
      ss = grp16sum(ss);
      const float inrm = 1.f / fmaxf(sqrtf(ss), 1e-12f);
#pragma unroll
      for (int j = 0; j < 4; ++j) {
        kk.v[j] *= inrm;
        {
          const float nx = -(w00.v[j] + wl0.v[j]);
          const float sp = fmaxf(nx, 0.f) + __logf(1.f + __expf(-fabsf(nx)));
          e0_.v[j] = __expf(-sp - 0.5f);
          const float a = sigmoidf_(a00.v[j] + al0.v[j]); a0_.v[j] = a;
          bon += r.v[j] * k.v[j] * (1.f + (a - 1.f) * kap.v[j]) * rkp.v[j];
        }
        {
          const float nx = -(w01.v[j] + wl1.v[j]);
          const float sp = fmaxf(nx, 0.f) + __logf(1.f + __expf(-fabsf(nx)));
          e1_.v[j] = __expf(-sp - 0.5f);
          const float a = sigmoidf_(a01.v[j] + al1.v[j]); a1_.v[j] = a;
          bon += r.v[j] * k.v[j] * (1.f + (a - 1.f) * kap.v[j]) * rkp.v[j];
        }
      }
      bon = grp16sum(bon);
      if ((lane & 15) == 0) BON[(long)t * 8 + hf * 4 + (lane >> 4)] = bon;
      const long o = (long)t * 512 + c0;
      st4bf(RR + o, r); st4bf(RK + o, k); st4bf(RV + o, v); st4bf(RKK + o, kk);
      st4bf(RE + o, e0_); st4bf(RE + (long)T * 512 + o, e1_); st4bf(RA + o, a0_); st4bf(RA + (long)T * 512 + o, a1_);
    }
  }
  __syncthreads();
}

#define SBAR() __builtin_amdgcn_sched_barrier(0)
__device__ __forceinline__ int crow(int r, int hi) { return (r & 3) + 8 * (r >> 2) + 4 * hi; }
template <int DK> struct AC {
  static constexpr float SCALE = (DK == 64) ? 0.125f : 0.07216878364870323f;
  static constexpr float THR = 8.f;
  static constexpr int NKG = DK / 64;
  static constexpr int SHM_K = 64 * DK * 2, SHM_V = 64 * 128 * 2;
};
template <int DK>
__device__ __forceinline__ void partialSM(f32x16& p0, f32x16& p1, float& m_reg, float& mn, float& alpha) {
  constexpr float C = AC<DK>::SCALE * 1.4426950408889634f;
  float pmax = p0[0];
#pragma unroll
  for (int r = 1; r < 16; ++r) pmax = fmaxf(pmax, p0[r]);
#pragma unroll
  for (int r = 0; r < 16; ++r) pmax = fmaxf(pmax, p1[r]);
  { auto rr = __builtin_amdgcn_permlane32_swap(__float_as_uint(pmax), __float_as_uint(pmax), false, false);
    pmax = fmaxf(__uint_as_float(rr[0]), __uint_as_float(rr[1])); }
  if (__builtin_expect(__all(pmax - m_reg <= AC<DK>::THR / AC<DK>::SCALE), 1)) { mn = m_reg; alpha = 1.f; }
  else { mn = fmaxf(m_reg, pmax); alpha = __builtin_amdgcn_exp2f((m_reg - mn) * C); m_reg = mn; }
  float mnC = -mn * C;
#pragma unroll
  for (int r = 0; r < 16; ++r) p0[r] = fmaf(p0[r], C, mnC);
#pragma unroll
  for (int r = 0; r < 16; ++r) p1[r] = fmaf(p1[r], C, mnC);
#pragma unroll
  for (int r = 0; r < 16; ++r) p0[r] = __builtin_amdgcn_exp2f(p0[r]);
}
__device__ __forceinline__ void finishSM(f32x16& p0, f32x16& p1, float alpha, float& l_reg, bf16x8& pa0, bf16x8& pa1, bf16x8& pa2, bf16x8& pa3) {
#pragma unroll
  for (int r = 0; r < 16; ++r) p1[r] = __builtin_amdgcn_exp2f(p1[r]);
  float ps = 0;
#pragma unroll
  for (int r = 0; r < 16; ++r) ps += p0[r];
#pragma unroll
  for (int r = 0; r < 16; ++r) ps += p1[r];
  { auto rr = __builtin_amdgcn_permlane32_swap(__float_as_uint(ps), __float_as_uint(ps), false, false);
    ps = __uint_as_float(rr[0]) + __uint_as_float(rr[1]); }
  l_reg = l_reg * alpha + ps;
#define PK4(Pv, BASE, OUT) do { unsigned a0 = cvtpk_asm(Pv[BASE + 0], Pv[BASE + 1]), a1 = cvtpk_asm(Pv[BASE + 2], Pv[BASE + 3]);   \
    unsigned b0 = cvtpk_asm(Pv[BASE + 4], Pv[BASE + 5]), b1 = cvtpk_asm(Pv[BASE + 6], Pv[BASE + 7]);                              \
    auto r0 = __builtin_amdgcn_permlane32_swap(a0, b0, false, false); auto r1 = __builtin_amdgcn_permlane32_swap(a1, b1, false, false); \
    u32x4 w = {r0[0], r1[0], r0[1], r1[1]}; OUT = *reinterpret_cast<bf16x8*>(&w); } while (0)
  PK4(p0, 0, pa0); PK4(p0, 8, pa1); PK4(p1, 0, pa2); PK4(p1, 8, pa3);
#undef PK4
}
template <int DK>
__device__ __forceinline__ void qkt(f32x16& p0, f32x16& p1, const char* Ks, const bf16x8* qr, int r32, int hi) {
  p0 = f32x16{}; p1 = f32x16{};
  const int sw = (r32 & 7) << 4;
  const char* kb[4];
#pragma unroll
  for (int q = 0; q < 4; ++q) kb[q] = Ks + r32 * (DK * 2) + ((q * 32 + hi * 16) ^ sw);
#pragma unroll
  for (int d0 = 0; d0 < DK / 16; ++d0) {
    bf16x8 b0 = *reinterpret_cast<const bf16x8*>(kb[d0 & 3] + (d0 >> 2) * 128);
    bf16x8 b1 = *reinterpret_cast<const bf16x8*>(kb[d0 & 3] + (d0 >> 2) * 128 + 32 * (DK * 2));
    p0 = __builtin_amdgcn_mfma_f32_32x32x16_bf16(b0, qr[d0], p0, 0, 0, 0);
    p1 = __builtin_amdgcn_mfma_f32_32x32x16_bf16(b1, qr[d0], p1, 0, 0, 0); }
}
__device__ __forceinline__ int v_st(int k, int c) { const int kk = (k & ~0xC) | ((k & 4) << 1) | ((k & 8) >> 1); return ((kk >> 3) * 4 + (c >> 5)) * 512 + ((kk & 7) * 32 + (c & 31)) * 2; }
__device__ __forceinline__ int v_rd_base(int lane) { return ((lane & 3) << 3) | (((lane >> 2) & 3) << 6) | (((lane >> 4) & 1) << 5) | (((lane >> 5) & 1) << 8); }
constexpr int v_rd_off(int d0, int ks, int half) { return d0 * 512 + ks * 4096 + half * 2048; }
template <int OFF> __device__ __forceinline__ s16x4 tr_read(int vb) {
  s16x4 r; asm volatile("ds_read_b64_tr_b16 %0, %1 offset:%2" : "=&v"(r) : "v"(vb), "i"(OFF) : "memory"); return r;
}
template <int D0> __device__ __forceinline__ void pv_one(f32x16& od, int vb, bf16x8 pa0, bf16x8 pa1, bf16x8 pa2, bf16x8 pa3) {
  const s16x4 l0 = tr_read<v_rd_off(D0, 0, 0)>(vb), h0 = tr_read<v_rd_off(D0, 0, 1)>(vb), l1 = tr_read<v_rd_off(D0, 1, 0)>(vb), h1 = tr_read<v_rd_off(D0, 1, 1)>(vb);
  const s16x4 l2 = tr_read<v_rd_off(D0, 2, 0)>(vb), h2 = tr_read<v_rd_off(D0, 2, 1)>(vb), l3 = tr_read<v_rd_off(D0, 3, 0)>(vb), h3 = tr_read<v_rd_off(D0, 3, 1)>(vb);
  asm volatile("s_waitcnt lgkmcnt(0)" ::: "memory"); SBAR();
#define PKV(L, H) (bf16x8){L[0], L[1], L[2], L[3], H[0], H[1], H[2], H[3]}
  od = __builtin_amdgcn_mfma_f32_32x32x16_bf16(pa0, PKV(l0, h0), od, 0, 0, 0);
  od = __builtin_amdgcn_mfma_f32_32x32x16_bf16(pa1, PKV(l1, h1), od, 0, 0, 0);
  od = __builtin_amdgcn_mfma_f32_32x32x16_bf16(pa2, PKV(l2, h2), od, 0, 0, 0);
  od = __builtin_amdgcn_mfma_f32_32x32x16_bf16(pa3, PKV(l3, h3), od, 0, 0, 0);
#undef PKV
}
__device__ __forceinline__ void pv_d0(f32x16* o, int vb, bf16x8 pa0, bf16x8 pa1, bf16x8 pa2, bf16x8 pa3) {
  pv_one<0>(o[0], vb, pa0, pa1, pa2, pa3); pv_one<1>(o[1], vb, pa0, pa1, pa2, pa3); pv_one<2>(o[2], vb, pa0, pa1, pa2, pa3); pv_one<3>(o[3], vb, pa0, pa1, pa2, pa3);
}
__device__ __forceinline__ void ostore(float* p, float v) { *p = v; }
__device__ __forceinline__ void ostore(u16* p, float v) { *p = f2bf(v); }

template <int DK, int SD, int LDQ, int LDK, int LDV, int LDO, typename TO>
__device__ __forceinline__ void attn_body(const u16* __restrict__ Qb, const u16* __restrict__ Kh, const u16* __restrict__ Vh,
                                          TO* __restrict__ Ob, int seq, char* lds) {
  const int TIDX = opaque_tid();
  constexpr int SHM_V = AC<DK>::SHM_V, SHM_K = AC<DK>::SHM_K, NKG = AC<DK>::NKG, KG = DK / 8;
  const int tid = TIDX, wid = tid >> 6, lane = tid & 63, r32 = lane & 31, hi = lane >> 5;
  char* V_lds = lds; char* K_lds = lds + 2 * SHM_V;
  float* wsl = (float*)(lds + 2 * SHM_V + 2 * SHM_K) + wid * 64; float* li_l = wsl; float* al_l = wsl + 32;
  float m_reg = -1e30f, l_reg = 0; f32x16 o[4] = {}; bf16x8 qr[DK / 16];
  const u16* Qw = Qb + (long)(wid * 32 + r32) * LDQ + hi * 8;
#pragma unroll
  for (int d0 = 0; d0 < DK / 16; ++d0) qr[d0] = *reinterpret_cast<const bf16x8*>(Qw + d0 * 16);
  const int sr = tid >> 4, sc = (tid & 15) * 8, vst0 = v_st(sr, sc), vst1 = v_st(32 + sr, sc);
  const int vb0 = (int)(uintptr_t)V_lds + v_rd_base(lane);
  struct { bf16x8 vs0, vs1, ks[NKG]; } sr_[SD];
#define SLOAD(i, k0) do { sr_[i].vs0 = *reinterpret_cast<const bf16x8*>(&Vh[(long)((k0) + sr) * LDV + sc]); \
    sr_[i].vs1 = *reinterpret_cast<const bf16x8*>(&Vh[(long)((k0) + 32 + sr) * LDV + sc]); \
    _Pragma("unroll") for (int g_ = 0; g_ < NKG; ++g_) { const int gi_ = tid + 512 * g_; const int kr_ = gi_ / KG, kc_ = (gi_ % KG) * 8; \
      sr_[i].ks[g_] = *reinterpret_cast<const bf16x8*>(&Kh[(long)((k0) + kr_) * LDK + kc_]); } } while (0)
#define SWRITE(b, i) do { *(bf16x8*)(V_lds + (b) * SHM_V + vst0) = sr_[i].vs0; *(bf16x8*)(V_lds + (b) * SHM_V + vst1) = sr_[i].vs1; \
    _Pragma("unroll") for (int g_ = 0; g_ < NKG; ++g_) { const int gi_ = tid + 512 * g_; const int kr_ = gi_ / KG, kc_ = (gi_ % KG) * 16; \
      *(bf16x8*)(K_lds + (b) * SHM_K + kr_ * (DK * 2) + (kc_ ^ ((kr_ & 7) << 4))) = sr_[i].ks[g_]; } } while (0)
#define SWAIT() do { if constexpr (SD == 2) { if constexpr (NKG == 1) asm volatile("s_waitcnt vmcnt(3)" ::: "memory"); else asm volatile("s_waitcnt vmcnt(5)" ::: "memory"); } \
    else asm volatile("s_waitcnt vmcnt(0)" ::: "memory"); } while (0)
#define RESC(a) do { if (__any((a) < 1.f)) { if (hi == 0) al_l[r32] = (a); asm volatile("s_waitcnt lgkmcnt(0)" ::: "memory"); \
    _Pragma("unroll") for (int d = 0; d < 4; ++d) _Pragma("unroll") for (int r = 0; r < 16; ++r) o[d][r] *= al_l[crow(r, hi)]; } } while (0)
  f32x16 pA0, pA1, pB0, pB1; float mnA, mnB, alA, alB; bf16x8 pa0, pa1, pa2, pa3; const int NT = seq / 64;
  constexpr int SE = 0, SO = SD - 1;
  SLOAD(SE, 0); asm volatile("s_waitcnt vmcnt(0)" ::: "memory"); SWRITE(0, SE); __syncthreads();
  qkt<DK>(pA0, pA1, K_lds, qr, r32, hi); partialSM<DK>(pA0, pA1, m_reg, mnA, alA);
  SLOAD(SO, 64); if constexpr (SD == 2) { if (2 < NT) SLOAD(SE, 2 * 64); }
  SWAIT(); SWRITE(1, SO); __syncthreads();
  for (int j = 1; j + 1 < NT; j += 2) {
    SBAR(); qkt<DK>(pB0, pB1, K_lds + SHM_K, qr, r32, hi);
    finishSM(pA0, pA1, alA, l_reg, pa0, pa1, pa2, pa3); SBAR();
    SLOAD(SO, (j + SD) * 64); SBAR();
    pv_d0(o, vb0, pa0, pa1, pa2, pa3); partialSM<DK>(pB0, pB1, m_reg, mnB, alB);
    __syncthreads(); SWAIT(); SWRITE(0, SE);
    RESC(alB); __syncthreads();
    SBAR(); qkt<DK>(pA0, pA1, K_lds, qr, r32, hi);
    finishSM(pB0, pB1, alB, l_reg, pa0, pa1, pa2, pa3); SBAR();
    if (SD == 1 || j + 3 < NT) SLOAD(SE, (j + 1 + SD) * 64); SBAR();
    pv_d0(o, vb0 + SHM_V, pa0, pa1, pa2, pa3); partialSM<DK>(pA0, pA1, m_reg, mnA, alA);
    __syncthreads(); SWAIT(); SWRITE(1, SO);
    RESC(alA); __syncthreads();
  }
  SBAR(); qkt<DK>(pB0, pB1, K_lds + SHM_K, qr, r32, hi);
  finishSM(pA0, pA1, alA, l_reg, pa0, pa1, pa2, pa3); SBAR();
  pv_d0(o, vb0, pa0, pa1, pa2, pa3); partialSM<DK>(pB0, pB1, m_reg, mnB, alB);
  __syncthreads(); RESC(alB);
  finishSM(pB0, pB1, alB, l_reg, pa0, pa1, pa2, pa3); SBAR();
  pv_d0(o, vb0 + SHM_V, pa0, pa1, pa2, pa3);
  if (hi == 0) li_l[r32] = l_reg; asm volatile("s_waitcnt lgkmcnt(0)" ::: "memory");
  float rli[16];
#pragma unroll
  for (int r = 0; r < 16; ++r) rli[r] = __builtin_amdgcn_rcpf(li_l[crow(r, hi)]);
  TO* Ow = Ob + (long)(wid * 32) * LDO;
#pragma unroll
  for (int r = 0; r < 16; ++r) { const int orow = crow(r, hi);
#pragma unroll
    for (int d0 = 0; d0 < 4; ++d0) ostore(&Ow[(long)orow * LDO + d0 * 32 + r32], o[d0][r] * rli[r]); }
#undef SLOAD
#undef SWRITE
#undef SWAIT
#undef RESC
}

template <int DK, int LDQ, int LDK, int LDV, int LDO, typename TO>
__device__ __forceinline__ void attn_body_simple(const u16* __restrict__ Qb, const u16* __restrict__ Kh, const u16* __restrict__ Vh,
                                                 TO* __restrict__ Ob, int seq, char* lds) {
  const int TIDX = opaque_tid();
  constexpr int SHM_V = AC<DK>::SHM_V, SHM_K = AC<DK>::SHM_K, NKG = AC<DK>::NKG, KG = DK / 8;
  const int tid = TIDX, wid = tid >> 6, lane = tid & 63, r32 = lane & 31, hi = lane >> 5;
  char* V_lds = lds; char* K_lds = lds + 2 * SHM_V;
  float* wsl = (float*)(lds + 2 * SHM_V + 2 * SHM_K) + wid * 64; float* li_l = wsl; float* al_l = wsl + 32;
  float m_reg = -1e30f, l_reg = 0; f32x16 o[4] = {}; bf16x8 qr[DK / 16];
  const u16* Qw = Qb + (long)(wid * 32 + r32) * LDQ + hi * 8;
#pragma unroll
  for (int d0 = 0; d0 < DK / 16; ++d0) qr[d0] = *reinterpret_cast<const bf16x8*>(Qw + d0 * 16);
  const int sr = tid >> 4, sc = (tid & 15) * 8, vst0 = v_st(sr, sc), vst1 = v_st(32 + sr, sc);
  const int vb0 = (int)(uintptr_t)V_lds + v_rd_base(lane);
  bf16x8 vs0, vs1, ks[NKG];
#define SLOAD(k0) do { vs0 = *reinterpret_cast<const bf16x8*>(&Vh[(long)((k0) + sr) * LDV + sc]); \
    vs1 = *reinterpret_cast<const bf16x8*>(&Vh[(long)((k0) + 32 + sr) * LDV + sc]); \
    _Pragma("unroll") for (int g_ = 0; g_ < NKG; ++g_) { const int gi_ = tid + 512 * g_; const int kr_ = gi_ / KG, kc_ = (gi_ % KG) * 8; \
      ks[g_] = *reinterpret_cast<const bf16x8*>(&Kh[(long)((k0) + kr_) * LDK + kc_]); } } while (0)
#define SWRITE(b) do { *(bf16x8*)(V_lds + (b) * SHM_V + vst0) = vs0; *(bf16x8*)(V_lds + (b) * SHM_V + vst1) = vs1; \
    _Pragma("unroll") for (int g_ = 0; g_ < NKG; ++g_) { const int gi_ = tid + 512 * g_; const int kr_ = gi_ / KG, kc_ = (gi_ % KG) * 16; \
      *(bf16x8*)(K_lds + (b) * SHM_K + kr_ * (DK * 2) + (kc_ ^ ((kr_ & 7) << 4))) = ks[g_]; } } while (0)
  const int NT = seq / 64;
  SLOAD(0); SWRITE(0); __syncthreads();
#pragma unroll 1
  for (int j = 0; j < NT; ++j) {
    const int cur = j & 1;
    if (j + 1 < NT) SLOAD((j + 1) * 64);
    f32x16 p0, p1; float mn, al; bf16x8 pa0, pa1, pa2, pa3;
    qkt<DK>(p0, p1, K_lds + cur * SHM_K, qr, r32, hi);
    partialSM<DK>(p0, p1, m_reg, mn, al);
    if (__any(al < 1.f)) { if (hi == 0) al_l[r32] = al; asm volatile("s_waitcnt lgkmcnt(0)" ::: "memory");
#pragma unroll
      for (int d = 0; d < 4; ++d)
#pragma unroll
        for (int r = 0; r < 16; ++r) o[d][r] *= al_l[crow(r, hi)]; }
    finishSM(p0, p1, al, l_reg, pa0, pa1, pa2, pa3); SBAR();
    pv_d0(o, vb0 + cur * SHM_V, pa0, pa1, pa2, pa3);
    if (j + 1 < NT) SWRITE(cur ^ 1);
    __syncthreads();
  }
  if (hi == 0) li_l[r32] = l_reg; asm volatile("s_waitcnt lgkmcnt(0)" ::: "memory");
  float rli[16];
#pragma unroll
  for (int r = 0; r < 16; ++r) rli[r] = __builtin_amdgcn_rcpf(li_l[crow(r, hi)]);
  TO* Ow = Ob + (long)(wid * 32) * LDO;
#pragma unroll
  for (int r = 0; r < 16; ++r) { const int orow = crow(r, hi);
#pragma unroll
    for (int d0 = 0; d0 < 4; ++d0) ostore(&Ow[(long)orow * LDO + d0 * 32 + r32], o[d0][r] * rli[r]); }
#undef SLOAD
#undef SWRITE
}

__device__ __forceinline__ void rwkv_item(const P& p, int l, int item, char* lds) {
  const int TIDX = opaque_tid();
  char* ws = p.ws;
  const int d = item & 1, b = (item >> 1) & 3, h = item >> 3;
  constexpr int CM = 16, REC = 584, BUF = CM * REC, NCH = S / (2 * CM), OFF_SC = 448, OFF_D = 456;
  float* buf0 = (float*)lds; float* buf1 = buf0 + BUF; float* yout = buf1 + BUF;
  const int tid = TIDX, wid = tid >> 6, lane = tid & 63;
  const bool consumer = wid < 4;
  const u16* RR = (const u16*)(ws + RW_R); const u16* RK = (const u16*)(ws + RW_K); const u16* RV = (const u16*)(ws + RW_V); const u16* RKK = (const u16*)(ws + RW_KK);
  const u16* RA = (const u16*)(ws + RW_A) + (long)d * T * 512; const u16* RE = (const u16*)(ws + RW_E) + (long)d * T * 512;
  u16* YR = (u16*)(ws + OO_YR) + (long)d * T * 512;
  const int sg = wid & 3;
  struct PR { uint2 r[2], k[2], v[2], kk[2], a[2], e[2]; };
  const int pm = sg * 4 + (lane >> 4), pk0 = (lane & 15) * 4;
  const F4 ka4 = ld4f(p.in[I_KA] + l * 512 + h * 64 + pk0);
  auto pload = [&](int c) {
    PR x;
#pragma unroll
    for (int q = 0; q < 2; ++q) {
      const int sidx = c * (2 * CM) + pm * 2 + q, t = d ? (S - 1 - sidx) : sidx;
      const long off = ((long)(b * S + t)) * 512 + h * 64 + pk0;
      x.r[q] = *reinterpret_cast<const uint2*>(RR + off); x.k[q] = *reinterpret_cast<const uint2*>(RK + off); x.v[q] = *reinterpret_cast<const uint2*>(RV + off);
      x.kk[q] = *reinterpret_cast<const uint2*>(RKK + off); x.a[q] = *reinterpret_cast<const uint2*>(RA + off); x.e[q] = *reinterpret_cast<const uint2*>(RE + off);
    }
    return x;
  };
  auto unp = [](const uint2& u, int j) { const unsigned w = (j < 2) ? u.x : u.y; return (j & 1) ? __uint_as_float(w & 0xffff0000u) : __uint_as_float(w << 16); };
  auto pfinish = [&](const PR& x, float* buf) {
    float* rec = buf + pm * REC;
    f32x4 ww, bw, kw, b2v, k2v, v1v, v2v; float d1[4], d2[4], d3[4], d4[4];
    float c1 = 0.f, c2 = 0.f, c3 = 0.f, c4 = 0.f, c5 = 0.f, c6 = 0.f, c7 = 0.f, c8 = 0.f;
#pragma unroll
    for (int j = 0; j < 4; ++j) {
      const float r1 = unp(x.r[0], j), k1r = unp(x.k[0], j), v1 = unp(x.v[0], j), kk1 = unp(x.kk[0], j), a1 = unp(x.a[0], j), e1 = unp(x.e[0], j);
      const float r2 = unp(x.r[1], j), k2r = unp(x.k[1], j), v2 = unp(x.v[1], j), kk2 = unp(x.kk[1], j), a2 = unp(x.a[1], j), e2 = unp(x.e[1], j);
      const float w1 = __expf(-e1), w2 = __expf(-e2);
      const float z1 = -kk1, z2 = -kk2, b1 = kk1 * a1, b2 = kk2 * a2;
      const float k1 = k1r * (1.f + (a1 - 1.f) * ka4.v[j]), k2 = k2r * (1.f + (a2 - 1.f) * ka4.v[j]);
      const float w2r2 = w2 * r2;
      ww[j] = w1 * w2; bw[j] = b1 * w2; kw[j] = k1 * w2; b2v[j] = b2; k2v[j] = k2; v1v[j] = v1; v2v[j] = v2;
      d1[j] = z1; d2[j] = w1 * z2; d3[j] = w1 * r1; d4[j] = w1 * w2r2;
      c1 += b1 * z2; c2 += k1 * z2; c3 += b1 * r1; c4 += k1 * r1; c5 += b1 * w2r2; c6 += k1 * w2r2; c7 += b2 * r2; c8 += k2 * r2;
    }
    *reinterpret_cast<f32x4*>(rec + pk0) = ww;        *reinterpret_cast<f32x4*>(rec + 64 + pk0) = bw;   *reinterpret_cast<f32x4*>(rec + 128 + pk0) = kw;
    *reinterpret_cast<f32x4*>(rec + 192 + pk0) = b2v; *reinterpret_cast<f32x4*>(rec + 256 + pk0) = k2v;
    *reinterpret_cast<f32x4*>(rec + 320 + pk0) = v1v; *reinterpret_cast<f32x4*>(rec + 384 + pk0) = v2v;
    { uint2 q;
      q.x = cvtpk(d1[0], d1[1]); q.y = cvtpk(d1[2], d1[3]); *reinterpret_cast<uint2*>(rec + OFF_D + 0 * 32 + (lane & 15) * 2) = q;
      q.x = cvtpk(d2[0], d2[1]); q.y = cvtpk(d2[2], d2[3]); *reinterpret_cast<uint2*>(rec + OFF_D + 1 * 32 + (lane & 15) * 2) = q;
      q.x = cvtpk(d3[0], d3[1]); q.y = cvtpk(d3[2], d3[3]); *reinterpret_cast<uint2*>(rec + OFF_D + 2 * 32 + (lane & 15) * 2) = q;
      q.x = cvtpk(d4[0], d4[1]); q.y = cvtpk(d4[2], d4[3]); *reinterpret_cast<uint2*>(rec + OFF_D + 3 * 32 + (lane & 15) * 2) = q; }
    c1 = grp16sum(c1); c2 = grp16sum(c2); c3 = grp16sum(c3); c4 = grp16sum(c4); c5 = grp16sum(c5); c6 = grp16sum(c6); c7 = grp16sum(c7); c8 = grp16sum(c8);
    if ((lane & 15) == 0) { *reinterpret_cast<f32x4*>(rec + OFF_SC) = f32x4{c1, c2, c3, c4}; *reinterpret_cast<f32x4*>(rec + OFF_SC + 4) = f32x4{c5, c6, c7, c8}; }
  };
  auto store_y = [&](int c) {
    const float* yo = yout + (c & 1) * (32 * 64);
#pragma unroll
    for (int i = 0; i < 8; ++i) {
      const int s = sg + 4 * i, sidx = c * 32 + s, t = d ? (S - 1 - sidx) : sidx;
      YR[((long)(b * S + t)) * 512 + h * 64 + lane] = f2bf(yo[s * 64 + lane]);
    }
  };
  const int j16 = lane & 15, g = lane >> 4, row = (wid & 3) * 16 + j16;
  const int aoff = OFF_D + (j16 & 3) * 32;
  f2 st[8];
#pragma unroll
  for (int i = 0; i < 8; ++i) st[i] = f2{0.f, 0.f};
  struct Ops { bf16x8 a0, a1; f2 v; f32x4 s0, s1; };
  auto ldops = [&](const float* rec) {
    Ops o;
    o.a0 = *reinterpret_cast<const bf16x8*>(rec + aoff + g * 4);
    o.a1 = *reinterpret_cast<const bf16x8*>(rec + aoff + 16 + g * 4);
    o.v = f2{rec[320 + row], rec[384 + row]};
    o.s0 = *reinterpret_cast<const f32x4*>(rec + OFF_SC); o.s1 = *reinterpret_cast<const f32x4*>(rec + OFF_SC + 4);
    return o;
  };
  PR pnx;
  if (!consumer) { PR p0 = pload(0); pfinish(p0, buf0); pnx = pload(1); }
  __syncthreads();
  for (int c = 0; c < NCH; ++c) {
    float* buf = (c & 1) ? buf1 : buf0;
    if (consumer) {
      float* yo = yout + (c & 1) * (32 * 64);
      auto step = [&](const Ops& cur, int ms) {
        const float* rec = buf + ms * REC;
        f32x4 ww[4], bw[4], kw[4], b2[4], k2[4];
#pragma unroll
        for (int m = 0; m < 2; ++m)
#pragma unroll
          for (int hq = 0; hq < 2; ++hq) {
            const int o = m * 32 + g * 8 + hq * 4;
            ww[m * 2 + hq] = *reinterpret_cast<const f32x4*>(rec + o);        bw[m * 2 + hq] = *reinterpret_cast<const f32x4*>(rec + 64 + o);
            kw[m * 2 + hq] = *reinterpret_cast<const f32x4*>(rec + 128 + o);  b2[m * 2 + hq] = *reinterpret_cast<const f32x4*>(rec + 192 + o);
            k2[m * 2 + hq] = *reinterpret_cast<const f32x4*>(rec + 256 + o);
          }
        u32x4 q0, q1;
        q0[0] = cvtpk(st[0][0], st[0][1]); q0[1] = cvtpk(st[1][0], st[1][1]); q0[2] = cvtpk(st[2][0], st[2][1]); q0[3] = cvtpk(st[3][0], st[3][1]);
        q1[0] = cvtpk(st[4][0], st[4][1]); q1[1] = cvtpk(st[5][0], st[5][1]); q1[2] = cvtpk(st[6][0], st[6][1]); q1[3] = cvtpk(st[7][0], st[7][1]);
        f32x4 dd = f32x4{0.f, 0.f, 0.f, 0.f};
        dd = __builtin_amdgcn_mfma_f32_16x16x32_bf16(cur.a0, __builtin_bit_cast(bf16x8, q0), dd, 0, 0, 0);
        dd = __builtin_amdgcn_mfma_f32_16x16x32_bf16(cur.a1, __builtin_bit_cast(bf16x8, q1), dd, 0, 0, 0);
        const float v1 = cur.v[0], v2 = cur.v[1];
        const float sa1 = dd[0];
        const float sa2 = dd[1] + sa1 * cur.s0[0] + v1 * cur.s0[1];
        const float y1 = dd[2] + sa1 * cur.s0[2] + v1 * cur.s0[3];
        const float y2 = dd[3] + sa1 * cur.s1[0] + v1 * cur.s1[1] + sa2 * cur.s1[2] + v2 * cur.s1[3];
        const f2 sa1v = f2{sa1, sa1}, v1v = f2{v1, v1}, sa2v = f2{sa2, sa2}, v2v = f2{v2, v2};
#pragma unroll
        for (int q = 0; q < 4; ++q) {
#pragma unroll
          for (int hh = 0; hh < 2; ++hh) {
            const f2 w_ = f2{ww[q][2 * hh], ww[q][2 * hh + 1]}, bw_ = f2{bw[q][2 * hh], bw[q][2 * hh + 1]}, kw_ = f2{kw[q][2 * hh], kw[q][2 * hh + 1]};
            const f2 b2_ = f2{b2[q][2 * hh], b2[q][2 * hh + 1]}, k2_ = f2{k2[q][2 * hh], k2[q][2 * hh + 1]};
            st[q * 2 + hh] = st[q * 2 + hh] * w_ + ((sa1v * bw_ + v1v * kw_) + (sa2v * b2_ + v2v * k2_));
          }
        }
        if (g == 0) { yo[(2 * ms) * 64 + row] = y1; yo[(2 * ms + 1) * 64 + row] = y2; }
      };
      Ops oa = ldops(buf);
#pragma unroll 1
      for (int ms = 0; ms < CM; ms += 2) {
        const Ops ob = ldops(buf + (ms + 1) * REC);
        step(oa, ms);
        if (ms + 2 < CM) oa = ldops(buf + (ms + 2) * REC);
        step(ob, ms + 1);
      }
    } else {
      if (c + 1 < NCH) { pfinish(pnx, (c & 1) ? buf0 : buf1); if (c + 2 < NCH) pnx = pload(c + 2); }
      if (c >= 1) store_y(c - 1);
    }
    __syncthreads();
  }
  if (!consumer) store_y(NCH - 1);
  __syncthreads();
}

__device__ __forceinline__ bf16x8 pad8(s16x4 v) { return bf16x8{v[0], v[1], v[2], v[3], 0, 0, 0, 0}; }
__device__ __forceinline__ void cmul(float ar, float ai, float br, float bi, float& cr, float& ci) { cr = ar * br - ai * bi; ci = ar * bi + ai * br; }
__device__ __forceinline__ void s5_item(const P& p, int l, int item, char* lds) {
  const int TIDX = opaque_tid();
  char* ws = p.ws;
  const int d = item & 1, g = (item >> 1) & 31, b = item >> 6;
  const int tid = TIDX, wv = tid >> 6, lane = tid & 63, jj = lane & 15, gq = lane >> 4;
  const long pg = ((long)(l * 2 + d) * 32 + g);
  const float* lre = p.in[I_LRE] + pg * 64; const float* lim = p.in[I_LIM] + pg * 64;
  const float dt = __expf(p.in[I_LDT][pg]);
  const float* bre = p.in[I_BRE] + pg * 64 * 16; const float* bim = p.in[I_BIM] + pg * 64 * 16;
  const float* cre = p.in[I_CRE] + pg * 16 * 64; const float* cim = p.in[I_CIM] + pg * 16 * 64;
  const u16* PB = (const u16*)(ws + O_P);
  u16* YS = (u16*)(ws + OO_YS) + (long)d * T * 512;
  float ar[16], ai[16];
  s16x4 Bop[8], Cop[8];
#pragma unroll
  for (int tl = 0; tl < 8; ++tl) {
#pragma unroll
    for (int e = 0; e < 2; ++e) {
      const int stt = tl * 8 + gq * 2 + e;
      const float lr = fminf(lre[stt], -1e-4f), li = lim[stt];
      const float mag = __expf(lr * dt); float sn, cs; sincos_rev(li * dt, sn, cs);
      ar[tl * 2 + e] = mag * cs; ai[tl * 2 + e] = mag * sn;
    }
    {
      const int i = lane & 15; const int stt = tl * 8 + (i >> 2) * 2 + (i & 1), part = (i >> 1) & 1;
      const float lr = fminf(lre[stt], -1e-4f), li = lim[stt];
      const float mag = __expf(lr * dt); float sn, cs; sincos_rev(li * dt, sn, cs);
      const float abr = mag * cs, abi = mag * sn, den = lr * lr + li * li;
      const float cor = ((abr - 1.f) * lr + abi * li) / den, coi = (abi * lr - (abr - 1.f) * li) / den;
      float vals[4];
#pragma unroll
      for (int c = 0; c < 4; ++c) {
        const float br_ = bre[stt * 16 + gq * 4 + c], bi_ = bim[stt * 16 + gq * 4 + c];
        vals[c] = part ? (cor * bi_ + coi * br_) : (cor * br_ - coi * bi_);
      }
      Bop[tl] = s16x4{(short)f2bf(vals[0]), (short)f2bf(vals[1]), (short)f2bf(vals[2]), (short)f2bf(vals[3])};
      float cv[4];
#pragma unroll
      for (int j = 0; j < 4; ++j) {
        const int st2 = tl * 8 + gq * 2 + (j & 1);
        cv[j] = (j >> 1) ? -cim[i * 64 + st2] : cre[i * 64 + st2];
      }
      Cop[tl] = s16x4{(short)f2bf(cv[0]), (short)f2bf(cv[1]), (short)f2bf(cv[2]), (short)f2bf(cv[3])};
    }
  }
  int bad_ = 9999;
#define UPD(v, code, th) do { if (!(fabsf(v) < (th))) bad_ = min(bad_, (code)); } while (0)
#pragma unroll
  for (int k = 0; k < 16; ++k) { UPD(ar[k] * ar[k] + ai[k] * ai[k], 30, 1.0f); }
#pragma unroll
  for (int tl = 0; tl < 8; ++tl)
#pragma unroll
    for (int c = 0; c < 4; ++c) { UPD(bf2f((u16)Bop[tl][c]), 31, 2.f); UPD(bf2f((u16)Cop[tl][c]), 32, 2.f); }
  float* aval = (float*)lds + 1024 + 32 * 512;
  if (wv == 0 && jj == 0) {
#pragma unroll
    for (int tl = 0; tl < 8; ++tl)
#pragma unroll
      for (int e = 0; e < 2; ++e) { const int stt = tl * 8 + gq * 2 + e; aval[stt * 2] = ar[tl * 2 + e]; aval[stt * 2 + 1] = ai[tl * 2 + e]; }
  }
  const int chunk = wv * 16 + jj;
  const long pcol = C_S5U + g * 16 + gq * 4;
  f32x4 x[8];
#pragma unroll
  for (int tl = 0; tl < 8; ++tl) x[tl] = f32x4{0.f, 0.f, 0.f, 0.f};
  auto tok_of = [&](int stp) { const int sidx = chunk * 32 + stp; const int t = d ? (S - 1 - sidx) : sidx; return (long)(b * S + t); };
  auto step_state = [&](s16x4 uf) {
#pragma unroll
    for (int tl = 0; tl < 8; ++tl) {
      const float xr0 = x[tl][0], xr1 = x[tl][1], xi0 = x[tl][2], xi1 = x[tl][3];
      f32x4 nx;
      nx[0] = ar[tl * 2] * xr0 - ai[tl * 2] * xi0; nx[2] = ar[tl * 2] * xi0 + ai[tl * 2] * xr0;
      nx[1] = ar[tl * 2 + 1] * xr1 - ai[tl * 2 + 1] * xi1; nx[3] = ar[tl * 2 + 1] * xi1 + ai[tl * 2 + 1] * xr1;
      x[tl] = __builtin_amdgcn_mfma_f32_16x16x32_bf16(pad8(Bop[tl]), pad8(uf), nx, 0, 0, 0);
    }
  };
#pragma unroll 1
  for (int g8 = 0; g8 < 4; ++g8) {
    s16x4 uf[8];
#pragma unroll
    for (int i = 0; i < 8; ++i) uf[i] = *reinterpret_cast<const s16x4*>(PB + tok_of(g8 * 8 + i) * NP + pcol);
#pragma unroll
    for (int i = 0; i < 8; ++i) { step_state(uf[i]);
#pragma unroll
      for (int c = 0; c < 4; ++c) UPD(bf2f((u16)uf[i][c]), 33, 20.f); }
  }
#pragma unroll
  for (int tl = 0; tl < 8; ++tl)
#pragma unroll
    for (int r = 0; r < 4; ++r) UPD(x[tl][r], 34, 50.f);
  __syncthreads();
  float* tot = (float*)lds;
  float* xs = (float*)lds + 1024;
#pragma unroll
  for (int tl = 0; tl < 8; ++tl)
#pragma unroll
    for (int r = 0; r < 4; ++r) xs[(tl * 4 + r) * 512 + tid] = x[tl][r];
#pragma unroll 1
  for (int tl = 0; tl < 8; ++tl) {
#pragma unroll
    for (int e = 0; e < 2; ++e) {
      const int stt = tl * 8 + gq * 2 + e;
      float pr_ = aval[stt * 2], pi_ = aval[stt * 2 + 1];
#pragma unroll
      for (int sq = 0; sq < 5; ++sq) { float nr, ni; cmul(pr_, pi_, pr_, pi_, nr, ni); pr_ = nr; pi_ = ni; }
      float xr = xs[(tl * 4 + e) * 512 + tid], xi = xs[(tl * 4 + 2 + e) * 512 + tid];
#pragma unroll
      for (int stg = 0; stg < 4; ++stg) {
        const int off = 1 << stg;
        const float or_ = __shfl_up(xr, off, 16), oi_ = __shfl_up(xi, off, 16);
        if (jj >= off) { float cr, ci; cmul(pr_, pi_, or_, oi_, cr, ci); xr += cr; xi += ci; }
        float nr, ni; cmul(pr_, pi_, pr_, pi_, nr, ni); pr_ = nr; pi_ = ni;
      }
      xs[(tl * 4 + e) * 512 + tid] = xr; xs[(tl * 4 + 2 + e) * 512 + tid] = xi;
      if (jj == 15) { float* tp = tot + (wv * 4 + gq) * 32 + tl * 4; tp[e] = xr; tp[2 + e] = xi; }
      UPD(xr, 35, 200.f); UPD(xi, 35, 200.f);
    }
  }
  __syncthreads();
#pragma unroll 1
  for (int tl = 0; tl < 8; ++tl) {
#pragma unroll
    for (int e = 0; e < 2; ++e) {
      const int stt = tl * 8 + gq * 2 + e;
      float pr_ = aval[stt * 2], pi_ = aval[stt * 2 + 1];
#pragma unroll
      for (int sq = 0; sq < 5; ++sq) { float nr, ni; cmul(pr_, pi_, pr_, pi_, nr, ni); pr_ = nr; pi_ = ni; }
      float qr_ = 1.f, qi_ = 0.f;
#pragma unroll
      for (int stg = 0; stg < 4; ++stg) {
        if (jj & (1 << stg)) { float cr, ci; cmul(qr_, qi_, pr_, pi_, cr, ci); qr_ = cr; qi_ = ci; }
        float nr, ni; cmul(pr_, pi_, pr_, pi_, nr, ni); pr_ = nr; pi_ = ni;
      }
      float Wr = 0.f, Wi = 0.f;
      for (int w2 = 0; w2 < wv; ++w2) {
        const float* tp = tot + (w2 * 4 + gq) * 32 + tl * 4;
        float cr, ci; cmul(pr_, pi_, Wr, Wi, cr, ci); Wr = cr + tp[e]; Wi = ci + tp[2 + e];
      }
      const float xr = xs[(tl * 4 + e) * 512 + tid], xi = xs[(tl * 4 + 2 + e) * 512 + tid];
      float er = __shfl_up(xr, 1, 16), ei = __shfl_up(xi, 1, 16);
      if (jj == 0) { er = 0.f; ei = 0.f; }
      float cr, ci; cmul(qr_, qi_, Wr, Wi, cr, ci);
      UPD(Wr, 36, 500.f); UPD(Wi, 36, 500.f); UPD(er + cr, 37, 500.f); UPD(ei + ci, 37, 500.f);
      xs[(tl * 4 + e) * 512 + tid] = er + cr; xs[(tl * 4 + 2 + e) * 512 + tid] = ei + ci;
    }
  }
#pragma unroll
  for (int tl = 0; tl < 8; ++tl)
#pragma unroll
    for (int r = 0; r < 4; ++r) x[tl][r] = xs[(tl * 4 + r) * 512 + tid];
  __syncthreads();
#pragma unroll 1
  for (int g8 = 0; g8 < 4; ++g8) {
    s16x4 uf[8];
#pragma unroll
    for (int i = 0; i < 8; ++i) uf[i] = *reinterpret_cast<const s16x4*>(PB + tok_of(g8 * 8 + i) * NP + pcol);
#pragma unroll
    for (int i = 0; i < 8; ++i) {
      step_state(uf[i]);
      f32x4 y = f32x4{0.f, 0.f, 0.f, 0.f};
#pragma unroll
      for (int tl = 0; tl < 8; ++tl) {
        const unsigned lo = cvtpk(x[tl][0], x[tl][1]), hi2 = cvtpk(x[tl][2], x[tl][3]);
        const s16x4 xb = s16x4{(short)(lo & 0xffffu), (short)(lo >> 16), (short)(hi2 & 0xffffu), (short)(hi2 >> 16)};
        y = __builtin_amdgcn_mfma_f32_16x16x32_bf16(pad8(Cop[tl]), pad8(xb), y, 0, 0, 0);
      }
#pragma unroll
      for (int tl = 0; tl < 8; ++tl) { UPD(x[tl][0], 38, 500.f); UPD(x[tl][1], 38, 500.f); UPD(x[tl][2], 38, 500.f); UPD(x[tl][3], 38, 500.f); }
      UPD(y[0], 39, 100.f); UPD(y[1], 39, 100.f); UPD(y[2], 39, 100.f); UPD(y[3], 39, 100.f);
      uint2 oo; oo.x = cvtpk(y[0], y[1]); oo.y = cvtpk(y[2], y[3]);
      *reinterpret_cast<uint2*>(YS + tok_of(g8 * 8 + i) * 512 + g * 16 + gq * 4) = oo;
    }
  }
  if (l == 0 && bad_ < 9999) atomicMin((int*)(ws + O_FLAG), bad_);
  __syncthreads();
}

__device__ __forceinline__ void phase5(const P& p, int l, int coff, int tmask = 15) {
  const int TIDX = opaque_tid();
  const int BIDX = opaque_bid();
  char* ws = p.ws;
  __shared__ int s_item;
  int* ctr = (int*)(ws + O_CTR) + l + coff;
  constexpr int N_RW = 64, N_S5 = 256, N_MLA = 256, N_DIFF = 512, N_ALL = N_RW + N_S5 + N_MLA + N_DIFF;
  for (;;) {
    __syncthreads();
    if (TIDX == 0) s_item = atomicAdd(ctr, 1);
    __syncthreads();
    int it = s_item;
    if (it >= N_ALL) break;
    if (it < N_RW) { if (tmask & 1) rwkv_item(p, l, it, smem); continue; }
    it -= N_RW;
    if (it < N_MLA) {
      const int qb = it & 15, hh = (it >> 4) & 3, b = it >> 6;
      const long bh = (long)(b * 4 + hh);
      if (tmask & 4) attn_body_simple<192, 192, 192, 128, 512, u16>((const u16*)(ws + QK_MQ) + (bh * S + qb * 256) * 192, (const u16*)(ws + QK_MK) + bh * S * 192,
                                                 (const u16*)(ws + QK_MV) + bh * S * 128, (u16*)(ws + OO_MO) + ((long)(b * S + qb * 256)) * 512 + hh * 128, S, smem);
      continue;
    }
    it -= N_MLA;
    if (it < N_DIFF) {
      const int qb = it & 15, h2 = (it >> 4) & 7, b = it >> 7;
      const long bh = (long)(b * 8 + h2);
      if (tmask & 8) attn_body<64, 2, 64, 64, NP, 1024, u16>((const u16*)(ws + QK_DQ) + (bh * S + qb * 256) * 64, (const u16*)(ws + QK_DK) + bh * S * 64,
                                                (const u16*)(ws + O_P) + (long)b * S * NP + C_DV + (h2 >> 1) * 128,
                                                (u16*)(ws + OO_DO) + ((long)(b * S + qb * 256)) * 1024 + h2 * 128, S, smem);
      continue;
    }
    it -= N_DIFF;
    if (tmask & 2) s5_item(p, l, it, smem);
  }
}

__device__ __forceinline__ void phase6(const P& p, int l) {
  const int TIDX = opaque_tid();
  const int BIDX = opaque_bid();
  char* ws = p.ws;
  const u16* __restrict__ PB = (const u16*)(ws + O_P);
  const u16* __restrict__ YS0 = (const u16*)(ws + OO_YS); const u16* __restrict__ YS1 = YS0 + (long)T * 512;
  const u16* __restrict__ YR0 = (const u16*)(ws + OO_YR); const u16* __restrict__ YR1 = YR0 + (long)T * 512;
  const u16* __restrict__ DO_ = (const u16*)(ws + OO_DO); const u16* __restrict__ MO = (const u16*)(ws + OO_MO);
  const u16* __restrict__ RV = (const u16*)(ws + RW_V); const float* __restrict__ BON = (const float*)(ws + RW_BON);
  u16* __restrict__ BR = (u16*)(ws + O_BR); u16* __restrict__ GS5 = (u16*)(ws + O_GS5);
  const int wid = TIDX >> 6, lane = TIDX & 63, c0 = lane * 8;
  const float lam_init = 0.8f - 0.6f * expf(-0.3f * (float)l);
  const float* dl = p.in[I_DLAM] + l * 256;
  const float lam_full = expf(wsum(dl[lane] * dl[64 + lane])) - expf(wsum(dl[128 + lane] * dl[192 + lane])) + lam_init;
  const F8 dsk = ld8f(p.in[I_S5D] + l * 512 + c0);
  const F8 sub = ld8f(p.in[I_SUBLN] + l * 128 + (lane & 15) * 8);
  const F8 lng = ld8f(p.in[I_LNG] + l * 512 + c0), lnb = ld8f(p.in[I_LNB] + l * 512 + c0);
  const int hD = lane >> 4, eD = (lane & 15) * 8;
  for (int t = BIDX * 8 + wid; t < T; t += gridDim.x * 8) {
    const u16* pr = PB + (long)t * NP;
    u16* br = BR + (long)t * 2048;
    const F8 u = ld8bf(pr + C_S5U + c0), ys0 = ld8bf(YS0 + (long)t * 512 + c0), ys1 = ld8bf(YS1 + (long)t * 512 + c0);
    const F8 o1 = ld8bf(DO_ + (long)t * 1024 + (hD * 2) * 128 + eD), o2 = ld8bf(DO_ + (long)t * 1024 + (hD * 2 + 1) * 128 + eD);
    const F8 zd = ld8bf(pr + C_DZ + c0), zm = ld8bf(pr + C_MZ + c0), zr = ld8bf(pr + C_RZ + c0);
    const F8 mo = ld8bf(MO + (long)t * 512 + c0);
    const F8 y0 = ld8bf(YR0 + (long)t * 512 + c0), y1 = ld8bf(YR1 + (long)t * 512 + c0), rv = ld8bf(RV + (long)t * 512 + c0);
    const float bon = BON[(long)t * 8 + (lane >> 3)];
    {
      F8 g;
#pragma unroll
      for (int j = 0; j < 8; ++j) {
        const float y = dsk.v[j] * u.v[j] + ys0.v[j] + ys1.v[j];
        const float uu = 0.7978845608028654f * (y + 0.044715f * y * y * y);
        const float e2 = __expf(2.f * uu); const float th = 1.f - 2.f * __builtin_amdgcn_rcpf(e2 + 1.f);
        g.v[j] = 0.5f * y * (1.f + th);
      }
      st8bf(GS5 + (long)t * 512 + c0, g);
    }
    {
      F8 a; float ss = 0.f;
#pragma unroll
      for (int j = 0; j < 8; ++j) { a.v[j] = o1.v[j] - lam_full * o2.v[j]; ss += a.v[j] * a.v[j]; }
      ss = grp16sum(ss);
      const float sc = rsqrtf(ss * (1.f / 128.f) + 1e-6f) * (1.f - lam_init);
#pragma unroll
      for (int j = 0; j < 8; ++j) a.v[j] = siluf_(zd.v[j]) * a.v[j] * sc * sub.v[j];
      st8bf(br + 512 + c0, a);
    }
    {
      F8 a;
#pragma unroll
      for (int j = 0; j < 8; ++j) a.v[j] = siluf_(zm.v[j]) * mo.v[j];
      st8bf(br + 1024 + c0, a);
    }
    {
      F8 y; float sm = 0.f;
#pragma unroll
      for (int j = 0; j < 8; ++j) { y.v[j] = y0.v[j] + y1.v[j]; sm += y.v[j]; }
      const float mean = grp8sum(sm) * (1.f / 64.f);
      float sv = 0.f;
#pragma unroll
      for (int j = 0; j < 8; ++j) { y.v[j] -= mean; sv += y.v[j] * y.v[j]; }
      const float rs = rsqrtf(grp8sum(sv) * (1.f / 64.f) + 64e-5f);
#pragma unroll
      for (int j = 0; j < 8; ++j) { const float yn = y.v[j] * rs * lng.v[j] + lnb.v[j] + bon * rv.v[j]; y.v[j] = siluf_(zr.v[j]) * yn; }
      st8bf(br + 1536 + c0, y);
    }
  }
}

struct EpiGlu { u16* BR; const u16* GS5; const u16* PB; const float* gb; __device__ __forceinline__ void operator()(int row, int col, f32x4 v0, f32x4 v1) const {
  const f32x4 b0 = *reinterpret_cast<const f32x4*>(gb + col), b1 = *reinterpret_cast<const f32x4*>(gb + col + 4);
  const F8 g = ld8bf(GS5 + (long)row * 512 + col), z = ld8bf(PB + (long)row * NP + C_S5Z + col);
  F8 o;
#pragma unroll
  for (int j = 0; j < 4; ++j) { o.v[j] = siluf_(z.v[j]) * g.v[j] * sigmoidf_(v0[j] + b0[j]); o.v[4 + j] = siluf_(z.v[4 + j]) * g.v[4 + j] * sigmoidf_(v1[j] + b1[j]); }
  st8bf(BR + (long)row * 2048 + col, o); } };
__device__ __forceinline__ void phase7(const P& p, int l) {
  char* ws = p.ws;
  EpiGlu e{(u16*)(ws + O_BR), (const u16*)(ws + O_GS5), (const u16*)(ws + O_P), p.in[I_GLUB] + l * 512};
  fg::gemm_phase<EpiGlu, true>((LAS3 unsigned char*)smem, (const u16*)(ws + O_GS5), 512, (const u16*)(ws + O_GLU), 512, T, 512, 512, e);
}

constexpr size_t O_GATES = O_O;
__device__ __forceinline__ void phase8a(const P& p, int l) {
  char* ws = p.ws;
  EpiGate e{(u16*)(ws + O_GATES), p.in[I_GATEB] + (long)l * 4 * 1024};
  fg::gemm_phase<EpiGate, true>((LAS3 unsigned char*)smem, (const u16*)(ws + O_H), 1024, (const u16*)(ws + O_WIN) + (long)NP * 1024, 1024, T, 4096, 1024, e);
}
__device__ __forceinline__ void phase8(const P& p, int l) {
  const int TIDX = opaque_tid();
  const int BIDX = opaque_bid();
  char* ws = p.ws;
  const u16* BR = (const u16*)(ws + O_BR); u16* M = (u16*)(ws + O_M);
  const u16* WBR = (const u16*)(ws + O_WBR); const u16* GT = (const u16*)(ws + O_GATES);
  for (int ti = BIDX; ti < 8 * 64; ti += gridDim.x) {
    const int nt = ti & 7, mt = ti >> 3; const int m0 = mt * 256, n0 = nt * 128;
    f32x4 tot[4][4]; zero_acc<4>(tot);
#pragma unroll 1
    for (int nb = 0; nb < 4; ++nb) {
      f32x4 ap[4][4]; zero_acc<4>(ap);
      gemm_main<4>(BR + (long)m0 * 2048 + nb * 512, 2048, WBR + ((long)nb * 1024 + n0) * 512, 512, 512, ap, smem);
      EPI_LOOP(4, { tot[i][j][jj] += bf2f(GT[(long)m * 4096 + nb * 1024 + n]) * ap[i][j][jj]; });
    }
    EPI_LOOP(4, { M[(long)m * 1024 + n] = f2bf(tot[i][j][jj]); });
  }
}

__device__ __forceinline__ void phase9(const P& p, int l) {
  char* ws = p.ws;
  EpiOut e{p.out, (l == 0) ? p.in[I_X] : p.out};
  fg::gemm_phase((LAS3 unsigned char*)smem, (const u16*)(ws + O_M), 1024, (const u16*)(ws + O_WOUT), 1024, T, 1024, 1024, e);
}

#define XB_TMO      128
#define XB_XCNT(j)  (256  + 64 * (j))
#define XB_XSUB(j)  (1280 + 64 * (j))
#define XB_XGEN(j)  (2304 + 64 * (j))
#define XB_TOP      3328
#define XB_TOPGEN   3392
#define XB_SPIN_CAP (1u << 18)
__device__ __forceinline__ unsigned xb_ld(unsigned* p) { return __hip_atomic_load(p, __ATOMIC_RELAXED, __HIP_MEMORY_SCOPE_AGENT); }
__device__ __forceinline__ unsigned xb_add(unsigned* p, unsigned v) { return __hip_atomic_fetch_add(p, v, __ATOMIC_RELAXED, __HIP_MEMORY_SCOPE_AGENT); }
__device__ __forceinline__ unsigned xb_xcc_id() { return (unsigned)__builtin_amdgcn_s_getreg((3 << 11) | 20) & 0xFu; }
#define XB_SPIN(cond, bar) do { unsigned _sp = 0; while (cond) { __builtin_amdgcn_s_sleep(1); \
    if ((++_sp & 255u) == 0u) { if (xb_ld(&(bar)[XB_TMO])) break; if (_sp > XB_SPIN_CAP) { atomicAdd(&(bar)[XB_TMO], 1u); break; } } } } while (0)
struct XcdBarrier { unsigned* bar; unsigned x; volatile LAS3 unsigned* st; };
__device__ __forceinline__ XcdBarrier xcd_barrier_post(unsigned* bar, volatile LAS3 unsigned* st) {
  XcdBarrier b; b.bar = bar; b.x = xb_xcc_id(); b.st = st;
  if (threadIdx.x == 0) (void)xb_add(&bar[XB_XCNT(b.x)], 1u);
  return b;
}
__device__ __forceinline__ void xcd_barrier_complete(unsigned* bar, unsigned x, unsigned& nloc, unsigned& nx) {
  const unsigned G = gridDim.x * gridDim.y * gridDim.z;
  unsigned sum, cnt, mine, sp = 0u;
  for (;;) {
    sum = 0u; cnt = 0u; mine = 0u;
#pragma unroll
    for (unsigned j = 0; j < 16; ++j) { const unsigned c = xb_ld(&bar[XB_XCNT(j)]); sum += c; cnt += (c > 0u) ? 1u : 0u; mine = (j == x) ? c : mine; }
    if (sum == G) break;
    __builtin_amdgcn_s_sleep(1);
    if ((++sp & 255u) == 0u) { if (xb_ld(&bar[XB_TMO])) break; if (sp > XB_SPIN_CAP) { atomicAdd(&bar[XB_TMO], 1u); break; } }
  }
  nloc = mine > 0u ? mine : 1u; nx = cnt > 0u ? cnt : 1u;
}
__device__ __forceinline__ void xcd_barrier(const XcdBarrier& b) {
  asm volatile("s_waitcnt vmcnt(0)" ::: "memory");
  __syncthreads();
  if (threadIdx.x == 0) {
    unsigned* bar = b.bar;
    __builtin_amdgcn_s_waitcnt(0);
    unsigned nloc = b.st[0], nx = b.st[1];
    if (nloc == 0u) { xcd_barrier_complete(bar, b.x, nloc, nx); b.st[0] = nloc; b.st[1] = nx; }
    const unsigned old = xb_add(&bar[XB_XSUB(b.x)], 1u);
    const unsigned gen = old / nloc;
    if (old + 1u == (gen + 1u) * nloc) {
      __builtin_amdgcn_fence(__ATOMIC_RELEASE, "agent");
      asm volatile("s_waitcnt vmcnt(0)" ::: "memory");
      const unsigned og = xb_add(&bar[XB_TOP], 1u);
      const unsigned tg = og / nx;
      if (og + 1u == (tg + 1u) * nx) xb_add(&bar[XB_TOPGEN], 1u);
      else XB_SPIN(xb_ld(&bar[XB_TOPGEN]) == tg, bar);
      __builtin_amdgcn_fence(__ATOMIC_ACQUIRE, "agent");
      xb_add(&bar[XB_XGEN(b.x)], 1u);
      asm volatile("s_waitcnt vmcnt(0)" ::: "memory");
    } else {
      XB_SPIN(xb_ld(&bar[XB_XGEN(b.x)]) == gen, bar);
      __builtin_amdgcn_fence(__ATOMIC_ACQUIRE, "agent");
      asm volatile("s_waitcnt vmcnt(0)" ::: "memory");
    }
  }
  __syncthreads();
}

__device__ __forceinline__ void gsync_cg(cg::grid_group& grid) {
  asm volatile("s_waitcnt vmcnt(0) lgkmcnt(0)" ::: "memory");
  grid.sync();
  __builtin_amdgcn_fence(__ATOMIC_ACQUIRE, "agent");
  asm volatile("s_waitcnt vmcnt(0)" ::: "memory");
}
#define gsync(g_) xcd_barrier(xbar)
#ifdef DBG
template <typename TT> __device__ __forceinline__ bool badv(TT v);
template <> __device__ __forceinline__ bool badv<u16>(u16 v) { float f = bf2f(v); return !(fabsf(f) < 1e5f); }
template <> __device__ __forceinline__ bool badv<float>(float f) { return !(fabsf(f) < 1e5f); }
template <typename TT>
__device__ __forceinline__ void chk(const P& p, size_t off, size_t n, int code) {
  const TT* q = (const TT*)(p.ws + off);
  bool bad = false;
  const int TIDX = opaque_tid(); const int BIDX = opaque_bid();
  for (size_t i = (size_t)BIDX * 512 + TIDX; i < n; i += (size_t)gridDim.x * 512) bad |= badv<TT>(q[i]);
  if (bad) atomicMin((int*)(p.ws + O_FLAG), code);
}
__device__ __forceinline__ void chko(const P& p, int code) {
  bool bad = false;
  const int TIDX = opaque_tid(); const int BIDX = opaque_bid();
  for (size_t i = (size_t)BIDX * 512 + TIDX; i < (size_t)T * 1024; i += (size_t)gridDim.x * 512) bad |= badv<float>(p.out[i]);
  if (bad) atomicMin((int*)(p.ws + O_FLAG), code);
}
#define CHK(...) do { if (l == 0) { __VA_ARGS__ } } while (0)
#else
#define CHK(...) do {} while (0)
#endif
__global__ void __launch_bounds__(512) mega(P p) {
  cg::grid_group grid = cg::this_grid();
  __shared__ uint4 xb_words;
  if (threadIdx.x == 0) xb_words = make_uint4(0u, 0u, 0u, 0u);
  __syncthreads();
  XcdBarrier xbar = xcd_barrier_post((unsigned*)(p.ws + O_BAR), (volatile LAS3 unsigned*)&xb_words);
  gsync_cg(grid);
#ifdef DBG
  if (blockIdx.x == 0 && threadIdx.x == 0) *(int*)(p.ws + O_FLAG) = 9999;
#endif
  for (int l = 0; l < NL; ++l) {
#ifndef ONLY
#define ONLY -1
#endif
#ifndef REPMASK
#define REPMASK 0
#endif
#define RUNP(k, call) do { call; gsync(grid); if (REPMASK & (1 << (k))) { call; gsync(grid); } } while (0)
    RUNP(0, phase0(p, l));
    CHK(chk<u16>(p, O_H, (size_t)T * 1024, 10); chk<u16>(p, O_WIN, (size_t)NIN * 1024, 11););
    RUNP(1, phase1(p));
    RUNP(2, phase2(p, l));
    RUNP(3, phase3(p));
    RUNP(4, phase4(p, l));
    phase5(p, l, 0); gsync(grid);
#ifndef REP5MASK
#define REP5MASK 15
#endif
    if (REPMASK & (1 << 5)) { phase5(p, l, 4, REP5MASK); gsync(grid); }
    RUNP(6, phase6(p, l));
    RUNP(7, phase7(p, l); phase8a(p, l));
    RUNP(9, phase8(p, l));
    phase9(p, l); gsync(grid);
    if (REPMASK & (1 << 10)) { gsync(grid); gsync(grid); gsync(grid); gsync(grid); gsync(grid); }
#ifdef DBG
    if (l > 0) chko(p, 90 + l);
#endif
  }
#ifdef DBG
  gsync(grid);
  {
    const int flag = *(volatile int*)(p.ws + O_FLAG);
    if (flag < 9999) {
      const int TIDX = opaque_tid(); const int BIDX = opaque_bid();
      for (size_t i = (size_t)BIDX * 512 + TIDX; i < (size_t)T * 1024; i += (size_t)gridDim.x * 512)
        p.out[i] = (i == 0) ? (float)(flag * 10) : p.in[I_X][i];
    }
  }
#endif
}

extern "C" void kernel_launch(void* const* d_in, const int* in_sizes, int n_in,
                              void* d_out, int out_size, void* d_ws, size_t ws_size,
                              hipStream_t stream) {
  constexpr size_t kDynLds = 128 * 1024;
  static int grid_blocks = 0;
  if (!grid_blocks) {
    int dev = 0, cus = 0, per_cu = 0;
    (void)hipGetDevice(&dev);
    (void)hipDeviceGetAttribute(&cus, hipDeviceAttributeMultiprocessorCount, dev);
    (void)hipFuncSetAttribute((const void*)mega, hipFuncAttributeMaxDynamicSharedMemorySize, (int)kDynLds);
    (void)hipOccupancyMaxActiveBlocksPerMultiprocessor(&per_cu, mega, 512, kDynLds);
    if (per_cu < 1) per_cu = 1;
    if (per_cu > 1) per_cu = 1;
    grid_blocks = cus * per_cu;
  }
  if (n_in < 36 || ws_size < O_BAR + BAR_BYTES) { fprintf(stderr, "bad args: n_in %d ws %zu need %zu\n", n_in, ws_size, (size_t)O_END); return; }
  P p{};
  for (int i = 0; i < 36; ++i) p.in[i] = (const float*)d_in[i];
  p.out = (float*)d_out; p.ws = (char*)d_ws;
  (void)hipMemsetAsync((char*)d_ws + O_BAR, 0, BAR_BYTES, stream);
  void* args[] = {&p};
  hipError_t e = hipLaunchCooperativeKernel((void*)mega, dim3(grid_blocks), dim3(512), args, kDynLds, stream);
  if (e != hipSuccess) fprintf(stderr, "coop launch failed: %s\n", hipGetErrorString(e));
}
```

```cpp
#define REPMASK 0

#include <hip/hip_runtime.h>
#include <hip/hip_bf16.h>
#include <hip/hip_cooperative_groups.h>
#include <cstdio>
#include <cstdint>
namespace cg = cooperative_groups;

typedef unsigned short u16;
using bf16x8 = __attribute__((ext_vector_type(8))) short;
using s16x4  = __attribute__((ext_vector_type(4))) short;
using f32x4  = __attribute__((ext_vector_type(4))) float;
using f32x16 = __attribute__((ext_vector_type(16))) float;
using u32x4  = __attribute__((ext_vector_type(4))) unsigned;
using f2     = __attribute__((ext_vector_type(2))) float;

constexpr int T = 16384, S = 4096, NB = 4, DM = 1024, NL = 4;
constexpr int NP = 6336;
constexpr int NIN = 10432;
constexpr int C_S5U = 0, C_S5Z = 512, C_DQ = 1024, C_DK = 1536, C_DV = 2048, C_DZ = 2560, C_MCQ = 3072, C_MCKV = 3328,
              C_MKR = 3456, C_MZ = 3520, C_RC = 4032, C_RZ = 5824;
constexpr size_t SZT512 = (size_t)T * 512 * 2;
constexpr size_t O_WIN = 0;
constexpr size_t O_WBR = O_WIN + (size_t)NIN * 1024 * 2;
constexpr size_t O_WOUT = O_WBR + 4194304;
constexpr size_t O_GLU = O_WOUT + 2097152;
constexpr size_t O_UQ = O_GLU + 524288;
constexpr size_t O_UKV = O_UQ + 393216;
constexpr size_t O_WUP = O_UKV + 262144;
constexpr size_t O_AUP = O_WUP + 131072;
constexpr size_t O_CTR = O_AUP + 131072;
constexpr size_t O_H = O_CTR + 4096;
constexpr size_t O_P = O_H + (size_t)T * 1024 * 2;
constexpr size_t O_RW = O_P + (size_t)T * NP * 2;
constexpr size_t RW_R = O_RW, RW_K = O_RW + SZT512, RW_V = O_RW + 2 * SZT512, RW_KK = O_RW + 3 * SZT512,
                 RW_A = O_RW + 4 * SZT512, RW_E = O_RW + 6 * SZT512, RW_BON = O_RW + 8 * SZT512;
constexpr size_t O_M = O_RW;
constexpr size_t O_QK = RW_BON + (size_t)T * 8 * 4;
constexpr size_t QK_DQ = O_QK, QK_DK = O_QK + SZT512, QK_MQ = O_QK + 2 * SZT512, QK_MK = QK_MQ + (size_t)T * 768 * 2,
                 QK_MV = QK_MK + (size_t)T * 768 * 2;
constexpr size_t O_BR = O_QK, O_GS5 = O_QK + 4 * SZT512;
constexpr size_t O_O = QK_MV + SZT512;
constexpr size_t OO_DO = O_O, OO_MO = O_O + 4 * SZT512, OO_YS = OO_MO + SZT512, OO_YR = OO_YS + 2 * SZT512;
constexpr size_t O_END = OO_YR + 2 * SZT512;
constexpr size_t OA_LINW = O_O, OA_LINA = O_O + 4194304, OA_CQN = O_O + 8388608, OA_CKVN = O_O + 16777216,
                 OA_QRAW = O_O + 20971520, OA_KVRAW = OA_QRAW + 25165824, OA_WL = OA_KVRAW + 33554432, OA_AL = OA_WL + 33554432;
static_assert(OA_AL + 33554432 <= O_END, "alias overflow");
static_assert(O_END <= 683000000ull, "ws overflow");
constexpr size_t O_FLAG = O_CTR + 64;
constexpr size_t O_BAR = O_END;
constexpr size_t BAR_BYTES = 3456 * 4;
static_assert(O_BAR + BAR_BYTES <= 683000000ull, "ws overflow");

struct P {
  const float* in[36];
  float* out;
  char* ws;
};
enum { I_X = 0, I_NORMG, I_WIN, I_GATEB, I_LRE, I_LIM, I_LDT, I_BRE, I_BIM, I_CRE, I_CIM, I_S5D, I_GLUW, I_GLUB, I_DQN, I_DKN,
       I_DLAM, I_SUBLN, I_QLN, I_KVLN, I_WUQ, I_WUKV, I_MQN, I_MKN, I_MU, I_W0, I_WUP, I_A0, I_AUP, I_KK, I_KA, I_RK, I_LNG,
       I_LNB, I_WBR, I_WOUT };

extern __shared__ __attribute__((aligned(16))) char smem[];

__device__ __forceinline__ float bf2f(u16 v) { return __uint_as_float(((unsigned)v) << 16); }
__device__ __forceinline__ u16 f2bf(float f) { unsigned u = __float_as_uint(f); u += 0x7fffu + ((u >> 16) & 1u); return (u16)(u >> 16); }
__device__ __forceinline__ unsigned cvtpk_asm(float lo, float hi) {
  unsigned r; asm volatile("v_cvt_pk_bf16_f32 %0, %1, %2" : "=v"(r) : "v"(lo), "v"(hi)); return r;
}
typedef __bf16 bf16v2_t __attribute__((ext_vector_type(2)));
__device__ __forceinline__ unsigned cvtpk(float lo, float hi) {
  f2 v = {lo, hi};
  bf16v2_t r = __builtin_convertvector(v, bf16v2_t);
  return __builtin_bit_cast(unsigned, r);
}
__device__ __forceinline__ float dpp_add_(float x, const int ctrl_unused) { return x; }
#define WS_DPP(x, ctrl) ((x) + __int_as_float(__builtin_amdgcn_update_dpp(0, __float_as_int(x), (ctrl), 0xf, 0xf, true)))
__device__ __forceinline__ float wsum(float v) {
  v = WS_DPP(v, 0xB1);
  v = WS_DPP(v, 0x4E);
  v = WS_DPP(v, 0x141);
  v = WS_DPP(v, 0x140);
  v += __shfl_xor(v, 16);
  v += __shfl_xor(v, 32);
  return v;
}
__device__ __forceinline__ float sigmoidf_(float x) { return __builtin_amdgcn_rcpf(1.f + __expf(-x)); }
__device__ __forceinline__ float siluf_(float x) { return x * __builtin_amdgcn_rcpf(1.f + __expf(-x)); }
__device__ __forceinline__ void sincos_rev(float ang, float& sn, float& cs) {
  float rev = ang * 0.15915494309189535f; rev -= rintf(rev);
  sn = __builtin_amdgcn_sinf(rev); cs = __builtin_amdgcn_cosf(rev);
}

__device__ __forceinline__ int opaque_tid() { int t = threadIdx.x; asm volatile("" : "+v"(t)); return t; }
__device__ __forceinline__ int opaque_bid() { int t = blockIdx.x; asm volatile("" : "+s"(t)); return t; }

struct F8 { float v[8]; };
__device__ __forceinline__ F8 ld8bf(const u16* p) {
  const u32x4 w = *reinterpret_cast<const u32x4*>(p); F8 r;
#pragma unroll
  for (int i = 0; i < 4; ++i) { r.v[2 * i] = __uint_as_float(w[i] << 16); r.v[2 * i + 1] = __uint_as_float(w[i] & 0xffff0000u); }
  return r;
}
__device__ __forceinline__ void st8bf(u16* p, const F8& f) {
  u32x4 w; w[0] = cvtpk(f.v[0], f.v[1]); w[1] = cvtpk(f.v[2], f.v[3]); w[2] = cvtpk(f.v[4], f.v[5]); w[3] = cvtpk(f.v[6], f.v[7]);
  *reinterpret_cast<u32x4*>(p) = w;
}
__device__ __forceinline__ F8 ld8f(const float* p) {
  const f32x4 a = *reinterpret_cast<const f32x4*>(p), b = *reinterpret_cast<const f32x4*>(p + 4); F8 r;
  r.v[0] = a[0]; r.v[1] = a[1]; r.v[2] = a[2]; r.v[3] = a[3]; r.v[4] = b[0]; r.v[5] = b[1]; r.v[6] = b[2]; r.v[7] = b[3]; return r;
}
struct F4 { float v[4]; };
__device__ __forceinline__ F4 ld4bf(const u16* p) {
  const uint2 w = *reinterpret_cast<const uint2*>(p); F4 r;
  r.v[0] = __uint_as_float(w.x << 16); r.v[1] = __uint_as_float(w.x & 0xffff0000u); r.v[2] = __uint_as_float(w.y << 16); r.v[3] = __uint_as_float(w.y & 0xffff0000u); return r;
}
__device__ __forceinline__ void st4bf(u16* p, const F4& f) { uint2 w; w.x = cvtpk(f.v[0], f.v[1]); w.y = cvtpk(f.v[2], f.v[3]); *reinterpret_cast<uint2*>(p) = w; }
__device__ __forceinline__ F4 ld4f(const float* p) { const f32x4 a = *reinterpret_cast<const f32x4*>(p); F4 r; r.v[0] = a[0]; r.v[1] = a[1]; r.v[2] = a[2]; r.v[3] = a[3]; return r; }
__device__ __forceinline__ F4 zero4() { F4 r; r.v[0] = r.v[1] = r.v[2] = r.v[3] = 0.f; return r; }
__device__ __forceinline__ F8 zero8() { F8 r;
#pragma unroll
  for (int i = 0; i < 8; ++i) r.v[i] = 0.f; return r; }
__device__ __forceinline__ float grp8sum(float v) { v = WS_DPP(v, 0xB1); v = WS_DPP(v, 0x4E); v = WS_DPP(v, 0x141); return v; }
__device__ __forceinline__ float grp16sum(float v) { v = grp8sum(v); v = WS_DPP(v, 0x140); return v; }
__device__ __forceinline__ float swz_xor4(float v) { return __int_as_float(__builtin_amdgcn_ds_swizzle(__float_as_int(v), 0x101F)); }
__device__ __forceinline__ float dpp_xor1(float v) { return __int_as_float(__builtin_amdgcn_update_dpp(0, __float_as_int(v), 0xB1, 0xf, 0xf, true)); }
__device__ __forceinline__ void tr_tile(const float* __restrict__ src, int ldsrc, u16* __restrict__ dst, int lddst, int k0, int n0, float* lds) {
  const int TIDX = opaque_tid();
  const int tid = TIDX;
  const int kr = tid >> 4, nc = (tid & 15) * 4;
#pragma unroll
  for (int i = 0; i < 2; ++i) {
    int k = kr + 32 * i;
    float4 v = *reinterpret_cast<const float4*>(src + (long)(k0 + k) * ldsrc + n0 + nc);
    float* d = lds + k * 65 + nc; d[0] = v.x; d[1] = v.y; d[2] = v.z; d[3] = v.w;
  }
  __syncthreads();
  const int n = tid >> 3, k8 = (tid & 7) * 8;
  u32x4 w;
  w[0] = cvtpk(lds[(k8 + 0) * 65 + n], lds[(k8 + 1) * 65 + n]);
  w[1] = cvtpk(lds[(k8 + 2) * 65 + n], lds[(k8 + 3) * 65 + n]);
  w[2] = cvtpk(lds[(k8 + 4) * 65 + n], lds[(k8 + 5) * 65 + n]);
  w[3] = cvtpk(lds[(k8 + 6) * 65 + n], lds[(k8 + 7) * 65 + n]);
  *reinterpret_cast<u32x4*>(dst + (long)(n0 + n) * lddst + k0 + k8) = w;
  __syncthreads();
}

__device__ __forceinline__ void phase0(const P& p, int l) {
  const int TIDX = opaque_tid();
  const int BIDX = opaque_bid();
  float* lds = (float*)smem;
  char* ws = p.ws;
  if (BIDX == 0 && TIDX == 0) { ((int*)(ws + O_CTR))[l] = 0; ((int*)(ws + O_CTR))[l + 4] = 0; }
  constexpr int NT_WIN = 16 * 163, NT_WBR = 4 * 128, NT_WOUT = 256, NT_GLU = 64, NT_UQ = 48, NT_UKV = 32, NT_UP = 16, NT_AUP = 16;
  constexpr int NT_ALL = NT_WIN + NT_WBR + NT_WOUT + NT_GLU + NT_UQ + NT_UKV + NT_UP + NT_AUP;
  for (int ti = BIDX; ti < NT_ALL; ti += gridDim.x) {
    int t = ti;
    if (t < NT_WIN) { tr_tile(p.in[I_WIN] + (long)l * 1024 * NIN, NIN, (u16*)(ws + O_WIN), 1024, (t & 15) * 64, (t >> 4) * 64, lds); continue; }
    t -= NT_WIN;
    if (t < NT_WBR) { int nb = t >> 7, r = t & 127;
      tr_tile(p.in[I_WBR] + ((long)l * 4 + nb) * 512 * 1024, 1024, (u16*)(ws + O_WBR) + (long)nb * 1024 * 512, 512, (r & 7) * 64, (r >> 3) * 64, lds); continue; }
    t -= NT_WBR;
    if (t < NT_WOUT) { tr_tile(p.in[I_WOUT] + (long)l * 1024 * 1024, 1024, (u16*)(ws + O_WOUT), 1024, (t & 15) * 64, (t >> 4) * 64, lds); continue; }
    t -= NT_WOUT;
    if (t < NT_GLU) { tr_tile(p.in[I_GLUW] + (long)l * 512 * 512, 512, (u16*)(ws + O_GLU), 512, (t & 7) * 64, (t >> 3) * 64, lds); continue; }
    t -= NT_GLU;
    if (t < NT_UQ) { tr_tile(p.in[I_WUQ] + (long)l * 256 * 768, 768, (u16*)(ws + O_UQ), 256, (t & 3) * 64, (t >> 2) * 64, lds); continue; }
    t -= NT_UQ;
    if (t < NT_UKV) { tr_tile(p.in[I_WUKV] + (long)l * 128 * 1024, 1024, (u16*)(ws + O_UKV), 128, (t & 1) * 64, (t >> 1) * 64, lds); continue; }
    t -= NT_UKV;
    if (t < NT_UP) { int d = t >> 3, r = t & 7;
      tr_tile(p.in[I_WUP] + ((long)l * 2 + d) * 64 * 512, 512, (u16*)(ws + O_WUP) + (long)d * 512 * 64, 64, 0, r * 64, lds); continue; }
    t -= NT_UP;
    { int d = t >> 3, r = t & 7;
      tr_tile(p.in[I_AUP] + ((long)l * 2 + d) * 64 * 512, 512, (u16*)(ws + O_AUP) + (long)d * 512 * 64, 64, 0, r * 64, lds); }
  }
  const float* xin = (l == 0) ? p.in[I_X] : p.out;
  const float* g = p.in[I_NORMG] + l * 1024;
  u16* h = (u16*)(ws + O_H);
  const int wid = TIDX >> 6, lane = TIDX & 63;
  for (int t = BIDX * 8 + wid; t < T; t += gridDim.x * 8) {
    const float* xr = xin + (long)t * 1024;
    float4 v[4]; float ss = 0.f;
#pragma unroll
    for (int i = 0; i < 4; ++i) { v[i] = *reinterpret_cast<const float4*>(xr + i * 256 + lane * 4); ss += v[i].x * v[i].x + v[i].y * v[i].y + v[i].z * v[i].z + v[i].w * v[i].w; }
    ss = wsum(ss);
    float sc = rsqrtf(ss * (1.f / 1024.f) + 1e-6f);
#pragma unroll
    for (int i = 0; i < 4; ++i) {
      float4 gg = *reinterpret_cast<const float4*>(g + i * 256 + lane * 4);
      uint2 o; o.x = cvtpk(v[i].x * sc * gg.x, v[i].y * sc * gg.y); o.y = cvtpk(v[i].z * sc * gg.z, v[i].w * sc * gg.w);
      *reinterpret_cast<uint2*>(h + (long)t * 1024 + i * 256 + lane * 4) = o;
    }
  }
}

template <int MT>
__device__ __forceinline__ void gemm_main(const u16* __restrict__ A, long lda, const u16* __restrict__ Bt, long ldb, int K,
                                          f32x4 (&acc)[MT][4], char* lds) {
  const int TIDX = opaque_tid();
  constexpr int BM = MT * 64;
  constexpr int ASZ = BM * 128, BSZ = 128 * 128, STG = ASZ + BSZ;
  const int tid = TIDX, lane = tid & 63, wid = tid >> 6, wm = wid >> 1, wn = wid & 1, fr = lane & 15, fq = lane >> 4;
  bf16x8 ra[MT], rb[2];
  const int nk = K >> 6;
#define GLOAD(k0) do { _Pragma("unroll") for (int i = 0; i < MT; ++i) { int gi = tid + 512 * i; int row = gi >> 3, g = gi & 7; \
      ra[i] = *reinterpret_cast<const bf16x8*>(A + (long)row * lda + (k0) + g * 8); } \
    _Pragma("unroll") for (int i = 0; i < 2; ++i) { int gi = tid + 512 * i; int row = gi >> 3, g = gi & 7; \
      rb[i] = *reinterpret_cast<const bf16x8*>(Bt + (long)row * ldb + (k0) + g * 8); } } while (0)
#define SWRITE(st) do { char* base_ = lds + (st) * STG; \
    _Pragma("unroll") for (int i = 0; i < MT; ++i) { int gi = tid + 512 * i; int row = gi >> 3, g = gi & 7; \
      *reinterpret_cast<bf16x8*>(base_ + row * 128 + ((g ^ ((row >> 1) & 7)) << 4)) = ra[i]; } \
    _Pragma("unroll") for (int i = 0; i < 2; ++i) { int gi = tid + 512 * i; int row = gi >> 3, g = gi & 7; \
      *reinterpret_cast<bf16x8*>(base_ + ASZ + row * 128 + ((g ^ ((row >> 1) & 7)) << 4)) = rb[i]; } } while (0)
  GLOAD(0); SWRITE(0); __syncthreads();
  for (int kt = 0; kt < nk; ++kt) {
    const int cur = kt & 1;
    if (kt + 1 < nk) GLOAD((kt + 1) * 64);
    const char* sa = lds + cur * STG; const char* sb = sa + ASZ;
#pragma unroll
    for (int kk = 0; kk < 2; ++kk) {
      bf16x8 af[MT], bfr[4];
      const int g = kk * 4 + fq;
#pragma unroll
      for (int i = 0; i < MT; ++i) { int row = wm * (MT * 16) + i * 16 + fr; af[i] = *reinterpret_cast<const bf16x8*>(sa + row * 128 + ((g ^ ((row >> 1) & 7)) << 4)); }
#pragma unroll
      for (int j = 0; j < 4; ++j) { int row = wn * 64 + j * 16 + fr; bfr[j] = *reinterpret_cast<const bf16x8*>(sb + row * 128 + ((g ^ ((row >> 1) & 7)) << 4)); }
#pragma unroll
      for (int i = 0; i < MT; ++i)
#pragma unroll
        for (int j = 0; j < 4; ++j) acc[i][j] = __builtin_amdgcn_mfma_f32_16x16x32_bf16(af[i], bfr[j], acc[i][j], 0, 0, 0);
    }
    if (kt + 1 < nk) SWRITE(cur ^ 1);
    __syncthreads();
  }
#undef GLOAD
#undef SWRITE
}
#define EPI_LOOP(MT_, BODY) do { const int lane_ = TIDX & 63, wid_ = TIDX >> 6, wm_ = wid_ >> 1, wn_ = wid_ & 1, fr_ = lane_ & 15, fq_ = lane_ >> 4; \
  _Pragma("unroll") for (int i = 0; i < MT_; ++i) _Pragma("unroll") for (int j = 0; j < 4; ++j) _Pragma("unroll") for (int jj = 0; jj < 4; ++jj) { \
    const int m = m0 + wm_ * (MT_ * 16) + i * 16 + fq_ * 4 + jj; const int n = n0 + wn_ * 64 + j * 16 + fr_; BODY } } while (0)

template <int MT> __device__ __forceinline__ void zero_acc(f32x4 (&acc)[MT][4]) {
#pragma unroll
  for (int i = 0; i < MT; ++i)
#pragma unroll
    for (int j = 0; j < 4; ++j) acc[i][j] = f32x4{0.f, 0.f, 0.f, 0.f};
}


#define LAS3 __attribute__((address_space(3)))
namespace fg {
constexpr int BM = 256, BK = 64, HALF = 128, HTB = HALF * BK * 2, NXCD = 8, WGM = 8;
__device__ __forceinline__ int lds_byte(int r, int c) { const int st = (r >> 4) * 2 + (c >> 5), rr = r & 15, cc = c & 31, ob = rr * 64 + cc * 2; return st * 1024 + (ob ^ (((ob >> 9) & 1) << 5)); }
__device__ __forceinline__ void stage_rc(int b, int& R, int& C) { const int st = b / 1024, sb = b % 1024, swz = sb ^ (((sb >> 9) & 1) << 5); R = (st >> 1) * 16 + swz / 64; C = (st & 1) * 32 + (swz % 64) / 2; }
struct Unit { int pm, pn; };
struct Order {
  int nM, nN, nwg, G, c;
  __device__ __forceinline__ void init(int M, int N, int G_, int c_) { nM = M / BM; nN = N / BM; nwg = nM * nN; G = G_; c = c_; }
  __device__ __forceinline__ bool next(int i, Unit& u) const {
    const long L = (long)i * G + c; if (L >= nwg) return false;
    int wgid = (int)L; { const int q = nwg / NXCD, r = nwg % NXCD, xcd = wgid % NXCD, off = wgid / NXCD; wgid = (xcd < r ? xcd * (q + 1) : r * (q + 1) + (xcd - r) * q) + off; }
    const int nig = WGM * nN, gid = wgid / nig, fm = gid * WGM, gsz = (nM - fm) < WGM ? (nM - fm) : WGM;
    u.pm = fm + ((wgid % nig) % gsz); u.pn = (wgid % nig) / gsz; return true;
  }
};
__device__ __forceinline__ int perm32(int rho) { const int n = rho >> 4, i = rho & 15; return 8 * (i >> 2) + 4 * n + (i & 3); }
template <class Epi, bool PERM = false>
__device__ __forceinline__ void gemm_phase(LAS3 unsigned char* lds, const u16* A, int lda, const u16* Bt, int ldb, int M, int N, int K, const Epi& E) {
  const int tid = opaque_tid(), wid = __builtin_amdgcn_readfirstlane(tid >> 6), lane = tid & 63, wr = wid >> 2, wc = wid & 3, fr = lane & 15, fq = lane >> 4;
  const int nt = K / BK;
  Order S; S.init(M, N, gridDim.x, opaque_bid());
  unsigned voffA[2], voffB[2];
#pragma unroll
  for (int i = 0; i < 2; ++i) { int R, C; stage_rc(tid * 16 + i * 8192, R, C); const int Rb = PERM ? ((R & ~31) + perm32(R & 31)) : R;
    voffA[i] = (unsigned)(R * lda + C) * 2u; voffB[i] = (unsigned)(Rb * ldb + C) * 2u; }
  const size_t kstep = (size_t)(BK * 2);
  const size_t hstepA = (size_t)HALF * lda * 2, hstepB = (size_t)HALF * ldb * 2;
  const size_t tstepA = 2 * hstepA, tstepB = 2 * hstepB;
  const unsigned ldsw = (unsigned)wid * 1024u;
  const int aoff = lds_byte(wr * 64 + fr, fq * 8), boff = lds_byte(wc * 32 + fr, fq * 8);
#define FG_SA(b, h) (((b) * 2 + (h)) * HTB)
#define FG_SB(b, h) ((4 + (b) * 2 + (h)) * HTB)
#define FG_STAGE(bufoff, gbase, voff) do { _Pragma("unroll") for (int _i = 0; _i < 2; ++_i) \
    __builtin_amdgcn_global_load_lds((const unsigned*)((const char*)(gbase) + (voff)[_i]), (LAS3 unsigned*)(lds + (bufoff) + ldsw + _i * 8192), 16, 0, 0); } while (0)
#define FG_LDA(dst, b, h) do { _Pragma("unroll") for (int m = 0; m < 4; ++m) _Pragma("unroll") for (int k = 0; k < 2; ++k) dst[m][k] = *(const LAS3 bf16x8*)(lds + FG_SA(b, h) + aoff + m * 2048 + k * 1024); } while (0)
#define FG_LDB(dst, b, h) do { _Pragma("unroll") for (int n = 0; n < 2; ++n) _Pragma("unroll") for (int k = 0; k < 2; ++k) dst[n][k] = *(const LAS3 bf16x8*)(lds + FG_SB(b, h) + boff + n * 2048 + k * 1024); } while (0)
#define FG_MMA(ai, bj, At, Bq) do { __builtin_amdgcn_s_setprio(1); _Pragma("unroll") for (int m = 0; m < 4; ++m) _Pragma("unroll") for (int n = 0; n < 2; ++n) _Pragma("unroll") for (int k = 0; k < 2; ++k) \
    acc[ai][bj][m][n] = __builtin_amdgcn_mfma_f32_16x16x32_bf16(Bq[n][k], At[m][k], acc[ai][bj][m][n], 0, 0, 0); __builtin_amdgcn_s_setprio(0); } while (0)
#define FG_WAIT_V(n) asm volatile("s_waitcnt vmcnt(" #n ")" ::: "memory")
#define FG_WAIT_L(n) asm volatile("s_waitcnt lgkmcnt(" #n ")" ::: "memory")
#define FG_BAR __builtin_amdgcn_s_barrier()
#define FG_SCHED __builtin_amdgcn_sched_barrier(0)
  Unit cur, nxt; int ui = 0;
  if (!S.next(0, cur)) return;
  f32x4 acc[2][2][4][2];
#pragma unroll
  for (int a = 0; a < 2; ++a)
#pragma unroll
    for (int b = 0; b < 2; ++b)
#pragma unroll
      for (int m = 0; m < 4; ++m)
#pragma unroll
        for (int n = 0; n < 2; ++n) acc[a][b][m][n] = (f32x4){0.f, 0.f, 0.f, 0.f};
  bf16x8 At[4][2], B0[2][2], B1[2][2];
  const char* cA = (const char*)A + (size_t)cur.pm * tstepA; const char* cB = (const char*)Bt + (size_t)cur.pn * tstepB;
  FG_STAGE(FG_SB(0, 0), cB, voffB); FG_STAGE(FG_SA(0, 0), cA, voffA); FG_STAGE(FG_SB(0, 1), cB + hstepB, voffB); FG_STAGE(FG_SA(0, 1), cA + hstepA, voffA);
  if (wr == 1) FG_BAR;
  FG_WAIT_V(4); FG_BAR;
  FG_STAGE(FG_SB(1, 0), cB + kstep, voffB); FG_STAGE(FG_SA(1, 0), cA + kstep, voffA); FG_STAGE(FG_SB(1, 1), cB + hstepB + kstep, voffB);
  FG_WAIT_V(6); FG_BAR;
  for (;;) {
    const bool has_next = S.next(ui + 1, nxt);
    const char* nA = has_next ? (const char*)A + (size_t)nxt.pm * tstepA : cA; const char* nB = has_next ? (const char*)Bt + (size_t)nxt.pn * tstepB : cB;
    for (int t = 0; t < nt; t += 2) {
      const bool last = (t == nt - 2);
      const char* a1 = cA + (size_t)(t + 1) * kstep;
      const char* a2 = last ? nA : cA + (size_t)(t + 2) * kstep; const char* b2 = last ? nB : cB + (size_t)(t + 2) * kstep;
      const char* a3 = a2 + kstep; const char* b3 = b2 + kstep;
      FG_LDB(B0, 0, 0); FG_SCHED; FG_LDA(At, 0, 0); FG_STAGE(FG_SA(1, 1), a1 + hstepA, voffA);
      FG_WAIT_L(8); FG_BAR; FG_WAIT_L(0); FG_MMA(0, 0, At, B0); FG_BAR; FG_SCHED;
      FG_LDB(B1, 0, 1); FG_STAGE(FG_SB(0, 0), b2, voffB);
      FG_BAR; FG_WAIT_L(0); FG_MMA(0, 1, At, B1); FG_BAR;
      FG_LDA(At, 0, 1); FG_STAGE(FG_SA(0, 0), a2, voffA);
      FG_BAR; FG_WAIT_L(0); FG_MMA(1, 0, At, B0); FG_BAR; FG_SCHED;
      FG_STAGE(FG_SB(0, 1), b2 + hstepB, voffB);
      FG_WAIT_V(6); FG_BAR; FG_MMA(1, 1, At, B1); FG_BAR;
      FG_LDB(B0, 1, 0); FG_SCHED; FG_LDA(At, 1, 0); FG_STAGE(FG_SA(0, 1), a2 + hstepA, voffA);
      FG_WAIT_L(8); FG_BAR; FG_WAIT_L(0); FG_MMA(0, 0, At, B0); FG_BAR; FG_SCHED;
      FG_LDB(B1, 1, 1); FG_STAGE(FG_SB(1, 0), b3, voffB);
      FG_BAR; FG_WAIT_L(0); FG_MMA(0, 1, At, B1); FG_BAR;
      FG_LDA(At, 1, 1); FG_STAGE(FG_SA(1, 0), a3, voffA);
      FG_BAR; FG_WAIT_L(0); FG_MMA(1, 0, At, B0); FG_BAR; FG_SCHED;
      FG_STAGE(FG_SB(1, 1), b3 + hstepB, voffB);
      FG_WAIT_V(6); FG_BAR; FG_MMA(1, 1, At, B1); FG_BAR;
    }
    if constexpr (PERM) {
      const int row0 = cur.pm * BM + wr * 64 + fr, col0 = cur.pn * BM + wc * 32 + 8 * fq;
#pragma unroll
      for (int ai = 0; ai < 2; ++ai)
#pragma unroll
        for (int m = 0; m < 4; ++m)
#pragma unroll
          for (int bj = 0; bj < 2; ++bj) E(row0 + ai * HALF + m * 16, col0 + bj * HALF, acc[ai][bj][m][0], acc[ai][bj][m][1]);
    } else {
      const int row0 = cur.pm * BM + wr * 64 + fr, col0 = cur.pn * BM + wc * 32 + 4 * fq;
#pragma unroll
      for (int ai = 0; ai < 2; ++ai)
#pragma unroll
        for (int m = 0; m < 4; ++m)
#pragma unroll
          for (int bj = 0; bj < 2; ++bj)
#pragma unroll
            for (int n = 0; n < 2; ++n) E(row0 + ai * HALF + m * 16, col0 + bj * HALF + n * 16, acc[ai][bj][m][n]);
    }
    if (!has_next) break;
#pragma unroll
    for (int a = 0; a < 2; ++a)
#pragma unroll
      for (int b = 0; b < 2; ++b)
#pragma unroll
        for (int m = 0; m < 4; ++m)
#pragma unroll
          for (int n = 0; n < 2; ++n) acc[a][b][m][n] = (f32x4){0.f, 0.f, 0.f, 0.f};
    cur = nxt; cA = nA; cB = nB; ++ui;
  }
  FG_WAIT_V(0);
  if (wr == 0) FG_BAR;
  FG_BAR;
#undef FG_SA
#undef FG_SB
#undef FG_STAGE
#undef FG_LDA
#undef FG_LDB
#undef FG_MMA
#undef FG_WAIT_V
#undef FG_WAIT_L
#undef FG_BAR
#undef FG_SCHED
}
}

struct EpiP1 { u16* PB; __device__ __forceinline__ void operator()(int row, int col, f32x4 v0, f32x4 v1) const {
  if (col < NP) { u32x4 o; o[0] = cvtpk(v0[0], v0[1]); o[1] = cvtpk(v0[2], v0[3]); o[2] = cvtpk(v1[0], v1[1]); o[3] = cvtpk(v1[2], v1[3]);
    *reinterpret_cast<u32x4*>(PB + (long)row * NP + col) = o; } } };
struct EpiGate { u16* G; const float* gb; __device__ __forceinline__ void operator()(int row, int col, f32x4 v0, f32x4 v1) const {
  const f32x4 b0 = *reinterpret_cast<const f32x4*>(gb + col), b1 = *reinterpret_cast<const f32x4*>(gb + col + 4);
  u32x4 o; o[0] = cvtpk(sigmoidf_(v0[0] + b0[0]), sigmoidf_(v0[1] + b0[1])); o[1] = cvtpk(sigmoidf_(v0[2] + b0[2]), sigmoidf_(v0[3] + b0[3]));
  o[2] = cvtpk(sigmoidf_(v1[0] + b1[0]), sigmoidf_(v1[1] + b1[1])); o[3] = cvtpk(sigmoidf_(v1[2] + b1[2]), sigmoidf_(v1[3] + b1[3]));
  *reinterpret_cast<u32x4*>(G + (long)row * 4096 + col) = o; } };
struct EpiOut { float* out; const float* xin; __device__ __forceinline__ void operator()(int row, int col, f32x4 v) const {
  const f32x4 x = *reinterpret_cast<const f32x4*>(xin + (long)row * 1024 + col);
  *reinterpret_cast<f32x4*>(out + (long)row * 1024 + col) = x + v; } };

__device__ __forceinline__ void phase1(const P& p) {
  char* ws = p.ws;
  EpiP1 e{(u16*)(ws + O_P)};
  fg::gemm_phase<EpiP1, true>((LAS3 unsigned char*)smem, (const u16*)(ws + O_H), 1024, (const u16*)(ws + O_WIN), 1024, T, 6400, 1024, e);
}

__device__ __forceinline__ void phase2(const P& p, int l) {
  const int TIDX = opaque_tid();
  const int BIDX = opaque_bid();
  char* ws = p.ws;
  const u16* __restrict__ PB = (const u16*)(ws + O_P);
  u16* __restrict__ DQ = (u16*)(ws + QK_DQ); u16* __restrict__ DKb = (u16*)(ws + QK_DK);
  u16* __restrict__ CQN = (u16*)(ws + OA_CQN); u16* __restrict__ CKVN = (u16*)(ws + OA_CKVN);
  u16* __restrict__ LINW = (u16*)(ws + OA_LINW); u16* __restrict__ LINA = (u16*)(ws + OA_LINA);
  const int wid = TIDX >> 6, lane = TIDX & 63, l7 = lane & 7, e0 = l7 * 8, hv = lane >> 3;
  const F8 gq = ld8f(p.in[I_DQN] + l * 64 + e0), gk = ld8f(p.in[I_DKN] + l * 64 + e0);
  float invd[8];
#pragma unroll
  for (int j = 0; j < 8; ++j) invd[j] = exp2f(-(float)j * (1.f / 8.f) * 18.931568569324174f);
  F8 glat = zero8();
  if (lane < 32) glat = ld8f(p.in[I_QLN] + l * 256 + lane * 8); else if (lane < 48) glat = ld8f(p.in[I_KVLN] + l * 128 + (lane - 32) * 8);
  F8 mu0 = zero8(), mu1 = zero8();
  if (lane < 32) { mu0 = ld8f(p.in[I_MU] + (long)l * 2 * 1792 + 1536 + lane * 8); mu1 = ld8f(p.in[I_MU] + (long)l * 2 * 1792 + 1792 + 1536 + lane * 8); }
  for (int t = BIDX * 8 + wid; t < T; t += gridDim.x * 8) {
    const int b = t >> 12, s = t & 4095;
    const u16* pr = PB + (long)t * NP;
    F8 q = ld8bf(pr + C_DQ + lane * 8), k = ld8bf(pr + C_DK + lane * 8);
    F8 lat = zero8(); if (lane < 48) lat = ld8bf(pr + C_MCQ + lane * 8);
    F8 xc = zero8(), xp = zero8(), xn = zero8();
    if (lane < 32) { xc = ld8bf(pr + C_RC + 1536 + lane * 8); if (s > 0) xp = ld8bf(pr - NP + C_RC + 1536 + lane * 8); if (s < S - 1) xn = ld8bf(pr + NP + C_RC + 1536 + lane * 8); }
    float sq = 0.f, sk = 0.f;
#pragma unroll
    for (int j = 0; j < 8; ++j) { sq += q.v[j] * q.v[j]; sk += k.v[j] * k.v[j]; }
    sq = grp8sum(sq); sk = grp8sum(sk);
    const float cq_ = rsqrtf(sq * (1.f / 64.f) + 1e-6f), ck_ = rsqrtf(sk * (1.f / 64.f) + 1e-6f);
#pragma unroll
    for (int j = 0; j < 8; ++j) {
      float yq = q.v[j] * cq_ * gq.v[j], yk = k.v[j] * ck_ * gk.v[j];
      const float pq = dpp_xor1(yq), pk = dpp_xor1(yk);
      float sn, cs; sincos_rev((float)s * invd[j], sn, cs);
      if (l7 == 0) { yq = yq * cs - pq * sn; yk = yk * cs - pk * sn; }
      else if (l7 == 1) { yq = pq * sn + yq * cs; yk = pk * sn + yk * cs; }
      q.v[j] = yq; k.v[j] = yk;
    }
    st8bf(DQ + ((long)(b * 8 + hv) * S + s) * 64 + e0, q);
    st8bf(DKb + ((long)(b * 8 + hv) * S + s) * 64 + e0, k);
    {
      float ss = 0.f;
#pragma unroll
      for (int j = 0; j < 8; ++j) ss += lat.v[j] * lat.v[j];
      const float s1 = wsum(lane < 32 ? ss : 0.f), s2 = wsum((lane >= 32 && lane < 48) ? ss : 0.f);
      const float sc = (lane < 32) ? rsqrtf(s1 * (1.f / 256.f) + 1e-6f) : rsqrtf(s2 * (1.f / 128.f) + 1e-6f);
#pragma unroll
      for (int j = 0; j < 8; ++j) lat.v[j] = lat.v[j] * sc * glat.v[j];
      if (lane < 32) st8bf(CQN + (long)t * 256 + lane * 8, lat); else if (lane < 48) st8bf(CKVN + (long)t * 128 + (lane - 32) * 8, lat);
    }
    if (lane < 32) {
      F8 o;
#pragma unroll
      for (int j = 0; j < 8; ++j) {
        const float xs = xc.v[j] + mu0.v[j] * (xp.v[j] - xc.v[j]) + mu1.v[j] * (xn.v[j] - xc.v[j]);
        if (lane < 16) { const float e2 = __expf(2.f * xs); o.v[j] = 1.f - 2.f * __builtin_amdgcn_rcpf(e2 + 1.f); } else o.v[j] = xs;
      }
      if (lane < 16) st8bf(LINW + (long)t * 128 + lane * 8, o); else st8bf(LINA + (long)t * 128 + (lane - 16) * 8, o);
    }
  }
}

__device__ __forceinline__ void phase3(const P& p) {
  const int TIDX = opaque_tid();
  const int BIDX = opaque_bid();
  char* ws = p.ws;
  for (int ti = BIDX; ti < 30 * 64; ti += gridDim.x) {
    const int ng = ti % 30, mt = ti / 30; const int m0 = mt * 256;
    const u16* A; long lda; const u16* Bt; long ldb; int K; u16* C; long ldc; int n0;
    if (ng < 6) { A = (const u16*)(ws + OA_CQN); lda = 256; K = 256; n0 = ng * 128; Bt = (const u16*)(ws + O_UQ) + (long)n0 * 256; ldb = 256; C = (u16*)(ws + OA_QRAW); ldc = 768; }
    else if (ng < 14) { A = (const u16*)(ws + OA_CKVN); lda = 128; K = 128; n0 = (ng - 6) * 128; Bt = (const u16*)(ws + O_UKV) + (long)n0 * 128; ldb = 128; C = (u16*)(ws + OA_KVRAW); ldc = 1024; }
    else { const int q = ng - 14; const int isA = q >> 3, d = (q >> 2) & 1; n0 = (q & 3) * 128;
      A = (const u16*)(ws + (isA ? OA_LINA : OA_LINW)) + d * 64; lda = 128; K = 64;
      Bt = (const u16*)(ws + (isA ? O_AUP : O_WUP)) + (long)d * 512 * 64 + (long)n0 * 64; ldb = 64;
      C = (u16*)(ws + (isA ? OA_AL : OA_WL)) + d * 512; ldc = 1024; }
    f32x4 acc[4][4]; zero_acc<4>(acc);
    gemm_main<4>(A + (long)m0 * lda, lda, Bt, ldb, K, acc, smem);
    EPI_LOOP(4, { C[(long)m * ldc + n] = f2bf(acc[i][j][jj]); });
  }
}

__device__ __forceinline__ void phase4(const P& p, int l) {
  const int TIDX = opaque_tid();
  const int BIDX = opaque_bid();
  char* ws = p.ws;
  const u16* __restrict__ PB = (const u16*)(ws + O_P);
  const u16* __restrict__ QRAW = (const u16*)(ws + OA_QRAW); const u16* __restrict__ KVRAW = (const u16*)(ws + OA_KVRAW);
  const u16* __restrict__ WL = (const u16*)(ws + OA_WL); const u16* __restrict__ AL = (const u16*)(ws + OA_AL);
  u16* __restrict__ MQ = (u16*)(ws + QK_MQ); u16* __restrict__ MK = (u16*)(ws + QK_MK); u16* __restrict__ MV = (u16*)(ws + QK_MV);
  u16* __restrict__ RR = (u16*)(ws + RW_R); u16* __restrict__ RK = (u16*)(ws + RW_K); u16* __restrict__ RV = (u16*)(ws + RW_V); u16* __restrict__ RKK = (u16*)(ws + RW_KK);
  u16* __restrict__ RA = (u16*)(ws + RW_A); u16* __restrict__ RE = (u16*)(ws + RW_E); float* __restrict__ BON = (float*)(ws + RW_BON);
  const int wid = TIDX >> 6, lane = TIDX & 63;
  float* lp = (float*)smem;
  {
    const float* mu = p.in[I_MU] + (long)l * 2 * 1792;
    for (int i = TIDX; i < 13 * 512; i += 512) {
      const int a = i >> 9, c = i & 511; float v;
      if (a < 3) v = mu[a * 512 + c]; else if (a < 6) v = mu[1792 + (a - 3) * 512 + c];
      else if (a == 6) v = p.in[I_KK][l * 512 + c]; else if (a == 7) v = p.in[I_KA][l * 512 + c]; else if (a == 8) v = p.in[I_RK][l * 512 + c];
      else if (a < 11) v = p.in[I_W0][(l * 2 + (a - 9)) * 512 + c]; else v = p.in[I_A0][(l * 2 + (a - 11)) * 512 + c];
      lp[i] = v;
    }
  }
  __syncthreads();
  const int hA = lane >> 4, eA = (lane & 15) * 8, hB = (lane >> 3) & 3, eB = (lane & 7) * 8;
  const F8 qnA = ld8f(p.in[I_MQN] + l * 192 + eA), qnB = ld8f(p.in[I_MQN] + l * 192 + 128 + eB);
  const F8 knA = ld8f(p.in[I_MKN] + l * 192 + eA), knB = ld8f(p.in[I_MKN] + l * 192 + 128 + eB);
  float invm[8];
#pragma unroll
  for (int j = 0; j < 8; ++j) invm[j] = exp2f(-(float)((lane & 3) * 8 + j) * (1.f / 32.f) * 13.287712379549449f);
  const bool lowhalf = (lane & 4) == 0;
  for (int t = BIDX * 8 + wid; t < T; t += gridDim.x * 8) {
    const int b = t >> 12, s = t & 4095;
    const u16* pr = PB + (long)t * NP;
    F8 qA = ld8bf(QRAW + (long)t * 768 + hA * 192 + eA), qB = ld8bf(QRAW + (long)t * 768 + hB * 192 + 128 + eB);
    F8 kA = ld8bf(KVRAW + (long)t * 1024 + hA * 256 + eA), vA = ld8bf(KVRAW + (long)t * 1024 + hA * 256 + 128 + eA);
    F8 kB = ld8bf(pr + C_MKR + eB);
    {
      float sqA = 0.f, sqB = 0.f, skA = 0.f, skB = 0.f;
#pragma unroll
      for (int j = 0; j < 8; ++j) { sqA += qA.v[j] * qA.v[j]; sqB += qB.v[j] * qB.v[j]; skA += kA.v[j] * kA.v[j]; skB += kB.v[j] * kB.v[j]; }
      sqA = grp16sum(sqA); skA = grp16sum(skA); sqB = grp8sum(sqB); skB = grp8sum(skB);
      const float sqB_forA = __shfl(sqB, 8 * hA), sqA_forB = __shfl(sqA, 16 * hB);
      const float skA_forB = __shfl(skA, 16 * hB);
      const float scqA = rsqrtf((sqA + sqB_forA) * (1.f / 192.f) + 1e-6f), scqB = rsqrtf((sqA_forB + sqB) * (1.f / 192.f) + 1e-6f);
      const float sckA = rsqrtf((skA + skB) * (1.f / 192.f) + 1e-6f), sckB = rsqrtf((skA_forB + skB) * (1.f / 192.f) + 1e-6f);
#pragma unroll
      for (int j = 0; j < 8; ++j) {
        qA.v[j] *= scqA * qnA.v[j]; kA.v[j] *= sckA * knA.v[j];
        float yq = qB.v[j] * scqB * qnB.v[j], yk = kB.v[j] * sckB * knB.v[j];
        const float pq = swz_xor4(yq), pk = swz_xor4(yk);
        float sn, cs; sincos_rev((float)s * invm[j], sn, cs);
        qB.v[j] = lowhalf ? (yq * cs - pq * sn) : (pq * sn + yq * cs);
        kB.v[j] = lowhalf ? (yk * cs - pk * sn) : (pk * sn + yk * cs);
      }
      u16* mq = MQ + ((long)(b * 4 + hA) * S + s) * 192; u16* mk = MK + ((long)(b * 4 + hA) * S + s) * 192;
      st8bf(mq + eA, qA); st8bf(mk + eA, kA);
      st8bf(MV + ((long)(b * 4 + hA) * S + s) * 128 + eA, vA);
      if (lane < 32) { st8bf(MQ + ((long)(b * 4 + hB) * S + s) * 192 + 128 + eB, qB); st8bf(MK + ((long)(b * 4 + hB) * S + s) * 192 + 128 + eB, kB); }
    }
#pragma unroll 1
    for (int hf = 0; hf < 2; ++hf) {
      const int c0 = hf * 256 + lane * 4;
      const F4 xr = ld4bf(pr + C_RC + c0), xk = ld4bf(pr + C_RC + 512 + c0), xv = ld4bf(pr + C_RC + 1024 + c0);
      F4 pr_ = zero4(), pk_ = zero4(), pv_ = zero4(), nr_ = zero4(), nk_ = zero4(), nv_ = zero4();
      if (s > 0) { pr_ = ld4bf(pr - NP + C_RC + c0); pk_ = ld4bf(pr - NP + C_RC + 512 + c0); pv_ = ld4bf(pr - NP + C_RC + 1024 + c0); }
      if (s < S - 1) { nr_ = ld4bf(pr + NP + C_RC + c0); nk_ = ld4bf(pr + NP + C_RC + 512 + c0); nv_ = ld4bf(pr + NP + C_RC + 1024 + c0); }
      const F4 wl0 = ld4bf(WL + ((long)t * 2) * 512 + c0), wl1 = ld4bf(WL + ((long)t * 2 + 1) * 512 + c0);
      const F4 al0 = ld4bf(AL + ((long)t * 2) * 512 + c0), al1 = ld4bf(AL + ((long)t * 2 + 1) * 512 + c0);
      const F4 m0r = ld4f(lp + 0 * 512 + c0), m0k = ld4f(lp + 1 * 512 + c0), m0v = ld4f(lp + 2 * 512 + c0);
      const F4 m1r = ld4f(lp + 3 * 512 + c0), m1k = ld4f(lp + 4 * 512 + c0), m1v = ld4f(lp + 5 * 512 + c0);
      const F4 kkp = ld4f(lp + 6 * 512 + c0), kap = ld4f(lp + 7 * 512 + c0), rkp = ld4f(lp + 8 * 512 + c0);
      const F4 w00 = ld4f(lp + 9 * 512 + c0), w01 = ld4f(lp + 10 * 512 + c0), a00 = ld4f(lp + 11 * 512 + c0), a01 = ld4f(lp + 12 * 512 + c0);
      F4 r, k, v, kk, e0_, e1_, a0_, a1_; float ss = 0.f, bon = 0.f;
#pragma unroll
      for (int j = 0; j < 4; ++j) {
        r.v[j] = xr.v[j] + m0r.v[j] * (pr_.v[j] - xr.v[j]) + m1r.v[j] * (nr_.v[j] - xr.v[j]);
        k.v[j] = xk.v[j] + m0k.v[j] * (pk_.v[j] - xk.v[j]) + m1k.v[j] * (nk_.v[j] - xk.v[j]);
        v.v[j] = xv.v[j] + m0v.v[j] * (pv_.v[j] - xv.v[j]) + m1v.v[j] * (nv_.v[j] - xv.v[j]);
        kk.v[j] = k.v[j] * kkp.v[j]; ss += kk.v[j] * kk.v[j];
      }
      ss = grp16sum(ss);
      const float inrm = rsqrtf(fmaxf(ss, 1e-24f));
#pragma unroll
      for (int j = 0; j < 4; ++j) {
        kk.v[j] *= inrm;
        {
          e0_.v[j] = 0.6065306597126334f * sigmoidf_(w00.v[j] + wl0.v[j]);
          const float a = sigmoidf_(a00.v[j] + al0.v[j]); a0_.v[j] = a;
          bon += r.v[j] * k.v[j] * (1.f + (a - 1.f) * kap.v[j]) * rkp.v[j];
        }
        {
          e1_.v[j] = 0.6065306597126334f * sigmoidf_(w01.v[j] + wl1.v[j]);
          const float a = sigmoidf_(a01.v[j] + al1.v[j]); a1_.v[j] = a;
          bon += r.v[j] * k.v[j] * (1.f + (a - 1.f) * kap.v[j]) * rkp.v[j];
        }
      }
      bon = grp16sum(bon);
      if ((lane & 15) == 0) BON[(long)t * 8 + hf * 4 + (lane >> 4)] = bon;
      const long o = (long)t * 512 + c0;
      st4bf(RR + o, r); st4bf(RK + o, k); st4bf(RV + o, v); st4bf(RKK + o, kk);
      st4bf(RE + o, e0_); st4bf(RE + (long)T * 512 + o, e1_); st4bf(RA + o, a0_); st4bf(RA + (long)T * 512 + o, a1_);
    }
  }
  __syncthreads();
}

#define SBAR() __builtin_amdgcn_sched_barrier(0)
__device__ __forceinline__ int crow(int r, int hi) { return (r & 3) + 8 * (r >> 2) + 4 * hi; }
template <int DK> struct AC {
  static constexpr float SCALE = (DK == 64) ? 0.125f : 0.07216878364870323f;
  static constexpr float THR = 8.f;
  static constexpr int NKG = DK / 64;
  static constexpr int SHM_K = 64 * DK * 2, SHM_V = 64 * 128 * 2;
};
template <int DK>
__device__ __forceinline__ void partialSM(f32x16& p0, f32x16& p1, float& m_reg, float& mn, float& alpha) {
  constexpr float C = AC<DK>::SCALE * 1.4426950408889634f;
  float pmax = p0[0];
#pragma unroll
  for (int r = 1; r < 16; ++r) pmax = fmaxf(pmax, p0[r]);
#pragma unroll
  for (int r = 0; r < 16; ++r) pmax = fmaxf(pmax, p1[r]);
  { auto rr = __builtin_amdgcn_permlane32_swap(__float_as_uint(pmax), __float_as_uint(pmax), false, false);
    pmax = fmaxf(__uint_as_float(rr[0]), __uint_as_float(rr[1])); }
  if (__builtin_expect(__all(pmax - m_reg <= AC<DK>::THR / AC<DK>::SCALE), 1)) { mn = m_reg; alpha = 1.f; }
  else { mn = fmaxf(m_reg, pmax); alpha = __builtin_amdgcn_exp2f((m_reg - mn) * C); m_reg = mn; }
  float mnC = -mn * C;
#pragma unroll
  for (int r = 0; r < 16; ++r) p0[r] = fmaf(p0[r], C, mnC);
#pragma unroll
  for (int r = 0; r < 16; ++r) p1[r] = fmaf(p1[r], C, mnC);
#pragma unroll
  for (int r = 0; r < 16; ++r) p0[r] = __builtin_amdgcn_exp2f(p0[r]);
}
__device__ __forceinline__ void finishSM(f32x16& p0, f32x16& p1, float alpha, float& l_reg, bf16x8& pa0, bf16x8& pa1, bf16x8& pa2, bf16x8& pa3) {
#pragma unroll
  for (int r = 0; r < 16; ++r) p1[r] = __builtin_amdgcn_exp2f(p1[r]);
  float ps = 0;
#pragma unroll
  for (int r = 0; r < 16; ++r) ps += p0[r];
#pragma unroll
  for (int r = 0; r < 16; ++r) ps += p1[r];
  { auto rr = __builtin_amdgcn_permlane32_swap(__float_as_uint(ps), __float_as_uint(ps), false, false);
    ps = __uint_as_float(rr[0]) + __uint_as_float(rr[1]); }
  l_reg = l_reg * alpha + ps;
#define PK4(Pv, BASE, OUT) do { unsigned a0 = cvtpk_asm(Pv[BASE + 0], Pv[BASE + 1]), a1 = cvtpk_asm(Pv[BASE + 2], Pv[BASE + 3]);   \
    unsigned b0 = cvtpk_asm(Pv[BASE + 4], Pv[BASE + 5]), b1 = cvtpk_asm(Pv[BASE + 6], Pv[BASE + 7]);                              \
    auto r0 = __builtin_amdgcn_permlane32_swap(a0, b0, false, false); auto r1 = __builtin_amdgcn_permlane32_swap(a1, b1, false, false); \
    u32x4 w = {r0[0], r1[0], r0[1], r1[1]}; OUT = *reinterpret_cast<bf16x8*>(&w); } while (0)
  PK4(p0, 0, pa0); PK4(p0, 8, pa1); PK4(p1, 0, pa2); PK4(p1, 8, pa3);
#undef PK4
}
template <int DK>
__device__ __forceinline__ void qkt(f32x16& p0, f32x16& p1, const char* Ks, const bf16x8* qr, int r32, int hi) {
  p0 = f32x16{}; p1 = f32x16{};
  const int sw = (r32 & 7) << 4;
  const char* kb[4];
#pragma unroll
  for (int q = 0; q < 4; ++q) kb[q] = Ks + r32 * (DK * 2) + ((q * 32 + hi * 16) ^ sw);
#pragma unroll
  for (int d0 = 0; d0 < DK / 16; ++d0) {
    bf16x8 b0 = *reinterpret_cast<const bf16x8*>(kb[d0 & 3] + (d0 >> 2) * 128);
    bf16x8 b1 = *reinterpret_cast<const bf16x8*>(kb[d0 & 3] + (d0 >> 2) * 128 + 32 * (DK * 2));
    p0 = __builtin_amdgcn_mfma_f32_32x32x16_bf16(b0, qr[d0], p0, 0, 0, 0);
    p1 = __builtin_amdgcn_mfma_f32_32x32x16_bf16(b1, qr[d0], p1, 0, 0, 0); }
}
__device__ __forceinline__ int v_st(int k, int c) { const int kk = (k & ~0xC) | ((k & 4) << 1) | ((k & 8) >> 1); return ((kk >> 3) * 4 + (c >> 5)) * 512 + ((kk & 7) * 32 + (c & 31)) * 2; }
__device__ __forceinline__ int v_rd_base(int lane) { return ((lane & 3) << 3) | (((lane >> 2) & 3) << 6) | (((lane >> 4) & 1) << 5) | (((lane >> 5) & 1) << 8); }
constexpr int v_rd_off(int d0, int ks, int half) { return d0 * 512 + ks * 4096 + half * 2048; }
template <int OFF> __device__ __forceinline__ s16x4 tr_read(int vb) {
  s16x4 r; asm volatile("ds_read_b64_tr_b16 %0, %1 offset:%2" : "=&v"(r) : "v"(vb), "i"(OFF) : "memory"); return r;
}
template <int D0> __device__ __forceinline__ void pv_one(f32x16& od, int vb, bf16x8 pa0, bf16x8 pa1, bf16x8 pa2, bf16x8 pa3) {
  const s16x4 l0 = tr_read<v_rd_off(D0, 0, 0)>(vb), h0 = tr_read<v_rd_off(D0, 0, 1)>(vb), l1 = tr_read<v_rd_off(D0, 1, 0)>(vb), h1 = tr_read<v_rd_off(D0, 1, 1)>(vb);
  const s16x4 l2 = tr_read<v_rd_off(D0, 2, 0)>(vb), h2 = tr_read<v_rd_off(D0, 2, 1)>(vb), l3 = tr_read<v_rd_off(D0, 3, 0)>(vb), h3 = tr_read<v_rd_off(D0, 3, 1)>(vb);
  asm volatile("s_waitcnt lgkmcnt(0)" ::: "memory"); SBAR();
#define PKV(L, H) (bf16x8){L[0], L[1], L[2], L[3], H[0], H[1], H[2], H[3]}
  od = __builtin_amdgcn_mfma_f32_32x32x16_bf16(pa0, PKV(l0, h0), od, 0, 0, 0);
  od = __builtin_amdgcn_mfma_f32_32x32x16_bf16(pa1, PKV(l1, h1), od, 0, 0, 0);
  od = __builtin_amdgcn_mfma_f32_32x32x16_bf16(pa2, PKV(l2, h2), od, 0, 0, 0);
  od = __builtin_amdgcn_mfma_f32_32x32x16_bf16(pa3, PKV(l3, h3), od, 0, 0, 0);
#undef PKV
}
__device__ __forceinline__ void pv_d0(f32x16* o, int vb, bf16x8 pa0, bf16x8 pa1, bf16x8 pa2, bf16x8 pa3) {
  pv_one<0>(o[0], vb, pa0, pa1, pa2, pa3); pv_one<1>(o[1], vb, pa0, pa1, pa2, pa3); pv_one<2>(o[2], vb, pa0, pa1, pa2, pa3); pv_one<3>(o[3], vb, pa0, pa1, pa2, pa3);
}
__device__ __forceinline__ void ostore(float* p, float v) { *p = v; }
__device__ __forceinline__ void ostore(u16* p, float v) { *p = f2bf(v); }

template <int DK, int SD, int LDQ, int LDK, int LDV, int LDO, typename TO>
__device__ __forceinline__ void attn_body(const u16* __restrict__ Qb, const u16* __restrict__ Kh, const u16* __restrict__ Vh,
                                          TO* __restrict__ Ob, int seq, char* lds) {
  const int TIDX = opaque_tid();
  constexpr int SHM_V = AC<DK>::SHM_V, SHM_K = AC<DK>::SHM_K, NKG = AC<DK>::NKG, KG = DK / 8;
  const int tid = TIDX, wid = tid >> 6, lane = tid & 63, r32 = lane & 31, hi = lane >> 5;
  char* V_lds = lds; char* K_lds = lds + 2 * SHM_V;
  float* wsl = (float*)(lds + 2 * SHM_V + 2 * SHM_K) + wid * 64; float* li_l = wsl; float* al_l = wsl + 32;
  float m_reg = -1e30f, l_reg = 0; f32x16 o[4] = {}; bf16x8 qr[DK / 16];
  const u16* Qw = Qb + (long)(wid * 32 + r32) * LDQ + hi * 8;
#pragma unroll
  for (int d0 = 0; d0 < DK / 16; ++d0) qr[d0] = *reinterpret_cast<const bf16x8*>(Qw + d0 * 16);
  const int sr = tid >> 4, sc = (tid & 15) * 8, vst0 = v_st(sr, sc), vst1 = v_st(32 + sr, sc);
  const int vb0 = (int)(uintptr_t)V_lds + v_rd_base(lane);
  struct { bf16x8 vs0, vs1, ks[NKG]; } sr_[SD];
#define SLOAD(i, k0) do { sr_[i].vs0 = *reinterpret_cast<const bf16x8*>(&Vh[(long)((k0) + sr) * LDV + sc]); \
    sr_[i].vs1 = *reinterpret_cast<const bf16x8*>(&Vh[(long)((k0) + 32 + sr) * LDV + sc]); \
    _Pragma("unroll") for (int g_ = 0; g_ < NKG; ++g_) { const int gi_ = tid + 512 * g_; const int kr_ = gi_ / KG, kc_ = (gi_ % KG) * 8; \
      sr_[i].ks[g_] = *reinterpret_cast<const bf16x8*>(&Kh[(long)((k0) + kr_) * LDK + kc_]); } } while (0)
#define SWRITE(b, i) do { *(bf16x8*)(V_lds + (b) * SHM_V + vst0) = sr_[i].vs0; *(bf16x8*)(V_lds + (b) * SHM_V + vst1) = sr_[i].vs1; \
    _Pragma("unroll") for (int g_ = 0; g_ < NKG; ++g_) { const int gi_ = tid + 512 * g_; const int kr_ = gi_ / KG, kc_ = (gi_ % KG) * 16; \
      *(bf16x8*)(K_lds + (b) * SHM_K + kr_ * (DK * 2) + (kc_ ^ ((kr_ & 7) << 4))) = sr_[i].ks[g_]; } } while (0)
#define SWAIT() do { if constexpr (SD == 2) { if constexpr (NKG == 1) asm volatile("s_waitcnt vmcnt(3)" ::: "memory"); else asm volatile("s_waitcnt vmcnt(5)" ::: "memory"); } \
    else asm volatile("s_waitcnt vmcnt(0)" ::: "memory"); } while (0)
#define RESC(a) do { if (__any((a) < 1.f)) { if (hi == 0) al_l[r32] = (a); asm volatile("s_waitcnt lgkmcnt(0)" ::: "memory"); \
    _Pragma("unroll") for (int d = 0; d < 4; ++d) _Pragma("unroll") for (int r = 0; r < 16; ++r) o[d][r] *= al_l[crow(r, hi)]; } } while (0)
  f32x16 pA0, pA1, pB0, pB1; float mnA, mnB, alA, alB; bf16x8 pa0, pa1, pa2, pa3; const int NT = seq / 64;
  constexpr int SE = 0, SO = SD - 1;
  SLOAD(SE, 0); asm volatile("s_waitcnt vmcnt(0)" ::: "memory"); SWRITE(0, SE); __syncthreads();
  qkt<DK>(pA0, pA1, K_lds, qr, r32, hi); partialSM<DK>(pA0, pA1, m_reg, mnA, alA);
  SLOAD(SO, 64); if constexpr (SD == 2) { if (2 < NT) SLOAD(SE, 2 * 64); }
  SWAIT(); SWRITE(1, SO); __syncthreads();
  for (int j = 1; j + 1 < NT; j += 2) {
    SBAR(); qkt<DK>(pB0, pB1, K_lds + SHM_K, qr, r32, hi);
    finishSM(pA0, pA1, alA, l_reg, pa0, pa1, pa2, pa3); SBAR();
    SLOAD(SO, (j + SD) * 64); SBAR();
    pv_d0(o, vb0, pa0, pa1, pa2, pa3); partialSM<DK>(pB0, pB1, m_reg, mnB, alB);
    __syncthreads(); SWAIT(); SWRITE(0, SE);
    RESC(alB); __syncthreads();
    SBAR(); qkt<DK>(pA0, pA1, K_lds, qr, r32, hi);
    finishSM(pB0, pB1, alB, l_reg, pa0, pa1, pa2, pa3); SBAR();
    if (SD == 1 || j + 3 < NT) SLOAD(SE, (j + 1 + SD) * 64); SBAR();
    pv_d0(o, vb0 + SHM_V, pa0, pa1, pa2, pa3); partialSM<DK>(pA0, pA1, m_reg, mnA, alA);
    __syncthreads(); SWAIT(); SWRITE(1, SO);
    RESC(alA); __syncthreads();
  }
  SBAR(); qkt<DK>(pB0, pB1, K_lds + SHM_K, qr, r32, hi);
  finishSM(pA0, pA1, alA, l_reg, pa0, pa1, pa2, pa3); SBAR();
  pv_d0(o, vb0, pa0, pa1, pa2, pa3); partialSM<DK>(pB0, pB1, m_reg, mnB, alB);
  __syncthreads(); RESC(alB);
  finishSM(pB0, pB1, alB, l_reg, pa0, pa1, pa2, pa3); SBAR();
  pv_d0(o, vb0 + SHM_V, pa0, pa1, pa2, pa3);
  if (hi == 0) li_l[r32] = l_reg; asm volatile("s_waitcnt lgkmcnt(0)" ::: "memory");
  float rli[16];
#pragma unroll
  for (int r = 0; r < 16; ++r) rli[r] = __builtin_amdgcn_rcpf(li_l[crow(r, hi)]);
  TO* Ow = Ob + (long)(wid * 32) * LDO;
#pragma unroll
  for (int r = 0; r < 16; ++r) { const int orow = crow(r, hi);
#pragma unroll
    for (int d0 = 0; d0 < 4; ++d0) ostore(&Ow[(long)orow * LDO + d0 * 32 + r32], o[d0][r] * rli[r]); }
#undef SLOAD
#undef SWRITE
#undef SWAIT
#undef RESC
}

template <int DK, int LDQ, int LDK, int LDV, int LDO, typename TO>
__device__ __forceinline__ void attn_body_simple(const u16* __restrict__ Qb, const u16* __restrict__ Kh, const u16* __restrict__ Vh,
                                                 TO* __restrict__ Ob, int seq, char* lds) {
  const int TIDX = opaque_tid();
  constexpr int SHM_V = AC<DK>::SHM_V, SHM_K = AC<DK>::SHM_K, NKG = AC<DK>::NKG, KG = DK / 8;
  const int tid = TIDX, wid = tid >> 6, lane = tid & 63, r32 = lane & 31, hi = lane >> 5;
  char* V_lds = lds; char* K_lds = lds + 2 * SHM_V;
  float* wsl = (float*)(lds + 2 * SHM_V + 2 * SHM_K) + wid * 64; float* li_l = wsl; float* al_l = wsl + 32;
  float m_reg = -1e30f, l_reg = 0; f32x16 o[4] = {}; bf16x8 qr[DK / 16];
  const u16* Qw = Qb + (long)(wid * 32 + r32) * LDQ + hi * 8;
#pragma unroll
  for (int d0 = 0; d0 < DK / 16; ++d0) qr[d0] = *reinterpret_cast<const bf16x8*>(Qw + d0 * 16);
  const int sr = tid >> 4, sc = (tid & 15) * 8, vst0 = v_st(sr, sc), vst1 = v_st(32 + sr, sc);
  const int vb0 = (int)(uintptr_t)V_lds + v_rd_base(lane);
  bf16x8 vs0, vs1, ks[NKG];
#define SLOAD(k0) do { vs0 = *reinterpret_cast<const bf16x8*>(&Vh[(long)((k0) + sr) * LDV + sc]); \
    vs1 = *reinterpret_cast<const bf16x8*>(&Vh[(long)((k0) + 32 + sr) * LDV + sc]); \
    _Pragma("unroll") for (int g_ = 0; g_ < NKG; ++g_) { const int gi_ = tid + 512 * g_; const int kr_ = gi_ / KG, kc_ = (gi_ % KG) * 8; \
      ks[g_] = *reinterpret_cast<const bf16x8*>(&Kh[(long)((k0) + kr_) * LDK + kc_]); } } while (0)
#define SWRITE(b) do { *(bf16x8*)(V_lds + (b) * SHM_V + vst0) = vs0; *(bf16x8*)(V_lds + (b) * SHM_V + vst1) = vs1; \
    _Pragma("unroll") for (int g_ = 0; g_ < NKG; ++g_) { const int gi_ = tid + 512 * g_; const int kr_ = gi_ / KG, kc_ = (gi_ % KG) * 16; \
      *(bf16x8*)(K_lds + (b) * SHM_K + kr_ * (DK * 2) + (kc_ ^ ((kr_ & 7) << 4))) = ks[g_]; } } while (0)
  const int NT = seq / 64;
  SLOAD(0); SWRITE(0); __syncthreads();
#pragma unroll 1
  for (int j = 0; j < NT; ++j) {
    const int cur = j & 1;
    if (j + 1 < NT) SLOAD((j + 1) * 64);
    f32x16 p0, p1; float mn, al; bf16x8 pa0, pa1, pa2, pa3;
    qkt<DK>(p0, p1, K_lds + cur * SHM_K, qr, r32, hi);
    partialSM<DK>(p0, p1, m_reg, mn, al);
    if (__any(al < 1.f)) { if (hi == 0) al_l[r32] = al; asm volatile("s_waitcnt lgkmcnt(0)" ::: "memory");
#pragma unroll
      for (int d = 0; d < 4; ++d)
#pragma unroll
        for (int r = 0; r < 16; ++r) o[d][r] *= al_l[crow(r, hi)]; }
    finishSM(p0, p1, al, l_reg, pa0, pa1, pa2, pa3); SBAR();
    pv_d0(o, vb0 + cur * SHM_V, pa0, pa1, pa2, pa3);
    if (j + 1 < NT) SWRITE(cur ^ 1);
    __syncthreads();
  }
  if (hi == 0) li_l[r32] = l_reg; asm volatile("s_waitcnt lgkmcnt(0)" ::: "memory");
  float rli[16];
#pragma unroll
  for (int r = 0; r < 16; ++r) rli[r] = __builtin_amdgcn_rcpf(li_l[crow(r, hi)]);
  TO* Ow = Ob + (long)(wid * 32) * LDO;
#pragma unroll
  for (int r = 0; r < 16; ++r) { const int orow = crow(r, hi);
#pragma unroll
    for (int d0 = 0; d0 < 4; ++d0) ostore(&Ow[(long)orow * LDO + d0 * 32 + r32], o[d0][r] * rli[r]); }
#undef SLOAD
#undef SWRITE
}

__device__ __forceinline__ void rwkv_item(const P& p, int l, int item, char* lds) {
  const int TIDX = opaque_tid();
  char* ws = p.ws;
  const int d = item & 1, b = (item >> 1) & 3, h = item >> 3;
  constexpr int CM = 16, REC = 584, BUF = CM * REC, NCH = S / (2 * CM), OFF_SC = 448, OFF_D = 456;
  float* buf0 = (float*)lds; float* buf1 = buf0 + BUF; float* yout = buf1 + BUF;
  const int tid = TIDX, wid = tid >> 6, lane = tid & 63;
  const bool consumer = wid < 4;
  const u16* RR = (const u16*)(ws + RW_R); const u16* RK = (const u16*)(ws + RW_K); const u16* RV = (const u16*)(ws + RW_V); const u16* RKK = (const u16*)(ws + RW_KK);
  const u16* RA = (const u16*)(ws + RW_A) + (long)d * T * 512; const u16* RE = (const u16*)(ws + RW_E) + (long)d * T * 512;
  u16* YR = (u16*)(ws + OO_YR) + (long)d * T * 512;
  const int sg = wid & 3;
  struct PR { uint2 r[2], k[2], v[2], kk[2], a[2], e[2]; };
  const int pm = sg * 4 + (lane >> 4), pk0 = (lane & 15) * 4;
  const F4 ka4 = ld4f(p.in[I_KA] + l * 512 + h * 64 + pk0);
  auto pload = [&](int c) {
    PR x;
#pragma unroll
    for (int q = 0; q < 2; ++q) {
      const int sidx = c * (2 * CM) + pm * 2 + q, t = d ? (S - 1 - sidx) : sidx;
      const long off = ((long)(b * S + t)) * 512 + h * 64 + pk0;
      x.r[q] = *reinterpret_cast<const uint2*>(RR + off); x.k[q] = *reinterpret_cast<const uint2*>(RK + off); x.v[q] = *reinterpret_cast<const uint2*>(RV + off);
      x.kk[q] = *reinterpret_cast<const uint2*>(RKK + off); x.a[q] = *reinterpret_cast<const uint2*>(RA + off); x.e[q] = *reinterpret_cast<const uint2*>(RE + off);
    }
    return x;
  };
  auto unp = [](const uint2& u, int j) { const unsigned w = (j < 2) ? u.x : u.y; return (j & 1) ? __uint_as_float(w & 0xffff0000u) : __uint_as_float(w << 16); };
  auto pfinish = [&](const PR& x, float* buf) {
    float* rec = buf + pm * REC;
    f32x4 ww, bw, kw, b2v, k2v, v1v, v2v; float d1[4], d2[4], d3[4], d4[4];
    float c1 = 0.f, c2 = 0.f, c3 = 0.f, c4 = 0.f, c5 = 0.f, c6 = 0.f, c7 = 0.f, c8 = 0.f;
#pragma unroll
    for (int j = 0; j < 4; ++j) {
      const float r1 = unp(x.r[0], j), k1r = unp(x.k[0], j), v1 = unp(x.v[0], j), kk1 = unp(x.kk[0], j), a1 = unp(x.a[0], j), e1 = unp(x.e[0], j);
      const float r2 = unp(x.r[1], j), k2r = unp(x.k[1], j), v2 = unp(x.v[1], j), kk2 = unp(x.kk[1], j), a2 = unp(x.a[1], j), e2 = unp(x.e[1], j);
      const float w1 = __expf(-e1), w2 = __expf(-e2);
      const float z1 = -kk1, z2 = -kk2, b1 = kk1 * a1, b2 = kk2 * a2;
      const float k1 = k1r * (1.f + (a1 - 1.f) * ka4.v[j]), k2 = k2r * (1.f + (a2 - 1.f) * ka4.v[j]);
      const float w2r2 = w2 * r2;
      ww[j] = w1 * w2; bw[j] = b1 * w2; kw[j] = k1 * w2; b2v[j] = b2; k2v[j] = k2; v1v[j] = v1; v2v[j] = v2;
      d1[j] = z1; d2[j] = w1 * z2; d3[j] = w1 * r1; d4[j] = w1 * w2r2;
      c1 += b1 * z2; c2 += k1 * z2; c3 += b1 * r1; c4 += k1 * r1; c5 += b1 * w2r2; c6 += k1 * w2r2; c7 += b2 * r2; c8 += k2 * r2;
    }
    *reinterpret_cast<f32x4*>(rec + pk0) = ww;        *reinterpret_cast<f32x4*>(rec + 64 + pk0) = bw;   *reinterpret_cast<f32x4*>(rec + 128 + pk0) = kw;
    *reinterpret_cast<f32x4*>(rec + 192 + pk0) = b2v; *reinterpret_cast<f32x4*>(rec + 256 + pk0) = k2v;
    *reinterpret_cast<f32x4*>(rec + 320 + pk0) = v1v; *reinterpret_cast<f32x4*>(rec + 384 + pk0) = v2v;
    { uint2 q;
      q.x = cvtpk(d1[0], d1[1]); q.y = cvtpk(d1[2], d1[3]); *reinterpret_cast<uint2*>(rec + OFF_D + 0 * 32 + (lane & 15) * 2) = q;
      q.x = cvtpk(d2[0], d2[1]); q.y = cvtpk(d2[2], d2[3]); *reinterpret_cast<uint2*>(rec + OFF_D + 1 * 32 + (lane & 15) * 2) = q;
      q.x = cvtpk(d3[0], d3[1]); q.y = cvtpk(d3[2], d3[3]); *reinterpret_cast<uint2*>(rec + OFF_D + 2 * 32 + (lane & 15) * 2) = q;
      q.x = cvtpk(d4[0], d4[1]); q.y = cvtpk(d4[2], d4[3]); *reinterpret_cast<uint2*>(rec + OFF_D + 3 * 32 + (lane & 15) * 2) = q; }
    c1 = grp16sum(c1); c2 = grp16sum(c2); c3 = grp16sum(c3); c4 = grp16sum(c4); c5 = grp16sum(c5); c6 = grp16sum(c6); c7 = grp16sum(c7); c8 = grp16sum(c8);
    if ((lane & 15) == 0) { *reinterpret_cast<f32x4*>(rec + OFF_SC) = f32x4{c1, c2, c3, c4}; *reinterpret_cast<f32x4*>(rec + OFF_SC + 4) = f32x4{c5, c6, c7, c8}; }
  };
  auto store_y = [&](int c) {
    const float* yo = yout + (c & 1) * (32 * 64);
#pragma unroll
    for (int i = 0; i < 8; ++i) {
      const int s = sg + 4 * i, sidx = c * 32 + s, t = d ? (S - 1 - sidx) : sidx;
      YR[((long)(b * S + t)) * 512 + h * 64 + lane] = f2bf(yo[s * 64 + lane]);
    }
  };
  const int j16 = lane & 15, g = lane >> 4, row = (wid & 3) * 16 + j16;
  const int aoff = OFF_D + (j16 & 3) * 32;
  f2 st[8];
#pragma unroll
  for (int i = 0; i < 8; ++i) st[i] = f2{0.f, 0.f};
  struct Ops { bf16x8 a0, a1; f2 v; f32x4 s0, s1; };
  auto ldops = [&](const float* rec) {
    Ops o;
    o.a0 = *reinterpret_cast<const bf16x8*>(rec + aoff + g * 4);
    o.a1 = *reinterpret_cast<const bf16x8*>(rec + aoff + 16 + g * 4);
    o.v = f2{rec[320 + row], rec[384 + row]};
    o.s0 = *reinterpret_cast<const f32x4*>(rec + OFF_SC); o.s1 = *reinterpret_cast<const f32x4*>(rec + OFF_SC + 4);
    return o;
  };
  PR pnx;
  if (!consumer) { PR p0 = pload(0); pfinish(p0, buf0); pnx = pload(1); }
  __syncthreads();
  for (int c = 0; c < NCH; ++c) {
    float* buf = (c & 1) ? buf1 : buf0;
    if (consumer) {
      float* yo = yout + (c & 1) * (32 * 64);
      auto step = [&](const Ops& cur, int ms) {
        const float* rec = buf + ms * REC;
        f32x4 ww[4], bw[4], kw[4], b2[4], k2[4];
#pragma unroll
        for (int m = 0; m < 2; ++m)
#pragma unroll
          for (int hq = 0; hq < 2; ++hq) {
            const int o = m * 32 + g * 8 + hq * 4;
            ww[m * 2 + hq] = *reinterpret_cast<const f32x4*>(rec + o);        bw[m * 2 + hq] = *reinterpret_cast<const f32x4*>(rec + 64 + o);
            kw[m * 2 + hq] = *reinterpret_cast<const f32x4*>(rec + 128 + o);  b2[m * 2 + hq] = *reinterpret_cast<const f32x4*>(rec + 192 + o);
            k2[m * 2 + hq] = *reinterpret_cast<const f32x4*>(rec + 256 + o);
          }
        u32x4 q0, q1;
        q0[0] = cvtpk(st[0][0], st[0][1]); q0[1] = cvtpk(st[1][0], st[1][1]); q0[2] = cvtpk(st[2][0], st[2][1]); q0[3] = cvtpk(st[3][0], st[3][1]);
        q1[0] = cvtpk(st[4][0], st[4][1]); q1[1] = cvtpk(st[5][0], st[5][1]); q1[2] = cvtpk(st[6][0], st[6][1]); q1[3] = cvtpk(st[7][0], st[7][1]);
        f32x4 dd = f32x4{0.f, 0.f, 0.f, 0.f};
        dd = __builtin_amdgcn_mfma_f32_16x16x32_bf16(cur.a0, __builtin_bit_cast(bf16x8, q0), dd, 0, 0, 0);
        dd = __builtin_amdgcn_mfma_f32_16x16x32_bf16(cur.a1, __builtin_bit_cast(bf16x8, q1), dd, 0, 0, 0);
        const float v1 = cur.v[0], v2 = cur.v[1];
        const float sa1 = dd[0];
        const float sa2 = dd[1] + sa1 * cur.s0[0] + v1 * cur.s0[1];
        const float y1 = dd[2] + sa1 * cur.s0[2] + v1 * cur.s0[3];
        const float y2 = dd[3] + sa1 * cur.s1[0] + v1 * cur.s1[1] + sa2 * cur.s1[2] + v2 * cur.s1[3];
        const f2 sa1v = f2{sa1, sa1}, v1v = f2{v1, v1}, sa2v = f2{sa2, sa2}, v2v = f2{v2, v2};
#pragma unroll
        for (int q = 0; q < 4; ++q) {
#pragma unroll
          for (int hh = 0; hh < 2; ++hh) {
            const f2 w_ = f2{ww[q][2 * hh], ww[q][2 * hh + 1]}, bw_ = f2{bw[q][2 * hh], bw[q][2 * hh + 1]}, kw_ = f2{kw[q][2 * hh], kw[q][2 * hh + 1]};
            const f2 b2_ = f2{b2[q][2 * hh], b2[q][2 * hh + 1]}, k2_ = f2{k2[q][2 * hh], k2[q][2 * hh + 1]};
            st[q * 2 + hh] = st[q * 2 + hh] * w_ + ((sa1v * bw_ + v1v * kw_) + (sa2v * b2_ + v2v * k2_));
          }
        }
        if (g == 0) { yo[(2 * ms) * 64 + row] = y1; yo[(2 * ms + 1) * 64 + row] = y2; }
      };
      Ops oa = ldops(buf);
#pragma unroll 1
      for (int ms = 0; ms < CM; ms += 2) {
        const Ops ob = ldops(buf + (ms + 1) * REC);
        step(oa, ms);
        if (ms + 2 < CM) oa = ldops(buf + (ms + 2) * REC);
        step(ob, ms + 1);
      }
    } else {
      if (c + 1 < NCH) { pfinish(pnx, (c & 1) ? buf0 : buf1); if (c + 2 < NCH) pnx = pload(c + 2); }
      if (c >= 1) store_y(c - 1);
    }
    __syncthreads();
  }
  if (!consumer) store_y(NCH - 1);
  __syncthreads();
}

__device__ __forceinline__ bf16x8 pad8(s16x4 v) { return bf16x8{v[0], v[1], v[2], v[3], 0, 0, 0, 0}; }
__device__ __forceinline__ void cmul(float ar, float ai, float br, float bi, float& cr, float& ci) { cr = ar * br - ai * bi; ci = ar * bi + ai * br; }
__device__ __forceinline__ void s5_item(const P& p, int l, int item, char* lds) {
  const int TIDX = opaque_tid();
  char* ws = p.ws;
  const int d = item & 1, g = (item >> 1) & 31, b = item >> 6;
  const int tid = TIDX, wv = tid >> 6, lane = tid & 63, jj = lane & 15, gq = lane >> 4;
  const long pg = ((long)(l * 2 + d) * 32 + g);
  const float* lre = p.in[I_LRE] + pg * 64; const float* lim = p.in[I_LIM] + pg * 64;
  const float dt = __expf(p.in[I_LDT][pg]);
  const float* bre = p.in[I_BRE] + pg * 64 * 16; const float* bim = p.in[I_BIM] + pg * 64 * 16;
  const float* cre = p.in[I_CRE] + pg * 16 * 64; const float* cim = p.in[I_CIM] + pg * 16 * 64;
  const u16* PB = (const u16*)(ws + O_P);
  u16* YS = (u16*)(ws + OO_YS) + (long)d * T * 512;
  float ar[16], ai[16];
  s16x4 Bop[8], Cop[8];
#pragma unroll
  for (int tl = 0; tl < 8; ++tl) {
#pragma unroll
    for (int e = 0; e < 2; ++e) {
      const int stt = tl * 8 + gq * 2 + e;
      const float lr = fminf(lre[stt], -1e-4f), li = lim[stt];
      const float mag = __expf(lr * dt); float sn, cs; sincos_rev(li * dt, sn, cs);
      ar[tl * 2 + e] = mag * cs; ai[tl * 2 + e] = mag * sn;
    }
    {
      const int i = lane & 15; const int stt = tl * 8 + (i >> 2) * 2 + (i & 1), part = (i >> 1) & 1;
      const float lr = fminf(lre[stt], -1e-4f), li = lim[stt];
      const float mag = __expf(lr * dt); float sn, cs; sincos_rev(li * dt, sn, cs);
      const float abr = mag * cs, abi = mag * sn, den = lr * lr + li * li;
      const float cor = ((abr - 1.f) * lr + abi * li) / den, coi = (abi * lr - (abr - 1.f) * li) / den;
      float vals[4];
#pragma unroll
      for (int c = 0; c < 4; ++c) {
        const float br_ = bre[stt * 16 + gq * 4 + c], bi_ = bim[stt * 16 + gq * 4 + c];
        vals[c] = part ? (cor * bi_ + coi * br_) : (cor * br_ - coi * bi_);
      }
      Bop[tl] = s16x4{(short)f2bf(vals[0]), (short)f2bf(vals[1]), (short)f2bf(vals[2]), (short)f2bf(vals[3])};
      float cv[4];
#pragma unroll
      for (int j = 0; j < 4; ++j) {
        const int st2 = tl * 8 + gq * 2 + (j & 1);
        cv[j] = (j >> 1) ? -cim[i * 64 + st2] : cre[i * 64 + st2];
      }
      Cop[tl] = s16x4{(short)f2bf(cv[0]), (short)f2bf(cv[1]), (short)f2bf(cv[2]), (short)f2bf(cv[3])};
    }
  }
  int bad_ = 9999;
#define UPD(v, code, th) do { if (!(fabsf(v) < (th))) bad_ = min(bad_, (code)); } while (0)
#pragma unroll
  for (int k = 0; k < 16; ++k) { UPD(ar[k] * ar[k] + ai[k] * ai[k], 30, 1.0f); }
#pragma unroll
  for (int tl = 0; tl < 8; ++tl)
#pragma unroll
    for (int c = 0; c < 4; ++c) { UPD(bf2f((u16)Bop[tl][c]), 31, 2.f); UPD(bf2f((u16)Cop[tl][c]), 32, 2.f); }
  float* aval = (float*)lds + 1024 + 32 * 512;
  if (wv == 0 && jj == 0) {
#pragma unroll
    for (int tl = 0; tl < 8; ++tl)
#pragma unroll
      for (int e = 0; e < 2; ++e) { const int stt = tl * 8 + gq * 2 + e; aval[stt * 2] = ar[tl * 2 + e]; aval[stt * 2 + 1] = ai[tl * 2 + e]; }
  }
  const int chunk = wv * 16 + jj;
  const long pcol = C_S5U + g * 16 + gq * 4;
  f32x4 x[8];
#pragma unroll
  for (int tl = 0; tl < 8; ++tl) x[tl] = f32x4{0.f, 0.f, 0.f, 0.f};
  auto tok_of = [&](int stp) { const int sidx = chunk * 32 + stp; const int t = d ? (S - 1 - sidx) : sidx; return (long)(b * S + t); };
  auto step_state = [&](s16x4 uf) {
#pragma unroll
    for (int tl = 0; tl < 8; ++tl) {
      const float xr0 = x[tl][0], xr1 = x[tl][1], xi0 = x[tl][2], xi1 = x[tl][3];
      f32x4 nx;
      nx[0] = ar[tl * 2] * xr0 - ai[tl * 2] * xi0; nx[2] = ar[tl * 2] * xi0 + ai[tl * 2] * xr0;
      nx[1] = ar[tl * 2 + 1] * xr1 - ai[tl * 2 + 1] * xi1; nx[3] = ar[tl * 2 + 1] * xi1 + ai[tl * 2 + 1] * xr1;
      x[tl] = __builtin_amdgcn_mfma_f32_16x16x32_bf16(pad8(Bop[tl]), pad8(uf), nx, 0, 0, 0);
    }
  };
#pragma unroll 1
  for (int g8 = 0; g8 < 4; ++g8) {
    s16x4 uf[8];
#pragma unroll
    for (int i = 0; i < 8; ++i) uf[i] = *reinterpret_cast<const s16x4*>(PB + tok_of(g8 * 8 + i) * NP + pcol);
#pragma unroll
    for (int i = 0; i < 8; ++i) { step_state(uf[i]);
#pragma unroll
      for (int c = 0; c < 4; ++c) UPD(bf2f((u16)uf[i][c]), 33, 20.f); }
  }
#pragma unroll
  for (int tl = 0; tl < 8; ++tl)
#pragma unroll
    for (int r = 0; r < 4; ++r) UPD(x[tl][r], 34, 50.f);
  __syncthreads();
  float* tot = (float*)lds;
  float* xs = (float*)lds + 1024;
#pragma unroll
  for (int tl = 0; tl < 8; ++tl)
#pragma unroll
    for (int r = 0; r < 4; ++r) xs[(tl * 4 + r) * 512 + tid] = x[tl][r];
#pragma unroll 1
  for (int tl = 0; tl < 8; ++tl) {
#pragma unroll
    for (int e = 0; e < 2; ++e) {
      const int stt = tl * 8 + gq * 2 + e;
      float pr_ = aval[stt * 2], pi_ = aval[stt * 2 + 1];
#pragma unroll
      for (int sq = 0; sq < 5; ++sq) { float nr, ni; cmul(pr_, pi_, pr_, pi_, nr, ni); pr_ = nr; pi_ = ni; }
      float xr = xs[(tl * 4 + e) * 512 + tid], xi = xs[(tl * 4 + 2 + e) * 512 + tid];
#pragma unroll
      for (int stg = 0; stg < 4; ++stg) {
        const int off = 1 << stg;
        const float or_ = __shfl_up(xr, off, 16), oi_ = __shfl_up(xi, off, 16);
        if (jj >= off) { float cr, ci; cmul(pr_, pi_, or_, oi_, cr, ci); xr += cr; xi += ci; }
        float nr, ni; cmul(pr_, pi_, pr_, pi_, nr, ni); pr_ = nr; pi_ = ni;
      }
      xs[(tl * 4 + e) * 512 + tid] = xr; xs[(tl * 4 + 2 + e) * 512 + tid] = xi;
      if (jj == 15) { float* tp = tot + (wv * 4 + gq) * 32 + tl * 4; tp[e] = xr; tp[2 + e] = xi; }
      UPD(xr, 35, 200.f); UPD(xi, 35, 200.f);
    }
  }
  __syncthreads();
#pragma unroll 1
  for (int tl = 0; tl < 8; ++tl) {
#pragma unroll
    for (int e = 0; e < 2; ++e) {
      const int stt = tl * 8 + gq * 2 + e;
      float pr_ = aval[stt * 2], pi_ = aval[stt * 2 + 1];
#pragma unroll
      for (int sq = 0; sq < 5; ++sq) { float nr, ni; cmul(pr_, pi_, pr_, pi_, nr, ni); pr_ = nr; pi_ = ni; }
      float qr_ = 1.f, qi_ = 0.f;
#pragma unroll
      for (int stg = 0; stg < 4; ++stg) {
        if (jj & (1 << stg)) { float cr, ci; cmul(qr_, qi_, pr_, pi_, cr, ci); qr_ = cr; qi_ = ci; }
        float nr, ni; cmul(pr_, pi_, pr_, pi_, nr, ni); pr_ = nr; pi_ = ni;
      }
      float Wr = 0.f, Wi = 0.f;
      for (int w2 = 0; w2 < wv; ++w2) {
        const float* tp = tot + (w2 * 4 + gq) * 32 + tl * 4;
        float cr, ci; cmul(pr_, pi_, Wr, Wi, cr, ci); Wr = cr + tp[e]; Wi = ci + tp[2 + e];
      }
      const float xr = xs[(tl * 4 + e) * 512 + tid], xi = xs[(tl * 4 + 2 + e) * 512 + tid];
      float er = __shfl_up(xr, 1, 16), ei = __shfl_up(xi, 1, 16);
      if (jj == 0) { er = 0.f; ei = 0.f; }
      float cr, ci; cmul(qr_, qi_, Wr, Wi, cr, ci);
      UPD(Wr, 36, 500.f); UPD(Wi, 36, 500.f); UPD(er + cr, 37, 500.f); UPD(ei + ci, 37, 500.f);
      xs[(tl * 4 + e) * 512 + tid] = er + cr; xs[(tl * 4 + 2 + e) * 512 + tid] = ei + ci;
    }
  }
#pragma unroll
  for (int tl = 0; tl < 8; ++tl)
#pragma unroll
    for (int r = 0; r < 4; ++r) x[tl][r] = xs[(tl * 4 + r) * 512 + tid];
  __syncthreads();
#pragma unroll 1
  for (int g8 = 0; g8 < 4; ++g8) {
    s16x4 uf[8];
#pragma unroll
    for (int i = 0; i < 8; ++i) uf[i] = *reinterpret_cast<const s16x4*>(PB + tok_of(g8 * 8 + i) * NP + pcol);
#pragma unroll
    for (int i = 0; i < 8; ++i) {
      step_state(uf[i]);
      f32x4 y = f32x4{0.f, 0.f, 0.f, 0.f};
#pragma unroll
      for (int tl = 0; tl < 8; ++tl) {
        const unsigned lo = cvtpk(x[tl][0], x[tl][1]), hi2 = cvtpk(x[tl][2], x[tl][3]);
        const s16x4 xb = s16x4{(short)(lo & 0xffffu), (short)(lo >> 16), (short)(hi2 & 0xffffu), (short)(hi2 >> 16)};
        y = __builtin_amdgcn_mfma_f32_16x16x32_bf16(pad8(Cop[tl]), pad8(xb), y, 0, 0, 0);
      }
#pragma unroll
      for (int tl = 0; tl < 8; ++tl) { UPD(x[tl][0], 38, 500.f); UPD(x[tl][1], 38, 500.f); UPD(x[tl][2], 38, 500.f); UPD(x[tl][3], 38, 500.f); }
      UPD(y[0], 39, 100.f); UPD(y[1], 39, 100.f); UPD(y[2], 39, 100.f); UPD(y[3], 39, 100.f);
      uint2 oo; oo.x = cvtpk(y[0], y[1]); oo.y = cvtpk(y[2], y[3]);
      *reinterpret_cast<uint2*>(YS + tok_of(g8 * 8 + i) * 512 + g * 16 + gq * 4) = oo;
    }
  }
  if (l == 0 && bad_ < 9999) atomicMin((int*)(ws + O_FLAG), bad_);
  __syncthreads();
}

__device__ __forceinline__ void phase5(const P& p, int l, int coff, int tmask = 15) {
  const int TIDX = opaque_tid();
  const int BIDX = opaque_bid();
  char* ws = p.ws;
  __shared__ int s_item;
  int* ctr = (int*)(ws + O_CTR) + l + coff;
  constexpr int N_RW = 64, N_S5 = 256, N_MLA = 256, N_DIFF = 512, N_ALL = N_RW + N_S5 + N_MLA + N_DIFF;
  for (;;) {
    __syncthreads();
    if (TIDX == 0) s_item = atomicAdd(ctr, 1);
    __syncthreads();
    int it = s_item;
    if (it >= N_ALL) break;
    if (it < N_RW) { if (tmask & 1) rwkv_item(p, l, it, smem); continue; }
    it -= N_RW;
    if (it < N_MLA) {
      const int qb = it & 15, hh = (it >> 4) & 3, b = it >> 6;
      const long bh = (long)(b * 4 + hh);
      if (tmask & 4) attn_body_simple<192, 192, 192, 128, 512, u16>((const u16*)(ws + QK_MQ) + (bh * S + qb * 256) * 192, (const u16*)(ws + QK_MK) + bh * S * 192,
                                                 (const u16*)(ws + QK_MV) + bh * S * 128, (u16*)(ws + OO_MO) + ((long)(b * S + qb * 256)) * 512 + hh * 128, S, smem);
      continue;
    }
    it -= N_MLA;
    if (it < N_DIFF) {
      const int qb = it & 15, h2 = (it >> 4) & 7, b = it >> 7;
      const long bh = (long)(b * 8 + h2);
      if (tmask & 8) attn_body<64, 2, 64, 64, NP, 1024, u16>((const u16*)(ws + QK_DQ) + (bh * S + qb * 256) * 64, (const u16*)(ws + QK_DK) + bh * S * 64,
                                                (const u16*)(ws + O_P) + (long)b * S * NP + C_DV + (h2 >> 1) * 128,
                                                (u16*)(ws + OO_DO) + ((long)(b * S + qb * 256)) * 1024 + h2 * 128, S, smem);
      continue;
    }
    it -= N_DIFF;
    if (tmask & 2) s5_item(p, l, it, smem);
  }
}

__device__ __forceinline__ void phase6(const P& p, int l) {
  const int TIDX = opaque_tid();
  const int BIDX = opaque_bid();
  char* ws = p.ws;
  const u16* __restrict__ PB = (const u16*)(ws + O_P);
  const u16* __restrict__ YS0 = (const u16*)(ws + OO_YS); const u16* __restrict__ YS1 = YS0 + (long)T * 512;
  const u16* __restrict__ YR0 = (const u16*)(ws + OO_YR); const u16* __restrict__ YR1 = YR0 + (long)T * 512;
  const u16* __restrict__ DO_ = (const u16*)(ws + OO_DO); const u16* __restrict__ MO = (const u16*)(ws + OO_MO);
  const u16* __restrict__ RV = (const u16*)(ws + RW_V); const float* __restrict__ BON = (const float*)(ws + RW_BON);
  u16* __restrict__ BR = (u16*)(ws + O_BR); u16* __restrict__ GS5 = (u16*)(ws + O_GS5);
  const int wid = TIDX >> 6, lane = TIDX & 63, c0 = lane * 8;
  const float lam_init = 0.8f - 0.6f * expf(-0.3f * (float)l);
  const float* dl = p.in[I_DLAM] + l * 256;
  const float lam_full = expf(wsum(dl[lane] * dl[64 + lane])) - expf(wsum(dl[128 + lane] * dl[192 + lane])) + lam_init;
  const F8 dsk = ld8f(p.in[I_S5D] + l * 512 + c0);
  const F8 sub = ld8f(p.in[I_SUBLN] + l * 128 + (lane & 15) * 8);
  const F8 lng = ld8f(p.in[I_LNG] + l * 512 + c0), lnb = ld8f(p.in[I_LNB] + l * 512 + c0);
  const int hD = lane >> 4, eD = (lane & 15) * 8;
  for (int t = BIDX * 8 + wid; t < T; t += gridDim.x * 8) {
    const u16* pr = PB + (long)t * NP;
    u16* br = BR + (long)t * 2048;
    const F8 u = ld8bf(pr + C_S5U + c0), ys0 = ld8bf(YS0 + (long)t * 512 + c0), ys1 = ld8bf(YS1 + (long)t * 512 + c0);
    const F8 o1 = ld8bf(DO_ + (long)t * 1024 + (hD * 2) * 128 + eD), o2 = ld8bf(DO_ + (long)t * 1024 + (hD * 2 + 1) * 128 + eD);
    const F8 zd = ld8bf(pr + C_DZ + c0), zm = ld8bf(pr + C_MZ + c0), zr = ld8bf(pr + C_RZ + c0);
    const F8 mo = ld8bf(MO + (long)t * 512 + c0);
    const F8 y0 = ld8bf(YR0 + (long)t * 512 + c0), y1 = ld8bf(YR1 + (long)t * 512 + c0), rv = ld8bf(RV + (long)t * 512 + c0);
    const float bon = BON[(long)t * 8 + (lane >> 3)];
    {
      F8 g;
#pragma unroll
      for (int j = 0; j < 8; ++j) {
        const float y = dsk.v[j] * u.v[j] + ys0.v[j] + ys1.v[j];
        const float uu = 0.7978845608028654f * (y + 0.044715f * y * y * y);
        const float e2 = __expf(2.f * uu); const float th = 1.f - 2.f * __builtin_amdgcn_rcpf(e2 + 1.f);
        g.v[j] = 0.5f * y * (1.f + th);
      }
      st8bf(GS5 + (long)t * 512 + c0, g);
    }
    {
      F8 a; float ss = 0.f;
#pragma unroll
      for (int j = 0; j < 8; ++j) { a.v[j] = o1.v[j] - lam_full * o2.v[j]; ss += a.v[j] * a.v[j]; }
      ss = grp16sum(ss);
      const float sc = rsqrtf(ss * (1.f / 128.f) + 1e-6f) * (1.f - lam_init);
#pragma unroll
      for (int j = 0; j < 8; ++j) a.v[j] = siluf_(zd.v[j]) * a.v[j] * sc * sub.v[j];
      st8bf(br + 512 + c0, a);
    }
    {
      F8 a;
#pragma unroll
      for (int j = 0; j < 8; ++j) a.v[j] = siluf_(zm.v[j]) * mo.v[j];
      st8bf(br + 1024 + c0, a);
    }
    {
      F8 y; float sm = 0.f;
#pragma unroll
      for (int j = 0; j < 8; ++j) { y.v[j] = y0.v[j] + y1.v[j]; sm += y.v[j]; }
      const float mean = grp8sum(sm) * (1.f / 64.f);
      float sv = 0.f;
#pragma unroll
      for (int j = 0; j < 8; ++j) { y.v[j] -= mean; sv += y.v[j] * y.v[j]; }
      const float rs = rsqrtf(grp8sum(sv) * (1.f / 64.f) + 64e-5f);
#pragma unroll
      for (int j = 0; j < 8; ++j) { const float yn = y.v[j] * rs * lng.v[j] + lnb.v[j] + bon * rv.v[j]; y.v[j] = siluf_(zr.v[j]) * yn; }
      st8bf(br + 1536 + c0, y);
    }
  }
}

struct EpiGlu { u16* BR; const u16* GS5; const u16* PB; const float* gb; __device__ __forceinline__ void operator()(int row, int col, f32x4 v0, f32x4 v1) const {
  const f32x4 b0 = *reinterpret_cast<const f32x4*>(gb + col), b1 = *reinterpret_cast<const f32x4*>(gb + col + 4);
  const F8 g = ld8bf(GS5 + (long)row * 512 + col), z = ld8bf(PB + (long)row * NP + C_S5Z + col);
  F8 o;
#pragma unroll
  for (int j = 0; j < 4; ++j) { o.v[j] = siluf_(z.v[j]) * g.v[j] * sigmoidf_(v0[j] + b0[j]); o.v[4 + j] = siluf_(z.v[4 + j]) * g.v[4 + j] * sigmoidf_(v1[j] + b1[j]); }
  st8bf(BR + (long)row * 2048 + col, o); } };
__device__ __forceinline__ void phase7(const P& p, int l) {
  char* ws = p.ws;
  EpiGlu e{(u16*)(ws + O_BR), (const u16*)(ws + O_GS5), (const u16*)(ws + O_P), p.in[I_GLUB] + l * 512};
  fg::gemm_phase<EpiGlu, true>((LAS3 unsigned char*)smem, (const u16*)(ws + O_GS5), 512, (const u16*)(ws + O_GLU), 512, T, 512, 512, e);
}

constexpr size_t O_GATES = O_O;
__device__ __forceinline__ void phase8a(const P& p, int l) {
  char* ws = p.ws;
  EpiGate e{(u16*)(ws + O_GATES), p.in[I_GATEB] + (long)l * 4 * 1024};
  fg::gemm_phase<EpiGate, true>((LAS3 unsigned char*)smem, (const u16*)(ws + O_H), 1024, (const u16*)(ws + O_WIN) + (long)NP * 1024, 1024, T, 4096, 1024, e);
}
__device__ __forceinline__ void phase8(const P& p, int l) {
  const int TIDX = opaque_tid();
  const int BIDX = opaque_bid();
  char* ws = p.ws;
  const u16* BR = (const u16*)(ws + O_BR); u16* M = (u16*)(ws + O_M);
  const u16* WBR = (const u16*)(ws + O_WBR); const u16* GT = (const u16*)(ws + O_GATES);
  for (int ti = BIDX; ti < 8 * 64; ti += gridDim.x) {
    const int nt = ti & 7, mt = ti >> 3; const int m0 = mt * 256, n0 = nt * 128;
    f32x4 tot[4][4]; zero_acc<4>(tot);
#pragma unroll 1
    for (int nb = 0; nb < 4; ++nb) {
      f32x4 ap[4][4]; zero_acc<4>(ap);
      gemm_main<4>(BR + (long)m0 * 2048 + nb * 512, 2048, WBR + ((long)nb * 1024 + n0) * 512, 512, 512, ap, smem);
      EPI_LOOP(4, { tot[i][j][jj] += bf2f(GT[(long)m * 4096 + nb * 1024 + n]) * ap[i][j][jj]; });
    }
    EPI_LOOP(4, { M[(long)m * 1024 + n] = f2bf(tot[i][j][jj]); });
  }
}

__device__ __forceinline__ void phase9(const P& p, int l) {
  char* ws = p.ws;
  EpiOut e{p.out, (l == 0) ? p.in[I_X] : p.out};
  fg::gemm_phase((LAS3 unsigned char*)smem, (const u16*)(ws + O_M), 1024, (const u16*)(ws + O_WOUT), 1024, T, 1024, 1024, e);
}

#define XB_TMO      128
#define XB_XCNT(j)  (256  + 64 * (j))
#define XB_XSUB(j)  (1280 + 64 * (j))
#define XB_XGEN(j)  (2304 + 64 * (j))
#define XB_TOP      3328
#define XB_TOPGEN   3392
#define XB_SPIN_CAP (1u << 18)
__device__ __forceinline__ unsigned xb_ld(unsigned* p) { return __hip_atomic_load(p, __ATOMIC_RELAXED, __HIP_MEMORY_SCOPE_AGENT); }
__device__ __forceinline__ unsigned xb_add(unsigned* p, unsigned v) { return __hip_atomic_fetch_add(p, v, __ATOMIC_RELAXED, __HIP_MEMORY_SCOPE_AGENT); }
__device__ __forceinline__ unsigned xb_xcc_id() { return (unsigned)__builtin_amdgcn_s_getreg((3 << 11) | 20) & 0xFu; }
#define XB_SPIN(cond, bar) do { unsigned _sp = 0; while (cond) { __builtin_amdgcn_s_sleep(1); \
    if ((++_sp & 255u) == 0u) { if (xb_ld(&(bar)[XB_TMO])) break; if (_sp > XB_SPIN_CAP) { atomicAdd(&(bar)[XB_TMO], 1u); break; } } } } while (0)
struct XcdBarrier { unsigned* bar; unsigned x; volatile LAS3 unsigned* st; };
__device__ __forceinline__ XcdBarrier xcd_barrier_post(unsigned* bar, volatile LAS3 unsigned* st) {
  XcdBarrier b; b.bar = bar; b.x = xb_xcc_id(); b.st = st;
  if (threadIdx.x == 0) (void)xb_add(&bar[XB_XCNT(b.x)], 1u);
  return b;
}
__device__ __forceinline__ void xcd_barrier_complete(unsigned* bar, unsigned x, unsigned& nloc, unsigned& nx) {
  const unsigned G = gridDim.x * gridDim.y * gridDim.z;
  unsigned sum, cnt, mine, sp = 0u;
  for (;;) {
    sum = 0u; cnt = 0u; mine = 0u;
#pragma unroll
    for (unsigned j = 0; j < 16; ++j) { const unsigned c = xb_ld(&bar[XB_XCNT(j)]); sum += c; cnt += (c > 0u) ? 1u : 0u; mine = (j == x) ? c : mine; }
    if (sum == G) break;
    __builtin_amdgcn_s_sleep(1);
    if ((++sp & 255u) == 0u) { if (xb_ld(&bar[XB_TMO])) break; if (sp > XB_SPIN_CAP) { atomicAdd(&bar[XB_TMO], 1u); break; } }
  }
  nloc = mine > 0u ? mine : 1u; nx = cnt > 0u ? cnt : 1u;
}
__device__ __forceinline__ void xcd_barrier(const XcdBarrier& b) {
  asm volatile("s_waitcnt vmcnt(0)" ::: "memory");
  __syncthreads();
  if (threadIdx.x == 0) {
    unsigned* bar = b.bar;
    __builtin_amdgcn_s_waitcnt(0);
    unsigned nloc = b.st[0], nx = b.st[1];
    if (nloc == 0u) { xcd_barrier_complete(bar, b.x, nloc, nx); b.st[0] = nloc; b.st[1] = nx; }
    const unsigned old = xb_add(&bar[XB_XSUB(b.x)], 1u);
    const unsigned gen = old / nloc;
    if (old + 1u == (gen + 1u) * nloc) {
      __builtin_amdgcn_fence(__ATOMIC_RELEASE, "agent");
      asm volatile("s_waitcnt vmcnt(0)" ::: "memory");
      const unsigned og = xb_add(&bar[XB_TOP], 1u);
      const unsigned tg = og / nx;
      if (og + 1u == (tg + 1u) * nx) xb_add(&bar[XB_TOPGEN], 1u);
      else XB_SPIN(xb_ld(&bar[XB_TOPGEN]) == tg, bar);
      __builtin_amdgcn_fence(__ATOMIC_ACQUIRE, "agent");
      xb_add(&bar[XB_XGEN(b.x)], 1u);
      asm volatile("s_waitcnt vmcnt(0)" ::: "memory");
    } else {
      XB_SPIN(xb_ld(&bar[XB_XGEN(b.x)]) == gen, bar);
      __builtin_amdgcn_fence(__ATOMIC_ACQUIRE, "agent");
      asm volatile("s_waitcnt vmcnt(0)" ::: "memory");
    }
  }
  __syncthreads();
}

__device__ __forceinline__ void gsync_cg(cg::grid_group& grid) {
  asm volatile("s_waitcnt vmcnt(0) lgkmcnt(0)" ::: "memory");
  grid.sync();
  __builtin_amdgcn_fence(__ATOMIC_ACQUIRE, "agent");
  asm volatile("s_waitcnt vmcnt(0)" ::: "memory");
}
#define gsync(g_) xcd_barrier(xbar)
#ifdef DBG
template <typename TT> __device__ __forceinline__ bool badv(TT v);
template <> __device__ __forceinline__ bool badv<u16>(u16 v) { float f = bf2f(v); return !(fabsf(f) < 1e5f); }
template <> __device__ __forceinline__ bool badv<float>(float f) { return !(fabsf(f) < 1e5f); }
template <typename TT>
__device__ __forceinline__ void chk(const P& p, size_t off, size_t n, int code) {
  const TT* q = (const TT*)(p.ws + off);
  bool bad = false;
  const int TIDX = opaque_tid(); const int BIDX = opaque_bid();
  for (size_t i = (size_t)BIDX * 512 + TIDX; i < n; i += (size_t)gridDim.x * 512) bad |= badv<TT>(q[i]);
  if (bad) atomicMin((int*)(p.ws + O_FLAG), code);
}
__device__ __forceinline__ void chko(const P& p, int code) {
  bool bad = false;
  const int TIDX = opaque_tid(); const int BIDX = opaque_bid();
  for (size_t i = (size_t)BIDX * 512 + TIDX; i < (size_t)T * 1024; i += (size_t)gridDim.x * 512) bad |= badv<float>(p.out[i]);
  if (bad) atomicMin((int*)(p.ws + O_FLAG), code);
}
#define CHK(...) do { if (l == 0) { __VA_ARGS__ } } while (0)
#else
#define CHK(...) do {} while (0)
#endif
__global__ void __launch_bounds__(512) mega(P p) {
  cg::grid_group grid = cg::this_grid();
  __shared__ uint4 xb_words;
  if (threadIdx.x == 0) xb_words = make_uint4(0u, 0u, 0u, 0u);
  __syncthreads();
  XcdBarrier xbar = xcd_barrier_post((unsigned*)(p.ws + O_BAR), (volatile LAS3 unsigned*)&xb_words);
  gsync_cg(grid);
#ifdef DBG
  if (blockIdx.x == 0 && threadIdx.x == 0) *(int*)(p.ws + O_FLAG) = 9999;
#endif
  for (int l = 0; l < NL; ++l) {
#ifndef ONLY
#define ONLY -1
#endif
#ifndef REPMASK
#define REPMASK 0
#endif
#define RUNP(k, call) do { call; gsync(grid); if (REPMASK & (1 << (k))) { call; gsync(grid); } } while (0)
    RUNP(0, phase0(p, l));
    CHK(chk<u16>(p, O_H, (size_t)T * 1024, 10); chk<u16>(p, O_WIN, (size_t)NIN * 1024, 11););
    RUNP(1, phase1(p));
    RUNP(2, phase2(p, l));
    RUNP(3, phase3(p));
    RUNP(4, phase4(p, l));
    phase5(p, l, 0); gsync(grid);
#ifndef REP5MASK
#define REP5MASK 15
#endif
    if (REPMASK & (1 << 5)) { phase5(p, l, 4, REP5MASK); gsync(grid); }
    RUNP(6, phase6(p, l));
    RUNP(7, phase7(p, l); phase8a(p, l));
    RUNP(9, phase8(p, l));
    phase9(p, l); gsync(grid);
    if (REPMASK & (1 << 10)) { gsync(grid); gsync(grid); gsync(grid); gsync(grid); gsync(grid); }
#ifdef DBG
    if (l > 0) chko(p, 90 + l);
#endif
  }
#ifdef DBG
  gsync(grid);
  {
    const int flag = *(volatile int*)(p.ws + O_FLAG);
    if (flag < 9999) {
      const int TIDX = opaque_tid(); const int BIDX = opaque_bid();
      for (size_t i = (size_t)BIDX * 512 + TIDX; i < (size_t)T * 1024; i += (size_t)gridDim.x * 512)
        p.out[i] = (i == 0) ? (float)(flag * 10) : p.in[I_X][i];
    }
  }
#endif
}

extern "C" void kernel_launch(void* const* d_in, const int* in_sizes, int n_in,
                              void* d_out, int out_size, void* d_ws, size_t ws_size,
                              hipStream_t stream) {
  constexpr size_t kDynLds = 128 * 1024;
  static int grid_blocks = 0;
  if (!grid_blocks) {
    int dev = 0, cus = 0, per_cu = 0;
    (void)hipGetDevice(&dev);
    (void)hipDeviceGetAttribute(&cus, hipDeviceAttributeMultiprocessorCount, dev);
    (void)hipFuncSetAttribute((const void*)mega, hipFuncAttributeMaxDynamicSharedMemorySize, (int)kDynLds);
    (void)hipOccupancyMaxActiveBlocksPerMultiprocessor(&per_cu, mega, 512, kDynLds);
    if (per_cu < 1) per_cu = 1;
    if (per_cu > 1) per_cu = 1;
    grid_blocks = cus * per_cu;
  }
  if (n_in < 36 || ws_size < O_BAR + BAR_BYTES) { fprintf(stderr, "bad args: n_in %d ws %zu need %zu\n", n_in, ws_size, (size_t)O_END); return; }
  P p{};
  for (int i = 0; i < 36; ++i) p.in[i] = (const float*)d_in[i];
  p.out = (float*)d_out; p.ws = (char*)d_ws;
  (void)hipMemsetAsync((char*)d_ws + O_BAR, 0, BAR_BYTES, stream);
  void* args[] = {&p};
  hipError_t e = hipLaunchCooperativeKernel((void*)mega, dim3(grid_blocks), dim3(512), args, kDynLds, stream);
  if (e != hipSuccess) fprintf(stderr, "coop launch failed: %s\n", hipGetErrorString(e));
}
```

```cpp
#define REPMASK 0

#include <hip/hip_runtime.h>
#include <hip/hip_bf16.h>
#include <hip/hip_cooperative_groups.h>
#include <cstdio>
#include <cstdint>
namespace cg = cooperative_groups;

typedef unsigned short u16;
using bf16x8 = __attribute__((ext_vector_type(8))) short;
using s16x4  = __attribute__((ext_vector_type(4))) short;
using f32x4  = __attribute__((ext_vector_type(4))) float;
using f32x16 = __attribute__((ext_vector_type(16))) float;
using u32x4  = __attribute__((ext_vector_type(4))) unsigned;
using f2     = __attribute__((ext_vector_type(2))) float;

constexpr int T = 16384, S = 4096, NB = 4, DM = 1024, NL = 4;
constexpr int NP = 6336;
constexpr int NIN = 10432;
constexpr int C_S5U = 0, C_S5Z = 512, C_DQ = 1024, C_DK = 1536, C_DV = 2048, C_DZ = 2560, C_MCQ = 3072, C_MCKV = 3328,
              C_MKR = 3456, C_MZ = 3520, C_RC = 4032, C_RZ = 5824;
constexpr size_t SZT512 = (size_t)T * 512 * 2;
constexpr size_t O_WIN = 0;
constexpr size_t O_WBR = O_WIN + (size_t)NIN * 1024 * 2;
constexpr size_t O_WOUT = O_WBR + 4194304;
constexpr size_t O_GLU = O_WOUT + 2097152;
constexpr size_t O_UQ = O_GLU + 524288;
constexpr size_t O_UKV = O_UQ + 393216;
constexpr size_t O_WUP = O_UKV + 262144;
constexpr size_t O_AUP = O_WUP + 131072;
constexpr size_t O_CTR = O_AUP + 131072;
constexpr size_t O_H = O_CTR + 4096;
constexpr size_t O_P = O_H + (size_t)T * 1024 * 2;
constexpr size_t O_RW = O_P + (size_t)T * NP * 2;
constexpr size_t RW_R = O_RW, RW_K = O_RW + SZT512, RW_V = O_RW + 2 * SZT512, RW_KK = O_RW + 3 * SZT512,
                 RW_A = O_RW + 4 * SZT512, RW_E = O_RW + 6 * SZT512, RW_BON = O_RW + 8 * SZT512;
constexpr size_t O_M = O_RW;
constexpr size_t O_QK = RW_BON + (size_t)T * 8 * 4;
constexpr size_t QK_DQ = O_QK, QK_DK = O_QK + SZT512, QK_MQ = O_QK + 2 * SZT512, QK_MK = QK_MQ + (size_t)T * 768 * 2,
                 QK_MV = QK_MK + (size_t)T * 768 * 2;
constexpr size_t O_BR = O_QK, O_GS5 = O_QK + 4 * SZT512;
constexpr size_t O_O = QK_MV + SZT512;
constexpr size_t OO_DO = O_O, OO_MO = O_O + 4 * SZT512, OO_YS = OO_MO + SZT512, OO_YR = OO_YS + 2 * SZT512;
constexpr size_t O_END = OO_YR + 2 * SZT512;
constexpr size_t OA_LINW = O_O, OA_LINA = O_O + 4194304, OA_CQN = O_O + 8388608, OA_CKVN = O_O + 16777216,
                 OA_QRAW = O_O + 20971520, OA_KVRAW = OA_QRAW + 25165824, OA_WL = OA_KVRAW + 33554432, OA_AL = OA_WL + 33554432;
static_assert(OA_AL + 33554432 <= O_END, "alias overflow");
static_assert(O_END <= 683000000ull, "ws overflow");
constexpr size_t O_FLAG = O_CTR + 64;
constexpr size_t O_BAR = O_END;
constexpr size_t BAR_BYTES = 3456 * 4;
static_assert(O_BAR + BAR_BYTES <= 683000000ull, "ws overflow");

struct P {
  const float* in[36];
  float* out;
  char* ws;
};
enum { I_X = 0, I_NORMG, I_WIN, I_GATEB, I_LRE, I_LIM, I_LDT, I_BRE, I_BIM, I_CRE, I_CIM, I_S5D, I_GLUW, I_GLUB, I_DQN, I_DKN,
       I_DLAM, I_SUBLN, I_QLN, I_KVLN, I_WUQ, I_WUKV, I_MQN, I_MKN, I_MU, I_W0, I_WUP, I_A0, I_AUP, I_KK, I_KA, I_RK, I_LNG,
       I_LNB, I_WBR, I_WOUT };

extern __shared__ __attribute__((aligned(16))) char smem[];

__device__ __forceinline__ float bf2f(u16 v) { return __uint_as_float(((unsigned)v) << 16); }
__device__ __forceinline__ u16 f2bf(float f) { unsigned u = __float_as_uint(f); u += 0x7fffu + ((u >> 16) & 1u); return (u16)(u >> 16); }
__device__ __forceinline__ unsigned cvtpk_asm(float lo, float hi) {
  unsigned r; asm volatile("v_cvt_pk_bf16_f32 %0, %1, %2" : "=v"(r) : "v"(lo), "v"(hi)); return r;
}
typedef __bf16 bf16v2_t __attribute__((ext_vector_type(2)));
__device__ __forceinline__ unsigned cvtpk(float lo, float hi) {
  f2 v = {lo, hi};
  bf16v2_t r = __builtin_convertvector(v, bf16v2_t);
  return __builtin_bit_cast(unsigned, r);
}
__device__ __forceinline__ float dpp_add_(float x, const int ctrl_unused) { return x; }
#define WS_DPP(x, ctrl) ((x) + __int_as_float(__builtin_amdgcn_update_dpp(0, __float_as_int(x), (ctrl), 0xf, 0xf, true)))
__device__ __forceinline__ float wsum(float v) {
  v = WS_DPP(v, 0xB1);
  v = WS_DPP(v, 0x4E);
  v = WS_DPP(v, 0x141);
  v = WS_DPP(v, 0x140);
  v += __shfl_xor(v, 16);
  v += __shfl_xor(v, 32);
  return v;
}
__device__ __forceinline__ float sigmoidf_(float x) { return __builtin_amdgcn_rcpf(1.f + __expf(-x)); }
__device__ __forceinline__ float siluf_(float x) { return x * __builtin_amdgcn_rcpf(1.f + __expf(-x)); }
__device__ __forceinline__ void sincos_rev(float ang, float& sn, float& cs) {
  float rev = ang * 0.15915494309189535f; rev -= rintf(rev);
  sn = __builtin_amdgcn_sinf(rev); cs = __builtin_amdgcn_cosf(rev);
}

__device__ __forceinline__ int opaque_tid() { int t = threadIdx.x; asm volatile("" : "+v"(t)); return t; }
__device__ __forceinline__ int opaque_bid() { int t = blockIdx.x; asm volatile("" : "+s"(t)); return t; }

struct F8 { float v[8]; };
__device__ __forceinline__ F8 ld8bf(const u16* p) {
  const u32x4 w = *reinterpret_cast<const u32x4*>(p); F8 r;
#pragma unroll
  for (int i = 0; i < 4; ++i) { r.v[2 * i] = __uint_as_float(w[i] << 16); r.v[2 * i + 1] = __uint_as_float(w[i] & 0xffff0000u); }
  return r;
}
__device__ __forceinline__ void st8bf(u16* p, const F8& f) {
  u32x4 w; w[0] = cvtpk(f.v[0], f.v[1]); w[1] = cvtpk(f.v[2], f.v[3]); w[2] = cvtpk(f.v[4], f.v[5]); w[3] = cvtpk(f.v[6], f.v[7]);
  *reinterpret_cast<u32x4*>(p) = w;
}
__device__ __forceinline__ F8 ld8f(const float* p) {
  const f32x4 a = *reinterpret_cast<const f32x4*>(p), b = *reinterpret_cast<const f32x4*>(p + 4); F8 r;
  r.v[0] = a[0]; r.v[1] = a[1]; r.v[2] = a[2]; r.v[3] = a[3]; r.v[4] = b[0]; r.v[5] = b[1]; r.v[6] = b[2]; r.v[7] = b[3]; return r;
}
struct F4 { float v[4]; };
__device__ __forceinline__ F4 ld4bf(const u16* p) {
  const uint2 w = *reinterpret_cast<const uint2*>(p); F4 r;
  r.v[0] = __uint_as_float(w.x << 16); r.v[1] = __uint_as_float(w.x & 0xffff0000u); r.v[2] = __uint_as_float(w.y << 16); r.v[3] = __uint_as_float(w.y & 0xffff0000u); return r;
}
__device__ __forceinline__ void st4bf(u16* p, const F4& f) { uint2 w; w.x = cvtpk(f.v[0], f.v[1]); w.y = cvtpk(f.v[2], f.v[3]); *reinterpret_cast<uint2*>(p) = w; }
__device__ __forceinline__ F4 ld4f(const float* p) { const f32x4 a = *reinterpret_cast<const f32x4*>(p); F4 r; r.v[0] = a[0]; r.v[1] = a[1]; r.v[2] = a[2]; r.v[3] = a[3]; return r; }
__device__ __forceinline__ F4 zero4() { F4 r; r.v[0] = r.v[1] = r.v[2] = r.v[3] = 0.f; return r; }
__device__ __forceinline__ F8 zero8() { F8 r;
#pragma unroll
  for (int i = 0; i < 8; ++i) r.v[i] = 0.f; return r; }
__device__ __forceinline__ float grp8sum(float v) { v = WS_DPP(v, 0xB1); v = WS_DPP(v, 0x4E); v = WS_DPP(v, 0x141); return v; }
__device__ __forceinline__ float grp16sum(float v) { v = grp8sum(v); v = WS_DPP(v, 0x140); return v; }
__device__ __forceinline__ float swz_xor4(float v) { return __int_as_float(__builtin_amdgcn_ds_swizzle(__float_as_int(v), 0x101F)); }
__device__ __forceinline__ float dpp_xor1(float v) { return __int_as_float(__builtin_amdgcn_update_dpp(0, __float_as_int(v), 0xB1, 0xf, 0xf, true)); }
__device__ __forceinline__ void tr_tile(const float* __restrict__ src, int ldsrc, u16* __restrict__ dst, int lddst, int k0, int n0, float* lds) {
  const int TIDX = opaque_tid();
  const int tid = TIDX;
  const int kr = tid >> 4, nc = (tid & 15) * 4;
#pragma unroll
  for (int i = 0; i < 2; ++i) {
    int k = kr + 32 * i;
    float4 v = *reinterpret_cast<const float4*>(src + (long)(k0 + k) * ldsrc + n0 + nc);
    float* d = lds + k * 65 + nc; d[0] = v.x; d[1] = v.y; d[2] = v.z; d[3] = v.w;
  }
  __syncthreads();
  const int n = tid >> 3, k8 = (tid & 7) * 8;
  u32x4 w;
  w[0] = cvtpk(lds[(k8 + 0) * 65 + n], lds[(k8 + 1) * 65 + n]);
  w[1] = cvtpk(lds[(k8 + 2) * 65 + n], lds[(k8 + 3) * 65 + n]);
  w[2] = cvtpk(lds[(k8 + 4) * 65 + n], lds[(k8 + 5) * 65 + n]);
  w[3] = cvtpk(lds[(k8 + 6) * 65 + n], lds[(k8 + 7) * 65 + n]);
  *reinterpret_cast<u32x4*>(dst + (long)(n0 + n) * lddst + k0 + k8) = w;
  __syncthreads();
}

__device__ __forceinline__ void phase0(const P& p, int l) {
  const int TIDX = opaque_tid();
  const int BIDX = opaque_bid();
  float* lds = (float*)smem;
  char* ws = p.ws;
  if (BIDX == 0 && TIDX == 0) { ((int*)(ws + O_CTR))[l] = 0; ((int*)(ws + O_CTR))[l + 4] = 0; }
  constexpr int NT_WIN = 16 * 163, NT_WBR = 4 * 128, NT_WOUT = 256, NT_GLU = 64, NT_UQ = 48, NT_UKV = 32, NT_UP = 16, NT_AUP = 16;
  constexpr int NT_ALL = NT_WIN + NT_WBR + NT_WOUT + NT_GLU + NT_UQ + NT_UKV + NT_UP + NT_AUP;
  for (int ti = BIDX; ti < NT_ALL; ti += gridDim.x) {
    int t = ti;
    if (t < NT_WIN) { tr_tile(p.in[I_WIN] + (long)l * 1024 * NIN, NIN, (u16*)(ws + O_WIN), 1024, (t & 15) * 64, (t >> 4) * 64, lds); continue; }
    t -= NT_WIN;
    if (t < NT_WBR) { int nb = t >> 7, r = t & 127;
      tr_tile(p.in[I_WBR] + ((long)l * 4 + nb) * 512 * 1024, 1024, (u16*)(ws + O_WBR) + (long)nb * 1024 * 512, 512, (r & 7) * 64, (r >> 3) * 64, lds); continue; }
    t -= NT_WBR;
    if (t < NT_WOUT) { tr_tile(p.in[I_WOUT] + (long)l * 1024 * 1024, 1024, (u16*)(ws + O_WOUT), 1024, (t & 15) * 64, (t >> 4) * 64, lds); continue; }
    t -= NT_WOUT;
    if (t < NT_GLU) { tr_tile(p.in[I_GLUW] + (long)l * 512 * 512, 512, (u16*)(ws + O_GLU), 512, (t & 7) * 64, (t >> 3) * 64, lds); continue; }
    t -= NT_GLU;
    if (t < NT_UQ) { tr_tile(p.in[I_WUQ] + (long)l * 256 * 768, 768, (u16*)(ws + O_UQ), 256, (t & 3) * 64, (t >> 2) * 64, lds); continue; }
    t -= NT_UQ;
    if (t < NT_UKV) { tr_tile(p.in[I_WUKV] + (long)l * 128 * 1024, 1024, (u16*)(ws + O_UKV), 128, (t & 1) * 64, (t >> 1) * 64, lds); continue; }
    t -= NT_UKV;
    if (t < NT_UP) { int d = t >> 3, r = t & 7;
      tr_tile(p.in[I_WUP] + ((long)l * 2 + d) * 64 * 512, 512, (u16*)(ws + O_WUP) + (long)d * 512 * 64, 64, 0, r * 64, lds); continue; }
    t -= NT_UP;
    { int d = t >> 3, r = t & 7;
      tr_tile(p.in[I_AUP] + ((long)l * 2 + d) * 64 * 512, 512, (u16*)(ws + O_AUP) + (long)d * 512 * 64, 64, 0, r * 64, lds); }
  }
  const float* xin = (l == 0) ? p.in[I_X] : p.out;
  const float* g = p.in[I_NORMG] + l * 1024;
  u16* h = (u16*)(ws + O_H);
  const int wid = TIDX >> 6, lane = TIDX & 63;
  for (int t = BIDX * 8 + wid; t < T; t += gridDim.x * 8) {
    const float* xr = xin + (long)t * 1024;
    float4 v[4]; float ss = 0.f;
#pragma unroll
    for (int i = 0; i < 4; ++i) { v[i] = *reinterpret_cast<const float4*>(xr + i * 256 + lane * 4); ss += v[i].x * v[i].x + v[i].y * v[i].y + v[i].z * v[i].z + v[i].w * v[i].w; }
    ss = wsum(ss);
    float sc = rsqrtf(ss * (1.f / 1024.f) + 1e-6f);
#pragma unroll
    for (int i = 0; i < 4; ++i) {
      float4 gg = *reinterpret_cast<const float4*>(g + i * 256 + lane * 4);
      uint2 o; o.x = cvtpk(v[i].x * sc * gg.x, v[i].y * sc * gg.y); o.y = cvtpk(v[i].z * sc * gg.z, v[i].w * sc * gg.w);
      *reinterpret_cast<uint2*>(h + (long)t * 1024 + i * 256 + lane * 4) = o;
    }
  }
}

template <int MT>
__device__ __forceinline__ void gemm_main(const u16* __restrict__ A, long lda, const u16* __restrict__ Bt, long ldb, int K,
                                          f32x4 (&acc)[MT][4], char* lds) {
  const int TIDX = opaque_tid();
  constexpr int BM = MT * 64;
  constexpr int ASZ = BM * 128, BSZ = 128 * 128, STG = ASZ + BSZ;
  const int tid = TIDX, lane = tid & 63, wid = tid >> 6, wm = wid >> 1, wn = wid & 1, fr = lane & 15, fq = lane >> 4;
  bf16x8 ra[MT], rb[2];
  const int nk = K >> 6;
#define GLOAD(k0) do { _Pragma("unroll") for (int i = 0; i < MT; ++i) { int gi = tid + 512 * i; int row = gi >> 3, g = gi & 7; \
      ra[i] = *reinterpret_cast<const bf16x8*>(A + (long)row * lda + (k0) + g * 8); } \
    _Pragma("unroll") for (int i = 0; i < 2; ++i) { int gi = tid + 512 * i; int row = gi >> 3, g = gi & 7; \
      rb[i] = *reinterpret_cast<const bf16x8*>(Bt + (long)row * ldb + (k0) + g * 8); } } while (0)
#define SWRITE(st) do { char* base_ = lds + (st) * STG; \
    _Pragma("unroll") for (int i = 0; i < MT; ++i) { int gi = tid + 512 * i; int row = gi >> 3, g = gi & 7; \
      *reinterpret_cast<bf16x8*>(base_ + row * 128 + ((g ^ ((row >> 1) & 7)) << 4)) = ra[i]; } \
    _Pragma("unroll") for (int i = 0; i < 2; ++i) { int gi = tid + 512 * i; int row = gi >> 3, g = gi & 7; \
      *reinterpret_cast<bf16x8*>(base_ + ASZ + row * 128 + ((g ^ ((row >> 1) & 7)) << 4)) = rb[i]; } } while (0)
  GLOAD(0); SWRITE(0); __syncthreads();
  for (int kt = 0; kt < nk; ++kt) {
    const int cur = kt & 1;
    if (kt + 1 < nk) GLOAD((kt + 1) * 64);
    const char* sa = lds + cur * STG; const char* sb = sa + ASZ;
#pragma unroll
    for (int kk = 0; kk < 2; ++kk) {
      bf16x8 af[MT], bfr[4];
      const int g = kk * 4 + fq;
#pragma unroll
      for (int i = 0; i < MT; ++i) { int row = wm * (MT * 16) + i * 16 + fr; af[i] = *reinterpret_cast<const bf16x8*>(sa + row * 128 + ((g ^ ((row >> 1) & 7)) << 4)); }
#pragma unroll
      for (int j = 0; j < 4; ++j) { int row = wn * 64 + j * 16 + fr; bfr[j] = *reinterpret_cast<const bf16x8*>(sb + row * 128 + ((g ^ ((row >> 1) & 7)) << 4)); }
#pragma unroll
      for (int i = 0; i < MT; ++i)
#pragma unroll
        for (int j = 0; j < 4; ++j) acc[i][j] = __builtin_amdgcn_mfma_f32_16x16x32_bf16(af[i], bfr[j], acc[i][j], 0, 0, 0);
    }
    if (kt + 1 < nk) SWRITE(cur ^ 1);
    __syncthreads();
  }
#undef GLOAD
#undef SWRITE
}
#define EPI_LOOP(MT_, BODY) do { const int lane_ = TIDX & 63, wid_ = TIDX >> 6, wm_ = wid_ >> 1, wn_ = wid_ & 1, fr_ = lane_ & 15, fq_ = lane_ >> 4; \
  _Pragma("unroll") for (int i = 0; i < MT_; ++i) _Pragma("unroll") for (int j = 0; j < 4; ++j) _Pragma("unroll") for (int jj = 0; jj < 4; ++jj) { \
    const int m = m0 + wm_ * (MT_ * 16) + i * 16 + fq_ * 4 + jj; const int n = n0 + wn_ * 64 + j * 16 + fr_; BODY } } while (0)

template <int MT> __device__ __forceinline__ void zero_acc(f32x4 (&acc)[MT][4]) {
#pragma unroll
  for (int i = 0; i < MT; ++i)
#pragma unroll
    for (int j = 0; j < 4; ++j) acc[i][j] = f32x4{0.f, 0.f, 0.f, 0.f};
}


#define LAS3 __attribute__((address_space(3)))
namespace fg {
constexpr int BM = 256, BK = 64, HALF = 128, HTB = HALF * BK * 2, NXCD = 8, WGM = 8;
__device__ __forceinline__ int lds_byte(int r, int c) { const int st = (r >> 4) * 2 + (c >> 5), rr = r & 15, cc = c & 31, ob = rr * 64 + cc * 2; return st * 1024 + (ob ^ (((ob >> 9) & 1) << 5)); }
__device__ __forceinline__ void stage_rc(int b, int& R, int& C) { const int st = b / 1024, sb = b % 1024, swz = sb ^ (((sb >> 9) & 1) << 5); R = (st >> 1) * 16 + swz / 64; C = (st & 1) * 32 + (swz % 64) / 2; }
struct Unit { int pm, pn; };
struct Order {
  int nM, nN, nwg, G, c;
  __device__ __forceinline__ void init(int M, int N, int G_, int c_) { nM = M / BM; nN = N / BM; nwg = nM * nN; G = G_; c = c_; }
  __device__ __forceinline__ bool next(int i, Unit& u) const {
    const long L = (long)i * G + c; if (L >= nwg) return false;
    int wgid = (int)L; { const int q = nwg / NXCD, r = nwg % NXCD, xcd = wgid % NXCD, off = wgid / NXCD; wgid = (xcd < r ? xcd * (q + 1) : r * (q + 1) + (xcd - r) * q) + off; }
    const int nig = WGM * nN, gid = wgid / nig, fm = gid * WGM, gsz = (nM - fm) < WGM ? (nM - fm) : WGM;
    u.pm = fm + ((wgid % nig) % gsz); u.pn = (wgid % nig) / gsz; return true;
  }
};
__device__ __forceinline__ int perm32(int rho) { const int n = rho >> 4, i = rho & 15; return 8 * (i >> 2) + 4 * n + (i & 3); }
template <class Epi, bool PERM = false>
__device__ __forceinline__ void gemm_phase(LAS3 unsigned char* lds, const u16* A, int lda, const u16* Bt, int ldb, int M, int N, int K, const Epi& E) {
  const int tid = opaque_tid(), wid = __builtin_amdgcn_readfirstlane(tid >> 6), lane = tid & 63, wr = wid >> 2, wc = wid & 3, fr = lane & 15, fq = lane >> 4;
  const int nt = K / BK;
  Order S; S.init(M, N, gridDim.x, opaque_bid());
  unsigned voffA[2], voffB[2];
#pragma unroll
  for (int i = 0; i < 2; ++i) { int R, C; stage_rc(tid * 16 + i * 8192, R, C); const int Rb = PERM ? ((R & ~31) + perm32(R & 31)) : R;
    voffA[i] = (unsigned)(R * lda + C) * 2u; voffB[i] = (unsigned)(Rb * ldb + C) * 2u; }
  const size_t kstep = (size_t)(BK * 2);
  const size_t hstepA = (size_t)HALF * lda * 2, hstepB = (size_t)HALF * ldb * 2;
  const size_t tstepA = 2 * hstepA, tstepB = 2 * hstepB;
  const unsigned ldsw = (unsigned)wid * 1024u;
  const int aoff = lds_byte(wr * 64 + fr, fq * 8), boff = lds_byte(wc * 32 + fr, fq * 8);
#define FG_SA(b, h) (((b) * 2 + (h)) * HTB)
#define FG_SB(b, h) ((4 + (b) * 2 + (h)) * HTB)
#define FG_STAGE(bufoff, gbase, voff) do { _Pragma("unroll") for (int _i = 0; _i < 2; ++_i) \
    __builtin_amdgcn_global_load_lds((const unsigned*)((const char*)(gbase) + (voff)[_i]), (LAS3 unsigned*)(lds + (bufoff) + ldsw + _i * 8192), 16, 0, 0); } while (0)
#define FG_LDA(dst, b, h) do { _Pragma("unroll") for (int m = 0; m < 4; ++m) _Pragma("unroll") for (int k = 0; k < 2; ++k) dst[m][k] = *(const LAS3 bf16x8*)(lds + FG_SA(b, h) + aoff + m * 2048 + k * 1024); } while (0)
#define FG_LDB(dst, b, h) do { _Pragma("unroll") for (int n = 0; n < 2; ++n) _Pragma("unroll") for (int k = 0; k < 2; ++k) dst[n][k] = *(const LAS3 bf16x8*)(lds + FG_SB(b, h) + boff + n * 2048 + k * 1024); } while (0)
#define FG_MMA(ai, bj, At, Bq) do { __builtin_amdgcn_s_setprio(1); _Pragma("unroll") for (int m = 0; m < 4; ++m) _Pragma("unroll") for (int n = 0; n < 2; ++n) _Pragma("unroll") for (int k = 0; k < 2; ++k) \
    acc[ai][bj][m][n] = __builtin_amdgcn_mfma_f32_16x16x32_bf16(Bq[n][k], At[m][k], acc[ai][bj][m][n], 0, 0, 0); __builtin_amdgcn_s_setprio(0); } while (0)
#define FG_WAIT_V(n) asm volatile("s_waitcnt vmcnt(" #n ")" ::: "memory")
#define FG_WAIT_L(n) asm volatile("s_waitcnt lgkmcnt(" #n ")" ::: "memory")
#define FG_BAR __builtin_amdgcn_s_barrier()
#define FG_SCHED __builtin_amdgcn_sched_barrier(0)
  Unit cur, nxt; int ui = 0;
  if (!S.next(0, cur)) return;
  f32x4 acc[2][2][4][2];
#pragma unroll
  for (int a = 0; a < 2; ++a)
#pragma unroll
    for (int b = 0; b < 2; ++b)
#pragma unroll
      for (int m = 0; m < 4; ++m)
#pragma unroll
        for (int n = 0; n < 2; ++n) acc[a][b][m][n] = (f32x4){0.f, 0.f, 0.f, 0.f};
  bf16x8 At[4][2], B0[2][2], B1[2][2];
  const char* cA = (const char*)A + (size_t)cur.pm * tstepA; const char* cB = (const char*)Bt + (size_t)cur.pn * tstepB;
  FG_STAGE(FG_SB(0, 0), cB, voffB); FG_STAGE(FG_SA(0, 0), cA, voffA); FG_STAGE(FG_SB(0, 1), cB + hstepB, voffB); FG_STAGE(FG_SA(0, 1), cA + hstepA, voffA);
  if (wr == 1) FG_BAR;
  FG_WAIT_V(4); FG_BAR;
  FG_STAGE(FG_SB(1, 0), cB + kstep, voffB); FG_STAGE(FG_SA(1, 0), cA + kstep, voffA); FG_STAGE(FG_SB(1, 1), cB + hstepB + kstep, voffB);
  FG_WAIT_V(6); FG_BAR;
  for (;;) {
    const bool has_next = S.next(ui + 1, nxt);
    const char* nA = has_next ? (const char*)A + (size_t)nxt.pm * tstepA : cA; const char* nB = has_next ? (const char*)Bt + (size_t)nxt.pn * tstepB : cB;
    for (int t = 0; t < nt; t += 2) {
      const bool last = (t == nt - 2);
      const char* a1 = cA + (size_t)(t + 1) * kstep;
      const char* a2 = last ? nA : cA + (size_t)(t + 2) * kstep; const char* b2 = last ? nB : cB + (size_t)(t + 2) * kstep;
      const char* a3 = a2 + kstep; const char* b3 = b2 + kstep;
      FG_LDB(B0, 0, 0); FG_SCHED; FG_LDA(At, 0, 0); FG_STAGE(FG_SA(1, 1), a1 + hstepA, voffA);
      FG_WAIT_L(8); FG_BAR; FG_WAIT_L(0); FG_MMA(0, 0, At, B0); FG_BAR; FG_SCHED;
      FG_LDB(B1, 0, 1); FG_STAGE(FG_SB(0, 0), b2, voffB);
      FG_BAR; FG_WAIT_L(0); FG_MMA(0, 1, At, B1); FG_BAR;
      FG_LDA(At, 0, 1); FG_STAGE(FG_SA(0, 0), a2, voffA);
      FG_BAR; FG_WAIT_L(0); FG_MMA(1, 0, At, B0); FG_BAR; FG_SCHED;
      FG_STAGE(FG_SB(0, 1), b2 + hstepB, voffB);
      FG_WAIT_V(6); FG_BAR; FG_MMA(1, 1, At, B1); FG_BAR;
      FG_LDB(B0, 1, 0); FG_SCHED; FG_LDA(At, 1, 0); FG_STAGE(FG_SA(0, 1), a2 + hstepA, voffA);
      FG_WAIT_L(8); FG_BAR; FG_WAIT_L(0); FG_MMA(0, 0, At, B0); FG_BAR; FG_SCHED;
      FG_LDB(B1, 1, 1); FG_STAGE(FG_SB(1, 0), b3, voffB);
      FG_BAR; FG_WAIT_L(0); FG_MMA(0, 1, At, B1); FG_BAR;
      FG_LDA(At, 1, 1); FG_STAGE(FG_SA(1, 0), a3, voffA);
      FG_BAR; FG_WAIT_L(0); FG_MMA(1, 0, At, B0); FG_BAR; FG_SCHED;
      FG_STAGE(FG_SB(1, 1), b3 + hstepB, voffB);
      FG_WAIT_V(6); FG_BAR; FG_MMA(1, 1, At, B1); FG_BAR;
    }
    if constexpr (PERM) {
      const int row0 = cur.pm * BM + wr * 64 + fr, col0 = cur.pn * BM + wc * 32 + 8 * fq;
#pragma unroll
      for (int ai = 0; ai < 2; ++ai)
#pragma unroll
        for (int m = 0; m < 4; ++m)
#pragma unroll
          for (int bj = 0; bj < 2; ++bj) E(row0 + ai * HALF + m * 16, col0 + bj * HALF, acc[ai][bj][m][0], acc[ai][bj][m][1]);
    } else {
      const int row0 = cur.pm * BM + wr * 64 + fr, col0 = cur.pn * BM + wc * 32 + 4 * fq;
#pragma unroll
      for (int ai = 0; ai < 2; ++ai)
#pragma unroll
        for (int m = 0; m < 4; ++m)
#pragma unroll
          for (int bj = 0; bj < 2; ++bj)
#pragma unroll
            for (int n = 0; n < 2; ++n) E(row0 + ai * HALF + m * 16, col0 + bj * HALF + n * 16, acc[ai][bj][m][n]);
    }
    if (!has_next) break;
#pragma unroll
    for (int a = 0; a < 2; ++a)
#pragma unroll
      for (int b = 0; b < 2; ++b)
#pragma unroll
        for (int m = 0; m < 4; ++m)
#pragma unroll
          for (int n = 0; n < 2; ++n) acc[a][b][m][n] = (f32x4){0.f, 0.f, 0.f, 0.f};
    cur = nxt; cA = nA; cB = nB; ++ui;
  }
  FG_WAIT_V(0);
  if (wr == 0) FG_BAR;
  FG_BAR;
#undef FG_SA
#undef FG_SB
#undef FG_STAGE
#undef FG_LDA
#undef FG_LDB
#undef FG_MMA
#undef FG_WAIT_V
#undef FG_WAIT_L
#undef FG_BAR
#undef FG_SCHED
}
}

struct EpiP1 { u16* PB; __device__ __forceinline__ void operator()(int row, int col, f32x4 v0, f32x4 v1) const {
  if (col < NP) { u32x4 o; o[0] = cvtpk(v0[0], v0[1]); o[1] = cvtpk(v0[2], v0[3]); o[2] = cvtpk(v1[0], v1[1]); o[3] = cvtpk(v1[2], v1[3]);
    *reinterpret_cast<u32x4*>(PB + (long)row * NP + col) = o; } } };
struct EpiGate { u16* G; const float* gb; __device__ __forceinline__ void operator()(int row, int col, f32x4 v0, f32x4 v1) const {
  const f32x4 b0 = *reinterpret_cast<const f32x4*>(gb + col), b1 = *reinterpret_cast<const f32x4*>(gb + col + 4);
  u32x4 o; o[0] = cvtpk(sigmoidf_(v0[0] + b0[0]), sigmoidf_(v0[1] + b0[1])); o[1] = cvtpk(sigmoidf_(v0[2] + b0[2]), sigmoidf_(v0[3] + b0[3]));
  o[2] = cvtpk(sigmoidf_(v1[0] + b1[0]), sigmoidf_(v1[1] + b1[1])); o[3] = cvtpk(sigmoidf_(v1[2] + b1[2]), sigmoidf_(v1[3] + b1[3]));
  *reinterpret_cast<u32x4*>(G + (long)row * 4096 + col) = o; } };
struct EpiOut { float* out; const float* xin; __device__ __forceinline__ void operator()(int row, int col, f32x4 v) const {
  const f32x4 x = *reinterpret_cast<const f32x4*>(xin + (long)row * 1024 + col);
  *reinterpret_cast<f32x4*>(out + (long)row * 1024 + col) = x + v; } };

__device__ __forceinline__ void phase1(const P& p) {
  char* ws = p.ws;
  EpiP1 e{(u16*)(ws + O_P)};
  fg::gemm_phase<EpiP1, true>((LAS3 unsigned char*)smem, (const u16*)(ws + O_H), 1024, (const u16*)(ws + O_WIN), 1024, T, 6400, 1024, e);
}

__device__ __forceinline__ void phase2(const P& p, int l) {
  const int TIDX = opaque_tid();
  const int BIDX = opaque_bid();
  char* ws = p.ws;
  const u16* __restrict__ PB = (const u16*)(ws + O_P);
  u16* __restrict__ DQ = (u16*)(ws + QK_DQ); u16* __restrict__ DKb = (u16*)(ws + QK_DK);
  u16* __restrict__ CQN = (u16*)(ws + OA_CQN); u16* __restrict__ CKVN = (u16*)(ws + OA_CKVN);
  u16* __restrict__ LINW = (u16*)(ws + OA_LINW); u16* __restrict__ LINA = (u16*)(ws + OA_LINA);
  const int wid = TIDX >> 6, lane = TIDX & 63, l7 = lane & 7, e0 = l7 * 8, hv = lane >> 3;
  const F8 gq = ld8f(p.in[I_DQN] + l * 64 + e0), gk = ld8f(p.in[I_DKN] + l * 64 + e0);
  float invd[8];
#pragma unroll
  for (int j = 0; j < 8; ++j) invd[j] = exp2f(-(float)j * (1.f / 8.f) * 18.931568569324174f);
  F8 glat = zero8();
  if (lane < 32) glat = ld8f(p.in[I_QLN] + l * 256 + lane * 8); else if (lane < 48) glat = ld8f(p.in[I_KVLN] + l * 128 + (lane - 32) * 8);
  F8 mu0 = zero8(), mu1 = zero8();
  if (lane < 32) { mu0 = ld8f(p.in[I_MU] + (long)l * 2 * 1792 + 1536 + lane * 8); mu1 = ld8f(p.in[I_MU] + (long)l * 2 * 1792 + 1792 + 1536 + lane * 8); }
  for (int t = BIDX * 8 + wid; t < T; t += gridDim.x * 8) {
    const int b = t >> 12, s = t & 4095;
    const u16* pr = PB + (long)t * NP;
    F8 q = ld8bf(pr + C_DQ + lane * 8), k = ld8bf(pr + C_DK + lane * 8);
    F8 lat = zero8(); if (lane < 48) lat = ld8bf(pr + C_MCQ + lane * 8);
    F8 xc = zero8(), xp = zero8(), xn = zero8();
    if (lane < 32) { xc = ld8bf(pr + C_RC + 1536 + lane * 8); if (s > 0) xp = ld8bf(pr - NP + C_RC + 1536 + lane * 8); if (s < S - 1) xn = ld8bf(pr + NP + C_RC + 1536 + lane * 8); }
    float sq = 0.f, sk = 0.f;
#pragma unroll
    for (int j = 0; j < 8; ++j) { sq += q.v[j] * q.v[j]; sk += k.v[j] * k.v[j]; }
    sq = grp8sum(sq); sk = grp8sum(sk);
    const float cq_ = rsqrtf(sq * (1.f / 64.f) + 1e-6f), ck_ = rsqrtf(sk * (1.f / 64.f) + 1e-6f);
#pragma unroll
    for (int j = 0; j < 8; ++j) {
      float yq = q.v[j] * cq_ * gq.v[j], yk = k.v[j] * ck_ * gk.v[j];
      const float pq = dpp_xor1(yq), pk = dpp_xor1(yk);
      float sn, cs; sincos_rev((float)s * invd[j], sn, cs);
      if (l7 == 0) { yq = yq * cs - pq * sn; yk = yk * cs - pk * sn; }
      else if (l7 == 1) { yq = pq * sn + yq * cs; yk = pk * sn + yk * cs; }
      q.v[j] = yq; k.v[j] = yk;
    }
    st8bf(DQ + ((long)(b * 8 + hv) * S + s) * 64 + e0, q);
    st8bf(DKb + ((long)(b * 8 + hv) * S + s) * 64 + e0, k);
    {
      float ss = 0.f;
#pragma unroll
      for (int j = 0; j < 8; ++j) ss += lat.v[j] * lat.v[j];
      const float s1 = wsum(lane < 32 ? ss : 0.f), s2 = wsum((lane >= 32 && lane < 48) ? ss : 0.f);
      const float sc = (lane < 32) ? rsqrtf(s1 * (1.f / 256.f) + 1e-6f) : rsqrtf(s2 * (1.f / 128.f) + 1e-6f);
#pragma unroll
      for (int j = 0; j < 8; ++j) lat.v[j] = lat.v[j] * sc * glat.v[j];
      if (lane < 32) st8bf(CQN + (long)t * 256 + lane * 8, lat); else if (lane < 48) st8bf(CKVN + (long)t * 128 + (lane - 32) * 8, lat);
    }
    if (lane < 32) {
      F8 o;
#pragma unroll
      for (int j = 0; j < 8; ++j) {
        const float xs = xc.v[j] + mu0.v[j] * (xp.v[j] - xc.v[j]) + mu1.v[j] * (xn.v[j] - xc.v[j]);
        if (lane < 16) { const float e2 = __expf(2.f * xs); o.v[j] = 1.f - 2.f * __builtin_amdgcn_rcpf(e2 + 1.f); } else o.v[j] = xs;
      }
      if (lane < 16) st8bf(LINW + (long)t * 128 + lane * 8, o); else st8bf(LINA + (long)t * 128 + (lane - 16) * 8, o);
    }
  }
}

__device__ __forceinline__ void phase3(const P& p) {
  const int TIDX = opaque_tid();
  const int BIDX = opaque_bid();
  char* ws = p.ws;
  for (int ti = BIDX; ti < 30 * 64; ti += gridDim.x) {
    const int ng = ti % 30, mt = ti / 30; const int m0 = mt * 256;
    const u16* A; long lda; const u16* Bt; long ldb; int K; u16* C; long ldc; int n0;
    if (ng < 6) { A = (const u16*)(ws + OA_CQN); lda = 256; K = 256; n0 = ng * 128; Bt = (const u16*)(ws + O_UQ) + (long)n0 * 256; ldb = 256; C = (u16*)(ws + OA_QRAW); ldc = 768; }
    else if (ng < 14) { A = (const u16*)(ws + OA_CKVN); lda = 128; K = 128; n0 = (ng - 6) * 128; Bt = (const u16*)(ws + O_UKV) + (long)n0 * 128; ldb = 128; C = (u16*)(ws + OA_KVRAW); ldc = 1024; }
    else { const int q = ng - 14; const int isA = q >> 3, d = (q >> 2) & 1; n0 = (q & 3) * 128;
      A = (const u16*)(ws + (isA ? OA_LINA : OA_LINW)) + d * 64; lda = 128; K = 64;
      Bt = (const u16*)(ws + (isA ? O_AUP : O_WUP)) + (long)d * 512 * 64 + (long)n0 * 64; ldb = 64;
      C = (u16*)(ws + (isA ? OA_AL : OA_WL)) + d * 512; ldc = 1024; }
    f32x4 acc[4][4]; zero_acc<4>(acc);
    gemm_main<4>(A + (long)m0 * lda, lda, Bt, ldb, K, acc, smem);
    EPI_LOOP(4, { C[(long)m * ldc + n] = f2bf(acc[i][j][jj]); });
  }
}

__device__ __forceinline__ void phase4(const P& p, int l) {
  const int TIDX = opaque_tid();
  const int BIDX = opaque_bid();
  char* ws = p.ws;
  const u16* __restrict__ PB = (const u16*)(ws + O_P);
  const u16* __restrict__ QRAW = (const u16*)(ws + OA_QRAW); const u16* __restrict__ KVRAW = (const u16*)(ws + OA_KVRAW);
  const u16* __restrict__ WL = (const u16*)(ws + OA_WL); const u16* __restrict__ AL = (const u16*)(ws + OA_AL);
  u16* __restrict__ MQ = (u16*)(ws + QK_MQ); u16* __restrict__ MK = (u16*)(ws + QK_MK); u16* __restrict__ MV = (u16*)(ws + QK_MV);
  u16* __restrict__ RR = (u16*)(ws + RW_R); u16* __restrict__ RK = (u16*)(ws + RW_K); u16* __restrict__ RV = (u16*)(ws + RW_V); u16* __restrict__ RKK = (u16*)(ws + RW_KK);
  u16* __restrict__ RA = (u16*)(ws + RW_A); u16* __restrict__ RE = (u16*)(ws + RW_E); float* __restrict__ BON = (float*)(ws + RW_BON);
  const int wid = TIDX >> 6, lane = TIDX & 63;
  float* lp = (float*)smem;
  {
    const float* mu = p.in[I_MU] + (long)l * 2 * 1792;
    for (int i = TIDX; i < 13 * 512; i += 512) {
      const int a = i >> 9, c = i & 511; float v;
      if (a < 3) v = mu[a * 512 + c]; else if (a < 6) v = mu[1792 + (a - 3) * 512 + c];
      else if (a == 6) v = p.in[I_KK][l * 512 + c]; else if (a == 7) v = p.in[I_KA][l * 512 + c]; else if (a == 8) v = p.in[I_RK][l * 512 + c];
      else if (a < 11) v = p.in[I_W0][(l * 2 + (a - 9)) * 512 + c]; else v = p.in[I_A0][(l * 2 + (a - 11)) * 512 + c];
      lp[i] = v;
    }
  }
  __syncthreads();
  const int hA = lane >> 4, eA = (lane & 15) * 8, hB = (lane >> 3) & 3, eB = (lane & 7) * 8;
  const F8 qnA = ld8f(p.in[I_MQN] + l * 192 + eA), qnB = ld8f(p.in[I_MQN] + l * 192 + 128 + eB);
  const F8 knA = ld8f(p.in[I_MKN] + l * 192 + eA), knB = ld8f(p.in[I_MKN] + l * 192 + 128 + eB);
  float invm[8];
#pragma unroll
  for (int j = 0; j < 8; ++j) invm[j] = exp2f(-(float)((lane & 3) * 8 + j) * (1.f / 32.f) * 13.287712379549449f);
  const bool lowhalf = (lane & 4) == 0;
  for (int t = BIDX * 8 + wid; t < T; t += gridDim.x * 8) {
    const int b = t >> 12, s = t & 4095;
    const u16* pr = PB + (long)t * NP;
    F8 qA = ld8bf(QRAW + (long)t * 768 + hA * 192 + eA), qB = ld8bf(QRAW + (long)t * 768 + hB * 192 + 128 + eB);
    F8 kA = ld8bf(KVRAW + (long)t * 1024 + hA * 256 + eA), vA = ld8bf(KVRAW + (long)t * 1024 + hA * 256 + 128 + eA);
    F8 kB = ld8bf(pr + C_MKR + eB);
    {
      float sqA = 0.f, sqB = 0.f, skA = 0.f, skB = 0.f;
#pragma unroll
      for (int j = 0; j < 8; ++j) { sqA += qA.v[j] * qA.v[j]; sqB += qB.v[j] * qB.v[j]; skA += kA.v[j] * kA.v[j]; skB += kB.v[j] * kB.v[j]; }
      sqA = grp16sum(sqA); skA = grp16sum(skA); sqB = grp8sum(sqB); skB = grp8sum(skB);
      const float sqB_forA = __shfl(sqB, 8 * hA), sqA_forB = __shfl(sqA, 16 * hB);
      const float skA_forB = __shfl(skA, 16 * hB);
      const float scqA = rsqrtf((sqA + sqB_forA) * (1.f / 192.f) + 1e-6f), scqB = rsqrtf((sqA_forB + sqB) * (1.f / 192.f) + 1e-6f);
      const float sckA = rsqrtf((skA + skB) * (1.f / 192.f) + 1e-6f), sckB = rsqrtf((skA_forB + skB) * (1.f / 192.f) + 1e-6f);
#pragma unroll
      for (int j = 0; j < 8; ++j) {
        qA.v[j] *= scqA * qnA.v[j]; kA.v[j] *= sckA * knA.v[j];
        float yq = qB.v[j] * scqB * qnB.v[j], yk = kB.v[j] * sckB * knB.v[j];
        const float pq = swz_xor4(yq), pk = swz_xor4(yk);
        float sn, cs; sincos_rev((float)s * invm[j], sn, cs);
        qB.v[j] = lowhalf ? (yq * cs - pq * sn) : (pq * sn + yq * cs);
        kB.v[j] = lowhalf ? (yk * cs - pk * sn) : (pk * sn + yk * cs);
      }
      u16* mq = MQ + ((long)(b * 4 + hA) * S + s) * 192; u16* mk = MK + ((long)(b * 4 + hA) * S + s) * 192;
      st8bf(mq + eA, qA); st8bf(mk + eA, kA);
      st8bf(MV + ((long)(b * 4 + hA) * S + s) * 128 + eA, vA);
      if (lane < 32) { st8bf(MQ + ((long)(b * 4 + hB) * S + s) * 192 + 128 + eB, qB); st8bf(MK + ((long)(b * 4 + hB) * S + s) * 192 + 128 + eB, kB); }
    }
#pragma unroll 1
    for (int hf = 0; hf < 2; ++hf) {
      const int c0 = hf * 256 + lane * 4;
      const F4 xr = ld4bf(pr + C_RC + c0), xk = ld4bf(pr + C_RC + 512 + c0), xv = ld4bf(pr + C_RC + 1024 + c0);
      F4 pr_ = zero4(), pk_ = zero4(), pv_ = zero4(), nr_ = zero4(), nk_ = zero4(), nv_ = zero4();
      if (s > 0) { pr_ = ld4bf(pr - NP + C_RC + c0); pk_ = ld4bf(pr - NP + C_RC + 512 + c0); pv_ = ld4bf(pr - NP + C_RC + 1024 + c0); }
      if (s < S - 1) { nr_ = ld4bf(pr + NP + C_RC + c0); nk_ = ld4bf(pr + NP + C_RC + 512 + c0); nv_ = ld4bf(pr + NP + C_RC + 1024 + c0); }
      const F4 wl0 = ld4bf(WL + ((long)t * 2) * 512 + c0), wl1 = ld4bf(WL + ((long)t * 2 + 1) * 512 + c0);
      const F4 al0 = ld4bf(AL + ((long)t * 2) * 512 + c0), al1 = ld4bf(AL + ((long)t * 2 + 1) * 512 + c0);
      const F4 m0r = ld4f(lp + 0 * 512 + c0), m0k = ld4f(lp + 1 * 512 + c0), m0v = ld4f(lp + 2 * 512 + c0);
      const F4 m1r = ld4f(lp + 3 * 512 + c0), m1k = ld4f(lp + 4 * 512 + c0), m1v = ld4f(lp + 5 * 512 + c0);
      const F4 kkp = ld4f(lp + 6 * 512 + c0), kap = ld4f(lp + 7 * 512 + c0), rkp = ld4f(lp + 8 * 512 + c0);
      const F4 w00 = ld4f(lp + 9 * 512 + c0), w01 = ld4f(lp + 10 * 512 + c0), a00 = ld4f(lp + 11 * 512 + c0), a01 = ld4f(lp + 12 * 512 + c0);
      F4 r, k, v, kk, e0_, e1_, a0_, a1_; float ss = 0.f, bon = 0.f;
#pragma unroll
      for (int j = 0; j < 4; ++j) {
        r.v[j] = xr.v[j] + m0r.v[j] * (pr_.v[j] - xr.v[j]) + m1r.v[j] * (nr_.v[j] - xr.v[j]);
        k.v[j] = xk.v[j] + m0k.v[j] * (pk_.v[j] - xk.v[j]) + m1k.v[j] * (nk_.v[j] - xk.v[j]);
        v.v[j] = xv.v[j] + m0v.v[j] * (pv_.v[j] - xv.v[j]) + m1v.v[j] * (nv_.v[j] - xv.v[j]);
        kk.v[j] = k.v[j] * kkp.v[j]; ss += kk.v[j] * kk.v[j];
      }
      ss = grp16sum(ss);
      const float inrm = rsqrtf(fmaxf(ss, 1e-24f));
#pragma unroll
      for (int j = 0; j < 4; ++j) {
        kk.v[j] *= inrm;
        {
          e0_.v[j] = 0.6065306597126334f * sigmoidf_(w00.v[j] + wl0.v[j]);
          const float a = sigmoidf_(a00.v[j] + al0.v[j]); a0_.v[j] = a;
          bon += r.v[j] * k.v[j] * (1.f + (a - 1.f) * kap.v[j]) * rkp.v[j];
        }
        {
          e1_.v[j] = 0.6065306597126334f * sigmoidf_(w01.v[j] + wl1.v[j]);
          const float a = sigmoidf_(a01.v[j] + al1.v[j]); a1_.v[j] = a;
          bon += r.v[j] * k.v[j] * (1.f + (a - 1.f) * kap.v[j]) * rkp.v[j];
        }
      }
      bon = grp16sum(bon);
      if ((lane & 15) == 0) BON[(long)t * 8 + hf * 4 + (lane >> 4)] = bon;
      const long o = (long)t * 512 + c0;
      st4bf(RR + o, r); st4bf(RK + o, k); st4bf(RV + o, v); st4bf(RKK + o, kk);
      st4bf(RE + o, e0_); st4bf(RE + (long)T * 512 + o, e1_); st4bf(RA + o, a0_); st4bf(RA + (long)T * 512 + o, a1_);
    }
  }
  __syncthreads();
}

#define SBAR() __builtin_amdgcn_sched_barrier(0)
__device__ __forceinline__ int crow(int r, int hi) { return (r & 3) + 8 * (r >> 2) + 4 * hi; }
template <int DK> struct AC {
  static constexpr float SCALE = (DK == 64) ? 0.125f : 0.07216878364870323f;
  static constexpr float THR = 8.f;
  static constexpr int NKG = DK / 64;
  static constexpr int SHM_K = 64 * DK * 2, SHM_V = 64 * 128 * 2;
};
template <int DK>
__device__ __forceinline__ void partialSM(f32x16& p0, f32x16& p1, float& m_reg, float& mn, float& alpha) {
  constexpr float C = AC<DK>::SCALE * 1.4426950408889634f;
  float pmax = p0[0];
#pragma unroll
  for (int r = 1; r < 16; ++r) pmax = fmaxf(pmax, p0[r]);
#pragma unroll
  for (int r = 0; r < 16; ++r) pmax = fmaxf(pmax, p1[r]);
  { auto rr = __builtin_amdgcn_permlane32_swap(__float_as_uint(pmax), __float_as_uint(pmax), false, false);
    pmax = fmaxf(__uint_as_float(rr[0]), __uint_as_float(rr[1])); }
  if (__builtin_expect(__all(pmax - m_reg <= AC<DK>::THR / AC<DK>::SCALE), 1)) { mn = m_reg; alpha = 1.f; }
  else { mn = fmaxf(m_reg, pmax); alpha = __builtin_amdgcn_exp2f((m_reg - mn) * C); m_reg = mn; }
  float mnC = -mn * C;
#pragma unroll
  for (int r = 0; r < 16; ++r) p0[r] = fmaf(p0[r], C, mnC);
#pragma unroll
  for (int r = 0; r < 16; ++r) p1[r] = fmaf(p1[r], C, mnC);
#pragma unroll
  for (int r = 0; r < 16; ++r) p0[r] = __builtin_amdgcn_exp2f(p0[r]);
}
__device__ __forceinline__ void finishSM(f32x16& p0, f32x16& p1, float alpha, float& l_reg, bf16x8& pa0, bf16x8& pa1, bf16x8& pa2, bf16x8& pa3) {
#pragma unroll
  for (int r = 0; r < 16; ++r) p1[r] = __builtin_amdgcn_exp2f(p1[r]);
  float ps = 0;
#pragma unroll
  for (int r = 0; r < 16; ++r) ps += p0[r];
#pragma unroll
  for (int r = 0; r < 16; ++r) ps += p1[r];
  { auto rr = __builtin_amdgcn_permlane32_swap(__float_as_uint(ps), __float_as_uint(ps), false, false);
    ps = __uint_as_float(rr[0]) + __uint_as_float(rr[1]); }
  l_reg = l_reg * alpha + ps;
#define PK4(Pv, BASE, OUT) do { unsigned a0 = cvtpk_asm(Pv[BASE + 0], Pv[BASE + 1]), a1 = cvtpk_asm(Pv[BASE + 2], Pv[BASE + 3]);   \
    unsigned b0 = cvtpk_asm(Pv[BASE + 4], Pv[BASE + 5]), b1 = cvtpk_asm(Pv[BASE + 6], Pv[BASE + 7]);                              \
    auto r0 = __builtin_amdgcn_permlane32_swap(a0, b0, false, false); auto r1 = __builtin_amdgcn_permlane32_swap(a1, b1, false, false); \
    u32x4 w = {r0[0], r1[0], r0[1], r1[1]}; OUT = *reinterpret_cast<bf16x8*>(&w); } while (0)
  PK4(p0, 0, pa0); PK4(p0, 8, pa1); PK4(p1, 0, pa2); PK4(p1, 8, pa3);
#undef PK4
}
template <int DK>
__device__ __forceinline__ void qkt(f32x16& p0, f32x16& p1, const char* Ks, const bf16x8* qr, int r32, int hi) {
  p0 = f32x16{}; p1 = f32x16{};
  const int sw = (r32 & 7) << 4;
  const char* kb[4];
#pragma unroll
  for (int q = 0; q < 4; ++q) kb[q] = Ks + r32 * (DK * 2) + ((q * 32 + hi * 16) ^ sw);
#pragma unroll
  for (int d0 = 0; d0 < DK / 16; ++d0) {
    bf16x8 b0 = *reinterpret_cast<const bf16x8*>(kb[d0 & 3] + (d0 >> 2) * 128);
    bf16x8 b1 = *reinterpret_cast<const bf16x8*>(kb[d0 & 3] + (d0 >> 2) * 128 + 32 * (DK * 2));
    p0 = __builtin_amdgcn_mfma_f32_32x32x16_bf16(b0, qr[d0], p0, 0, 0, 0);
    p1 = __builtin_amdgcn_mfma_f32_32x32x16_bf16(b1, qr[d0], p1, 0, 0, 0); }
}
__device__ __forceinline__ int v_st(int k, int c) { const int kk = (k & ~0xC) | ((k & 4) << 1) | ((k & 8) >> 1); return ((kk >> 3) * 4 + (c >> 5)) * 512 + ((kk & 7) * 32 + (c & 31)) * 2; }
__device__ __forceinline__ int v_rd_base(int lane) { return ((lane & 3) << 3) | (((lane >> 2) & 3) << 6) | (((lane >> 4) & 1) << 5) | (((lane >> 5) & 1) << 8); }
constexpr int v_rd_off(int d0, int ks, int half) { return d0 * 512 + ks * 4096 + half * 2048; }
template <int OFF> __device__ __forceinline__ s16x4 tr_read(int vb) {
  s16x4 r; asm volatile("ds_read_b64_tr_b16 %0, %1 offset:%2" : "=&v"(r) : "v"(vb), "i"(OFF) : "memory"); return r;
}
template <int D0> __device__ __forceinline__ void pv_one(f32x16& od, int vb, bf16x8 pa0, bf16x8 pa1, bf16x8 pa2, bf16x8 pa3) {
  const s16x4 l0 = tr_read<v_rd_off(D0, 0, 0)>(vb), h0 = tr_read<v_rd_off(D0, 0, 1)>(vb), l1 = tr_read<v_rd_off(D0, 1, 0)>(vb), h1 = tr_read<v_rd_off(D0, 1, 1)>(vb);
  const s16x4 l2 = tr_read<v_rd_off(D0, 2, 0)>(vb), h2 = tr_read<v_rd_off(D0, 2, 1)>(vb), l3 = tr_read<v_rd_off(D0, 3, 0)>(vb), h3 = tr_read<v_rd_off(D0, 3, 1)>(vb);
  asm volatile("s_waitcnt lgkmcnt(0)" ::: "memory"); SBAR();
#define PKV(L, H) (bf16x8){L[0], L[1], L[2], L[3], H[0], H[1], H[2], H[3]}
  od = __builtin_amdgcn_mfma_f32_32x32x16_bf16(pa0, PKV(l0, h0), od, 0, 0, 0);
  od = __builtin_amdgcn_mfma_f32_32x32x16_bf16(pa1, PKV(l1, h1), od, 0, 0, 0);
  od = __builtin_amdgcn_mfma_f32_32x32x16_bf16(pa2, PKV(l2, h2), od, 0, 0, 0);
  od = __builtin_amdgcn_mfma_f32_32x32x16_bf16(pa3, PKV(l3, h3), od, 0, 0, 0);
#undef PKV
}
__device__ __forceinline__ void pv_d0(f32x16* o, int vb, bf16x8 pa0, bf16x8 pa1, bf16x8 pa2, bf16x8 pa3) {
  pv_one<0>(o[0], vb, pa0, pa1, pa2, pa3); pv_one<1>(o[1], vb, pa0, pa1, pa2, pa3); pv_one<2>(o[2], vb, pa0, pa1, pa2, pa3); pv_one<3>(o[3], vb, pa0, pa1, pa2, pa3);
}
__device__ __forceinline__ void ostore(float* p, float v) { *p = v; }
__device__ __forceinline__ void ostore(u16* p, float v) { *p = f2bf(v); }

template <int DK, int SD, int LDQ, int LDK, int LDV, int LDO, typename TO>
__device__ __forceinline__ void attn_body(const u16* __restrict__ Qb, const u16* __restrict__ Kh, const u16* __restrict__ Vh,
                                          TO* __restrict__ Ob, int seq, char* lds) {
  const int TIDX = opaque_tid();
  constexpr int SHM_V = AC<DK>::SHM_V, SHM_K = AC<DK>::SHM_K, NKG = AC<DK>::NKG, KG = DK / 8;
  const int tid = TIDX, wid = tid >> 6, lane = tid & 63, r32 = lane & 31, hi = lane >> 5;
  char* V_lds = lds; char* K_lds = lds + 2 * SHM_V;
  float* wsl = (float*)(lds + 2 * SHM_V + 2 * SHM_K) + wid * 64; float* li_l = wsl; float* al_l = wsl + 32;
  float m_reg = -1e30f, l_reg = 0; f32x16 o[4] = {}; bf16x8 qr[DK / 16];
  const u16* Qw = Qb + (long)(wid * 32 + r32) * LDQ + hi * 8;
#pragma unroll
  for (int d0 = 0; d0 < DK / 16; ++d0) qr[d0] = *reinterpret_cast<const bf16x8*>(Qw + d0 * 16);
  const int sr = tid >> 4, sc = (tid & 15) * 8, vst0 = v_st(sr, sc), vst1 = v_st(32 + sr, sc);
  const int vb0 = (int)(uintptr_t)V_lds + v_rd_base(lane);
  struct { bf16x8 vs0, vs1, ks[NKG]; } sr_[SD];
#define SLOAD(i, k0) do { sr_[i].vs0 = *reinterpret_cast<const bf16x8*>(&Vh[(long)((k0) + sr) * LDV + sc]); \
    sr_[i].vs1 = *reinterpret_cast<const bf16x8*>(&Vh[(long)((k0) + 32 + sr) * LDV + sc]); \
    _Pragma("unroll") for (int g_ = 0; g_ < NKG; ++g_) { const int gi_ = tid + 512 * g_; const int kr_ = gi_ / KG, kc_ = (gi_ % KG) * 8; \
      sr_[i].ks[g_] = *reinterpret_cast<const bf16x8*>(&Kh[(long)((k0) + kr_) * LDK + kc_]); } } while (0)
#define SWRITE(b, i) do { *(bf16x8*)(V_lds + (b) * SHM_V + vst0) = sr_[i].vs0; *(bf16x8*)(V_lds + (b) * SHM_V + vst1) = sr_[i].vs1; \
    _Pragma("unroll") for (int g_ = 0; g_ < NKG; ++g_) { const int gi_ = tid + 512 * g_; const int kr_ = gi_ / KG, kc_ = (gi_ % KG) * 16; \
      *(bf16x8*)(K_lds + (b) * SHM_K + kr_ * (DK * 2) + (kc_ ^ ((kr_ & 7) << 4))) = sr_[i].ks[g_]; } } while (0)
#define SWAIT() do { if constexpr (SD == 2) { if constexpr (NKG == 1) asm volatile("s_waitcnt vmcnt(3)" ::: "memory"); else asm volatile("s_waitcnt vmcnt(5)" ::: "memory"); } \
    else asm volatile("s_waitcnt vmcnt(0)" ::: "memory"); } while (0)
#define RESC(a) do { if (__any((a) < 1.f)) { if (hi == 0) al_l[r32] = (a); asm volatile("s_waitcnt lgkmcnt(0)" ::: "memory"); \
    _Pragma("unroll") for (int d = 0; d < 4; ++d) _Pragma("unroll") for (int r = 0; r < 16; ++r) o[d][r] *= al_l[crow(r, hi)]; } } while (0)
  f32x16 pA0, pA1, pB0, pB1; float mnA, mnB, alA, alB; bf16x8 pa0, pa1, pa2, pa3; const int NT = seq / 64;
  constexpr int SE = 0, SO = SD - 1;
  SLOAD(SE, 0); asm volatile("s_waitcnt vmcnt(0)" ::: "memory"); SWRITE(0, SE); __syncthreads();
  qkt<DK>(pA0, pA1, K_lds, qr, r32, hi); partialSM<DK>(pA0, pA1, m_reg, mnA, alA);
  SLOAD(SO, 64); if constexpr (SD == 2) { if (2 < NT) SLOAD(SE, 2 * 64); }
  SWAIT(); SWRITE(1, SO); __syncthreads();
  for (int j = 1; j + 1 < NT; j += 2) {
    SBAR(); qkt<DK>(pB0, pB1, K_lds + SHM_K, qr, r32, hi);
    finishSM(pA0, pA1, alA, l_reg, pa0, pa1, pa2, pa3); SBAR();
    SLOAD(SO, (j + SD) * 64); SBAR();
    pv_d0(o, vb0, pa0, pa1, pa2, pa3); partialSM<DK>(pB0, pB1, m_reg, mnB, alB);
    __syncthreads(); SWAIT(); SWRITE(0, SE);
    RESC(alB); __syncthreads();
    SBAR(); qkt<DK>(pA0, pA1, K_lds, qr, r32, hi);
    finishSM(pB0, pB1, alB, l_reg, pa0, pa1, pa2, pa3); SBAR();
    if (SD == 1 || j + 3 < NT) SLOAD(SE, (j + 1 + SD) * 64); SBAR();
    pv_d0(o, vb0 + SHM_V, pa0, pa1, pa2, pa3); partialSM<DK>(pA0, pA1, m_reg, mnA, alA);
    __syncthreads(); SWAIT(); SWRITE(1, SO);
    RESC(alA); __syncthreads();
  }
  SBAR(); qkt<DK>(pB0, pB1, K_lds + SHM_K, qr, r32, hi);
  finishSM(pA0, pA1, alA, l_reg, pa0, pa1, pa2, pa3); SBAR();
  pv_d0(o, vb0, pa0, pa1, pa2, pa3); partialSM<DK>(pB0, pB1, m_reg, mnB, alB);
  __syncthreads(); RESC(alB);
  finishSM(pB0, pB1, alB, l_reg, pa0, pa1, pa2, pa3); SBAR();
  pv_d0(o, vb0 + SHM_V, pa0, pa1, pa2, pa3);
  if (hi == 0) li_l[r32] = l_reg; asm volatile("s_waitcnt lgkmcnt(0)" ::: "memory");
  float rli[16];
#pragma unroll
  for (int r = 0; r < 16; ++r) rli[r] = __builtin_amdgcn_rcpf(li_l[crow(r, hi)]);
  TO* Ow = Ob + (long)(wid * 32) * LDO;
#pragma unroll
  for (int r = 0; r < 16; ++r) { const int orow = crow(r, hi);
#pragma unroll
    for (int d0 = 0; d0 < 4; ++d0) ostore(&Ow[(long)orow * LDO + d0 * 32 + r32], o[d0][r] * rli[r]); }
#undef SLOAD
#undef SWRITE
#undef SWAIT
#undef RESC
}

template <int DK, int LDQ, int LDK, int LDV, int LDO, typename TO>
__device__ __forceinline__ void attn_body_simple(const u16* __restrict__ Qb, const u16* __restrict__ Kh, const u16* __restrict__ Vh,
                                                 TO* __restrict__ Ob, int seq, char* lds) {
  const int TIDX = opaque_tid();
  constexpr int SHM_V = AC<DK>::SHM_V, SHM_K = AC<DK>::SHM_K, NKG = AC<DK>::NKG, KG = DK / 8;
  const int tid = TIDX, wid = tid >> 6, lane = tid & 63, r32 = lane & 31, hi = lane >> 5;
  char* V_lds = lds; char* K_lds = lds + 2 * SHM_V;
  float* wsl = (float*)(lds + 2 * SHM_V + 2 * SHM_K) + wid * 64; float* li_l = wsl; float* al_l = wsl + 32;
  float m_reg = -1e30f, l_reg = 0; f32x16 o[4] = {}; bf16x8 qr[DK / 16];
  const u16* Qw = Qb + (long)(wid * 32 + r32) * LDQ + hi * 8;
#pragma unroll
  for (int d0 = 0; d0 < DK / 16; ++d0) qr[d0] = *reinterpret_cast<const bf16x8*>(Qw + d0 * 16);
  const int sr = tid >> 4, sc = (tid & 15) * 8, vst0 = v_st(sr, sc), vst1 = v_st(32 + sr, sc);
  const int vb0 = (int)(uintptr_t)V_lds + v_rd_base(lane);
  bf16x8 vs0, vs1, ks[NKG];
#define SLOAD(k0) do { vs0 = *reinterpret_cast<const bf16x8*>(&Vh[(long)((k0) + sr) * LDV + sc]); \
    vs1 = *reinterpret_cast<const bf16x8*>(&Vh[(long)((k0) + 32 + sr) * LDV + sc]); \
    _Pragma("unroll") for (int g_ = 0; g_ < NKG; ++g_) { const int gi_ = tid + 512 * g_; const int kr_ = gi_ / KG, kc_ = (gi_ % KG) * 8; \
      ks[g_] = *reinterpret_cast<const bf16x8*>(&Kh[(long)((k0) + kr_) * LDK + kc_]); } } while (0)
#define SWRITE(b) do { *(bf16x8*)(V_lds + (b) * SHM_V + vst0) = vs0; *(bf16x8*)(V_lds + (b) * SHM_V + vst1) = vs1; \
    _Pragma("unroll") for (int g_ = 0; g_ < NKG; ++g_) { const int gi_ = tid + 512 * g_; const int kr_ = gi_ / KG, kc_ = (gi_ % KG) * 16; \
      *(bf16x8*)(K_lds + (b) * SHM_K + kr_ * (DK * 2) + (kc_ ^ ((kr_ & 7) << 4))) = ks[g_]; } } while (0)
  const int NT = seq / 64;
  SLOAD(0); SWRITE(0); __syncthreads();
#pragma unroll 1
  for (int j = 0; j < NT; ++j) {
    const int cur = j & 1;
    if (j + 1 < NT) SLOAD((j + 1) * 64);
    f32x16 p0, p1; float mn, al; bf16x8 pa0, pa1, pa2, pa3;
    qkt<DK>(p0, p1, K_lds + cur * SHM_K, qr, r32, hi);
    partialSM<DK>(p0, p1, m_reg, mn, al);
    if (__any(al < 1.f)) { if (hi == 0) al_l[r32] = al; asm volatile("s_waitcnt lgkmcnt(0)" ::: "memory");
#pragma unroll
      for (int d = 0; d < 4; ++d)
#pragma unroll
        for (int r = 0; r < 16; ++r) o[d][r] *= al_l[crow(r, hi)]; }
    finishSM(p0, p1, al, l_reg, pa0, pa1, pa2, pa3); SBAR();
    pv_d0(o, vb0 + cur * SHM_V, pa0, pa1, pa2, pa3);
    if (j + 1 < NT) SWRITE(cur ^ 1);
    __syncthreads();
  }
  if (hi == 0) li_l[r32] = l_reg; asm volatile("s_waitcnt lgkmcnt(0)" ::: "memory");
  float rli[16];
#pragma unroll
  for (int r = 0; r < 16; ++r) rli[r] = __builtin_amdgcn_rcpf(li_l[crow(r, hi)]);
  TO* Ow = Ob + (long)(wid * 32) * LDO;
#pragma unroll
  for (int r = 0; r < 16; ++r) { const int orow = crow(r, hi);
#pragma unroll
    for (int d0 = 0; d0 < 4; ++d0) ostore(&Ow[(long)orow * LDO + d0 * 32 + r32], o[d0][r] * rli[r]); }
#undef SLOAD
#undef SWRITE
}

__device__ __forceinline__ void rwkv_item(const P& p, int l, int item, char* lds) {
  const int TIDX = opaque_tid();
  char* ws = p.ws;
  const int d = item & 1, b = (item >> 1) & 3, h = item >> 3;
  constexpr int CM = 16, REC = 584, BUF = CM * REC, NCH = S / (2 * CM), OFF_SC = 448, OFF_D = 456;
  float* buf0 = (float*)lds; float* buf1 = buf0 + BUF; float* yout = buf1 + BUF;
  const int tid = TIDX, wid = tid >> 6, lane = tid & 63;
  const bool consumer = wid < 4;
  const u16* RR = (const u16*)(ws + RW_R); const u16* RK = (const u16*)(ws + RW_K); const u16* RV = (const u16*)(ws + RW_V); const u16* RKK = (const u16*)(ws + RW_KK);
  const u16* RA = (const u16*)(ws + RW_A) + (long)d * T * 512; const u16* RE = (const u16*)(ws + RW_E) + (long)d * T * 512;
  u16* YR = (u16*)(ws + OO_YR) + (long)d * T * 512;
  const int sg = wid & 3;
  struct PR { uint2 r[2], k[2], v[2], kk[2], a[2], e[2]; };
  const int pm = sg * 4 + (lane >> 4), pk0 = (lane & 15) * 4;
  const F4 ka4 = ld4f(p.in[I_KA] + l * 512 + h * 64 + pk0);
  auto pload = [&](int c) {
    PR x;
#pragma unroll
    for (int q = 0; q < 2; ++q) {
      const int sidx = c * (2 * CM) + pm * 2 + q, t = d ? (S - 1 - sidx) : sidx;
      const long off = ((long)(b * S + t)) * 512 + h * 64 + pk0;
      x.r[q] = *reinterpret_cast<const uint2*>(RR + off); x.k[q] = *reinterpret_cast<const uint2*>(RK + off); x.v[q] = *reinterpret_cast<const uint2*>(RV + off);
      x.kk[q] = *reinterpret_cast<const uint2*>(RKK + off); x.a[q] = *reinterpret_cast<const uint2*>(RA + off); x.e[q] = *reinterpret_cast<const uint2*>(RE + off);
    }
    return x;
  };
  auto unp = [](const uint2& u, int j) { const unsigned w = (j < 2) ? u.x : u.y; return (j & 1) ? __uint_as_float(w & 0xffff0000u) : __uint_as_float(w << 16); };
  auto pfinish = [&](const PR& x, float* buf) {
    float* rec = buf + pm * REC;
    f32x4 ww, bw, kw, b2v, k2v, v1v, v2v; float d1[4], d2[4], d3[4], d4[4];
    float c1 = 0.f, c2 = 0.f, c3 = 0.f, c4 = 0.f, c5 = 0.f, c6 = 0.f, c7 = 0.f, c8 = 0.f;
#pragma unroll
    for (int j = 0; j < 4; ++j) {
      const float r1 = unp(x.r[0], j), k1r = unp(x.k[0], j), v1 = unp(x.v[0], j), kk1 = unp(x.kk[0], j), a1 = unp(x.a[0], j), e1 = unp(x.e[0], j);
      const float r2 = unp(x.r[1], j), k2r = unp(x.k[1], j), v2 = unp(x.v[1], j), kk2 = unp(x.kk[1], j), a2 = unp(x.a[1], j), e2 = unp(x.e[1], j);
      const float w1 = __expf(-e1), w2 = __expf(-e2);
      const float z1 = -kk1, z2 = -kk2, b1 = kk1 * a1, b2 = kk2 * a2;
      const float k1 = k1r * (1.f + (a1 - 1.f) * ka4.v[j]), k2 = k2r * (1.f + (a2 - 1.f) * ka4.v[j]);
      const float w2r2 = w2 * r2;
      ww[j] = w1 * w2; bw[j] = b1 * w2; kw[j] = k1 * w2; b2v[j] = b2; k2v[j] = k2; v1v[j] = v1; v2v[j] = v2;
      d1[j] = z1; d2[j] = w1 * z2; d3[j] = w1 * r1; d4[j] = w1 * w2r2;
      c1 += b1 * z2; c2 += k1 * z2; c3 += b1 * r1; c4 += k1 * r1; c5 += b1 * w2r2; c6 += k1 * w2r2; c7 += b2 * r2; c8 += k2 * r2;
    }
    *reinterpret_cast<f32x4*>(rec + pk0) = ww;        *reinterpret_cast<f32x4*>(rec + 64 + pk0) = bw;   *reinterpret_cast<f32x4*>(rec + 128 + pk0) = kw;
    *reinterpret_cast<f32x4*>(rec + 192 + pk0) = b2v; *reinterpret_cast<f32x4*>(rec + 256 + pk0) = k2v;
    *reinterpret_cast<f32x4*>(rec + 320 + pk0) = v1v; *reinterpret_cast<f32x4*>(rec + 384 + pk0) = v2v;
    { uint2 q;
      q.x = cvtpk(d1[0], d1[1]); q.y = cvtpk(d1[2], d1[3]); *reinterpret_cast<uint2*>(rec + OFF_D + 0 * 32 + (lane & 15) * 2) = q;
      q.x = cvtpk(d2[0], d2[1]); q.y = cvtpk(d2[2], d2[3]); *reinterpret_cast<uint2*>(rec + OFF_D + 1 * 32 + (lane & 15) * 2) = q;
      q.x = cvtpk(d3[0], d3[1]); q.y = cvtpk(d3[2], d3[3]); *reinterpret_cast<uint2*>(rec + OFF_D + 2 * 32 + (lane & 15) * 2) = q;
      q.x = cvtpk(d4[0], d4[1]); q.y = cvtpk(d4[2], d4[3]); *reinterpret_cast<uint2*>(rec + OFF_D + 3 * 32 + (lane & 15) * 2) = q; }
    c1 = grp16sum(c1); c2 = grp16sum(c2); c3 = grp16sum(c3); c4 = grp16sum(c4); c5 = grp16sum(c5); c6 = grp16sum(c6); c7 = grp16sum(c7); c8 = grp16sum(c8);
    if ((lane & 15) == 0) { *reinterpret_cast<f32x4*>(rec + OFF_SC) = f32x4{c1, c2, c3, c4}; *reinterpret_cast<f32x4*>(rec + OFF_SC + 4) = f32x4{c5, c6, c7, c8}; }
  };
  auto store_y = [&](int c) {
    const float* yo = yout + (c & 1) * (32 * 64);
#pragma unroll
    for (int i = 0; i < 8; ++i) {
      const int s = sg + 4 * i, sidx = c * 32 + s, t = d ? (S - 1 - sidx) : sidx;
      YR[((long)(b * S + t)) * 512 + h * 64 + lane] = f2bf(yo[s * 64 + lane]);
    }
  };
  const int j16 = lane & 15, g = lane >> 4, row = (wid & 3) * 16 + j16;
  const int aoff = OFF_D + (j16 & 3) * 32;
  f2 st[8];
#pragma unroll
  for (int i = 0; i < 8; ++i) st[i] = f2{0.f, 0.f};
  struct Ops { bf16x8 a0, a1; f2 v; f32x4 s0, s1; };
  auto ldops = [&](const float* rec) {
    Ops o;
    o.a0 = *reinterpret_cast<const bf16x8*>(rec + aoff + g * 4);
    o.a1 = *reinterpret_cast<const bf16x8*>(rec + aoff + 16 + g * 4);
    o.v = f2{rec[320 + row], rec[384 + row]};
    o.s0 = *reinterpret_cast<const f32x4*>(rec + OFF_SC); o.s1 = *reinterpret_cast<const f32x4*>(rec + OFF_SC + 4);
    return o;
  };
  PR pnx;
  if (!consumer) { PR p0 = pload(0); pfinish(p0, buf0); pnx = pload(1); }
  __syncthreads();
  for (int c = 0; c < NCH; ++c) {
    float* buf = (c & 1) ? buf1 : buf0;
    if (consumer) {
      float* yo = yout + (c & 1) * (32 * 64);
      auto step = [&](const Ops& cur, int ms) {
        const float* rec = buf + ms * REC;
        f32x4 ww[4], bw[4], kw[4], b2[4], k2[4];
#pragma unroll
        for (int m = 0; m < 2; ++m)
#pragma unroll
          for (int hq = 0; hq < 2; ++hq) {
            const int o = m * 32 + g * 8 + hq * 4;
            ww[m * 2 + hq] = *reinterpret_cast<const f32x4*>(rec + o);        bw[m * 2 + hq] = *reinterpret_cast<const f32x4*>(rec + 64 + o);
            kw[m * 2 + hq] = *reinterpret_cast<const f32x4*>(rec + 128 + o);  b2[m * 2 + hq] = *reinterpret_cast<const f32x4*>(rec + 192 + o);
            k2[m * 2 + hq] = *reinterpret_cast<const f32x4*>(rec + 256 + o);
          }
        u32x4 q0, q1;
        q0[0] = cvtpk(st[0][0], st[0][1]); q0[1] = cvtpk(st[1][0], st[1][1]); q0[2] = cvtpk(st[2][0], st[2][1]); q0[3] = cvtpk(st[3][0], st[3][1]);
        q1[0] = cvtpk(st[4][0], st[4][1]); q1[1] = cvtpk(st[5][0], st[5][1]); q1[2] = cvtpk(st[6][0], st[6][1]); q1[3] = cvtpk(st[7][0], st[7][1]);
        f32x4 dd = f32x4{0.f, 0.f, 0.f, 0.f};
        dd = __builtin_amdgcn_mfma_f32_16x16x32_bf16(cur.a0, __builtin_bit_cast(bf16x8, q0), dd, 0, 0, 0);
        dd = __builtin_amdgcn_mfma_f32_16x16x32_bf16(cur.a1, __builtin_bit_cast(bf16x8, q1), dd, 0, 0, 0);
        const float v1 = cur.v[0], v2 = cur.v[1];
        const float sa1 = dd[0];
        const float sa2 = dd[1] + sa1 * cur.s0[0] + v1 * cur.s0[1];
        const float y1 = dd[2] + sa1 * cur.s0[2] + v1 * cur.s0[3];
        const float y2 = dd[3] + sa1 * cur.s1[0] + v1 * cur.s1[1] + sa2 * cur.s1[2] + v2 * cur.s1[3];
        const f2 sa1v = f2{sa1, sa1}, v1v = f2{v1, v1}, sa2v = f2{sa2, sa2}, v2v = f2{v2, v2};
#pragma unroll
        for (int q = 0; q < 4; ++q) {
#pragma unroll
          for (int hh = 0; hh < 2; ++hh) {
            const f2 w_ = f2{ww[q][2 * hh], ww[q][2 * hh + 1]}, bw_ = f2{bw[q][2 * hh], bw[q][2 * hh + 1]}, kw_ = f2{kw[q][2 * hh], kw[q][2 * hh + 1]};
            const f2 b2_ = f2{b2[q][2 * hh], b2[q][2 * hh + 1]}, k2_ = f2{k2[q][2 * hh], k2[q][2 * hh + 1]};
            st[q * 2 + hh] = st[q * 2 + hh] * w_ + ((sa1v * bw_ + v1v * kw_) + (sa2v * b2_ + v2v * k2_));
          }
        }
        if (g == 0) { yo[(2 * ms) * 64 + row] = y1; yo[(2 * ms + 1) * 64 + row] = y2; }
      };
      Ops oa = ldops(buf);
#pragma unroll 1
      for (int ms = 0; ms < CM; ms += 2) {
        const Ops ob = ldops(buf + (ms + 1) * REC);
        step(oa, ms);
        if (ms + 2 < CM) oa = ldops(buf + (ms + 2) * REC);
        step(ob, ms + 1);
      }
    } else {
      if (c + 1 < NCH) { pfinish(pnx, (c & 1) ? buf0 : buf1); if (c + 2 < NCH) pnx = pload(c + 2); }
      if (c >= 1) store_y(c - 1);
    }
    __syncthreads();
  }
  if (!consumer) store_y(NCH - 1);
  __syncthreads();
}

__device__ __forceinline__ bf16x8 pad8(s16x4 v) { return bf16x8{v[0], v[1], v[2], v[3], 0, 0, 0, 0}; }
__device__ __forceinline__ void cmul(float ar, float ai, float br, float bi, float& cr, float& ci) { cr = ar * br - ai * bi; ci = ar * bi + ai * br; }
__device__ __forceinline__ void s5_item(const P& p, int l, int item, char* lds) {
  const int TIDX = opaque_tid();
  char* ws = p.ws;
  const int d = item & 1, g = (item >> 1) & 31, b = item >> 6;
  const int tid = TIDX, wv = tid >> 6, lane = tid & 63, jj = lane & 15, gq = lane >> 4;
  const long pg = ((long)(l * 2 + d) * 32 + g);
  const float* lre = p.in[I_LRE] + pg * 64; const float* lim = p.in[I_LIM] + pg * 64;
  const float dt = __expf(p.in[I_LDT][pg]);
  const float* bre = p.in[I_BRE] + pg * 64 * 16; const float* bim = p.in[I_BIM] + pg * 64 * 16;
  const float* cre = p.in[I_CRE] + pg * 16 * 64; const float* cim = p.in[I_CIM] + pg * 16 * 64;
  const u16* PB = (const u16*)(ws + O_P);
  u16* YS = (u16*)(ws + OO_YS) + (long)d * T * 512;
  float ar[16], ai[16];
  s16x4 Bop[8], Cop[8];
#pragma unroll
  for (int tl = 0; tl < 8; ++tl) {
#pragma unroll
    for (int e = 0; e < 2; ++e) {
      const int stt = tl * 8 + gq * 2 + e;
      const float lr = fminf(lre[stt], -1e-4f), li = lim[stt];
      const float mag = __expf(lr * dt); float sn, cs; sincos_rev(li * dt, sn, cs);
      ar[tl * 2 + e] = mag * cs; ai[tl * 2 + e] = mag * sn;
    }
    {
      const int i = lane & 15; const int stt = tl * 8 + (i >> 2) * 2 + (i & 1), part = (i >> 1) & 1;
      const float lr = fminf(lre[stt], -1e-4f), li = lim[stt];
      const float mag = __expf(lr * dt); float sn, cs; sincos_rev(li * dt, sn, cs);
      const float abr = mag * cs, abi = mag * sn, den = lr * lr + li * li;
      const float cor = ((abr - 1.f) * lr + abi * li) / den, coi = (abi * lr - (abr - 1.f) * li) / den;
      float vals[4];
#pragma unroll
      for (int c = 0; c < 4; ++c) {
        const float br_ = bre[stt * 16 + gq * 4 + c], bi_ = bim[stt * 16 + gq * 4 + c];
        vals[c] = part ? (cor * bi_ + coi * br_) : (cor * br_ - coi * bi_);
      }
      Bop[tl] = s16x4{(short)f2bf(vals[0]), (short)f2bf(vals[1]), (short)f2bf(vals[2]), (short)f2bf(vals[3])};
      float cv[4];
#pragma unroll
      for (int j = 0; j < 4; ++j) {
        const int st2 = tl * 8 + gq * 2 + (j & 1);
        cv[j] = (j >> 1) ? -cim[i * 64 + st2] : cre[i * 64 + st2];
      }
      Cop[tl] = s16x4{(short)f2bf(cv[0]), (short)f2bf(cv[1]), (short)f2bf(cv[2]), (short)f2bf(cv[3])};
    }
  }
  int bad_ = 9999;
#define UPD(v, code, th) do { if (!(fabsf(v) < (th))) bad_ = min(bad_, (code)); } while (0)
#pragma unroll
  for (int k = 0; k < 16; ++k) { UPD(ar[k] * ar[k] + ai[k] * ai[k], 30, 1.0f); }
#pragma unroll
  for (int tl = 0; tl < 8; ++tl)
#pragma unroll
    for (int c = 0; c < 4; ++c) { UPD(bf2f((u16)Bop[tl][c]), 31, 2.f); UPD(bf2f((u16)Cop[tl][c]), 32, 2.f); }
  float* aval = (float*)lds + 1024 + 32 * 512;
  if (wv == 0 && jj == 0) {
#pragma unroll
    for (int tl = 0; tl < 8; ++tl)
#pragma unroll
      for (int e = 0; e < 2; ++e) { const int stt = tl * 8 + gq * 2 + e; aval[stt * 2] = ar[tl * 2 + e]; aval[stt * 2 + 1] = ai[tl * 2 + e]; }
  }
  const int chunk = wv * 16 + jj;
  const long pcol = C_S5U + g * 16 + gq * 4;
  f32x4 x[8];
#pragma unroll
  for (int tl = 0; tl < 8; ++tl) x[tl] = f32x4{0.f, 0.f, 0.f, 0.f};
  auto tok_of = [&](int stp) { const int sidx = chunk * 32 + stp; const int t = d ? (S - 1 - sidx) : sidx; return (long)(b * S + t); };
  auto step_state = [&](s16x4 uf) {
#pragma unroll
    for (int tl = 0; tl < 8; ++tl) {
      const float xr0 = x[tl][0], xr1 = x[tl][1], xi0 = x[tl][2], xi1 = x[tl][3];
      f32x4 nx;
      nx[0] = ar[tl * 2] * xr0 - ai[tl * 2] * xi0; nx[2] = ar[tl * 2] * xi0 + ai[tl * 2] * xr0;
      nx[1] = ar[tl * 2 + 1] * xr1 - ai[tl * 2 + 1] * xi1; nx[3] = ar[tl * 2 + 1] * xi1 + ai[tl * 2 + 1] * xr1;
      x[tl] = __builtin_amdgcn_mfma_f32_16x16x32_bf16(pad8(Bop[tl]), pad8(uf), nx, 0, 0, 0);
    }
  };
#pragma unroll 1
  for (int g8 = 0; g8 < 4; ++g8) {
    s16x4 uf[8];
#pragma unroll
    for (int i = 0; i < 8; ++i) uf[i] = *reinterpret_cast<const s16x4*>(PB + tok_of(g8 * 8 + i) * NP + pcol);
#pragma unroll
    for (int i = 0; i < 8; ++i) { step_state(uf[i]);
#pragma unroll
      for (int c = 0; c < 4; ++c) UPD(bf2f((u16)uf[i][c]), 33, 20.f); }
  }
#pragma unroll
  for (int tl = 0; tl < 8; ++tl)
#pragma unroll
    for (int r = 0; r < 4; ++r) UPD(x[tl][r], 34, 50.f);
  __syncthreads();
  float* tot = (float*)lds;
  float* xs = (float*)lds + 1024;
#pragma unroll
  for (int tl = 0; tl < 8; ++tl)
#pragma unroll
    for (int r = 0; r < 4; ++r) xs[(tl * 4 + r) * 512 + tid] = x[tl][r];
#pragma unroll 1
  for (int tl = 0; tl < 8; ++tl) {
#pragma unroll
    for (int e = 0; e < 2; ++e) {
      const int stt = tl * 8 + gq * 2 + e;
      float pr_ = aval[stt * 2], pi_ = aval[stt * 2 + 1];
#pragma unroll
      for (int sq = 0; sq < 5; ++sq) { float nr, ni; cmul(pr_, pi_, pr_, pi_, nr, ni); pr_ = nr; pi_ = ni; }
      float xr = xs[(tl * 4 + e) * 512 + tid], xi = xs[(tl * 4 + 2 + e) * 512 + tid];
#pragma unroll
      for (int stg = 0; stg < 4; ++stg) {
        const int off = 1 << stg;
        const float or_ = __shfl_up(xr, off, 16), oi_ = __shfl_up(xi, off, 16);
        if (jj >= off) { float cr, ci; cmul(pr_, pi_, or_, oi_, cr, ci); xr += cr; xi += ci; }
        float nr, ni; cmul(pr_, pi_, pr_, pi_, nr, ni); pr_ = nr; pi_ = ni;
      }
      xs[(tl * 4 + e) * 512 + tid] = xr; xs[(tl * 4 + 2 + e) * 512 + tid] = xi;
      if (jj == 15) { float* tp = tot + (wv * 4 + gq) * 32 + tl * 4; tp[e] = xr; tp[2 + e] = xi; }
      UPD(xr, 35, 200.f); UPD(xi, 35, 200.f);
    }
  }
  __syncthreads();
#pragma unroll 1
  for (int tl = 0; tl < 8; ++tl) {
#pragma unroll
    for (int e = 0; e < 2; ++e) {
      const int stt = tl * 8 + gq * 2 + e;
      float pr_ = aval[stt * 2], pi_ = aval[stt * 2 + 1];
#pragma unroll
      for (int sq = 0; sq < 5; ++sq) { float nr, ni; cmul(pr_, pi_, pr_, pi_, nr, ni); pr_ = nr; pi_ = ni; }
      float qr_ = 1.f, qi_ = 0.f;
#pragma unroll
      for (int stg = 0; stg < 4; ++stg) {
        if (jj & (1 << stg)) { float cr, ci; cmul(qr_, qi_, pr_, pi_, cr, ci); qr_ = cr; qi_ = ci; }
        float nr, ni; cmul(pr_, pi_, pr_, pi_, nr, ni); pr_ = nr; pi_ = ni;
      }
      float Wr = 0.f, Wi = 0.f;
      for (int w2 = 0; w2 < wv; ++w2) {
        const float* tp = tot + (w2 * 4 + gq) * 32 + tl * 4;
        float cr, ci; cmul(pr_, pi_, Wr, Wi, cr, ci); Wr = cr + tp[e]; Wi = ci + tp[2 + e];
      }
      const float xr = xs[(tl * 4 + e) * 512 + tid], xi = xs[(tl * 4 + 2 + e) * 512 + tid];
      float er = __shfl_up(xr, 1, 16), ei = __shfl_up(xi, 1, 16);
      if (jj == 0) { er = 0.f; ei = 0.f; }
      float cr, ci; cmul(qr_, qi_, Wr, Wi, cr, ci);
      UPD(Wr, 36, 500.f); UPD(Wi, 36, 500.f); UPD(er + cr, 37, 500.f); UPD(ei + ci, 37, 500.f);
      xs[(tl * 4 + e) * 512 + tid] = er + cr; xs[(tl * 4 + 2 + e) * 512 + tid] = ei + ci;
    }
  }
#pragma unroll
  for (int tl = 0; tl < 8; ++tl)
#pragma unroll
    for (int r = 0; r < 4; ++r) x[tl][r] = xs[(tl * 4 + r) * 512 + tid];
  __syncthreads();
#pragma unroll 1
  for (int g8 = 0; g8 < 4; ++g8) {
    s16x4 uf[8];
#pragma unroll
    for (int i = 0; i < 8; ++i) uf[i] = *reinterpret_cast<const s16x4*>(PB + tok_of(g8 * 8 + i) * NP + pcol);
#pragma unroll
    for (int i = 0; i < 8; ++i) {
      step_state(uf[i]);
      f32x4 y = f32x4{0.f, 0.f, 0.f, 0.f};
#pragma unroll
      for (int tl = 0; tl < 8; ++tl) {
        const unsigned lo = cvtpk(x[tl][0], x[tl][1]), hi2 = cvtpk(x[tl][2], x[tl][3]);
        const s16x4 xb = s16x4{(short)(lo & 0xffffu), (short)(lo >> 16), (short)(hi2 & 0xffffu), (short)(hi2 >> 16)};
        y = __builtin_amdgcn_mfma_f32_16x16x32_bf16(pad8(Cop[tl]), pad8(xb), y, 0, 0, 0);
      }
#pragma unroll
      for (int tl = 0; tl < 8; ++tl) { UPD(x[tl][0], 38, 500.f); UPD(x[tl][1], 38, 500.f); UPD(x[tl][2], 38, 500.f); UPD(x[tl][3], 38, 500.f); }
      UPD(y[0], 39, 100.f); UPD(y[1], 39, 100.f); UPD(y[2], 39, 100.f); UPD(y[3], 39, 100.f);
      uint2 oo; oo.x = cvtpk(y[0], y[1]); oo.y = cvtpk(y[2], y[3]);
      *reinterpret_cast<uint2*>(YS + tok_of(g8 * 8 + i) * 512 + g * 16 + gq * 4) = oo;
    }
  }
  if (l == 0 && bad_ < 9999) atomicMin((int*)(ws + O_FLAG), bad_);
  __syncthreads();
}

__device__ __forceinline__ void phase5(const P& p, int l, int coff, int tmask = 15) {
  const int TIDX = opaque_tid();
  const int BIDX = opaque_bid();
  char* ws = p.ws;
  __shared__ int s_item;
  int* ctr = (int*)(ws + O_CTR) + l + coff;
  constexpr int N_RW = 64, N_S5 = 256, N_MLA = 256, N_DIFF = 512, N_ALL = N_RW + N_S5 + N_MLA + N_DIFF;
  for (;;) {
    __syncthreads();
    if (TIDX == 0) s_item = atomicAdd(ctr, 1);
    __syncthreads();
    int it = s_item;
    if (it >= N_ALL) break;
    if (it < N_RW) { if (tmask & 1) rwkv_item(p, l, it, smem); continue; }
    it -= N_RW;
    if (it < N_MLA) {
      const int qb = it & 15, hh = (it >> 4) & 3, b = it >> 6;
      const long bh = (long)(b * 4 + hh);
      if (tmask & 4) attn_body_simple<192, 192, 192, 128, 512, u16>((const u16*)(ws + QK_MQ) + (bh * S + qb * 256) * 192, (const u16*)(ws + QK_MK) + bh * S * 192,
                                                 (const u16*)(ws + QK_MV) + bh * S * 128, (u16*)(ws + OO_MO) + ((long)(b * S + qb * 256)) * 512 + hh * 128, S, smem);
      continue;
    }
    it -= N_MLA;
    if (it < N_DIFF) {
      const int qb = it & 15, h2 = (it >> 4) & 7, b = it >> 7;
      const long bh = (long)(b * 8 + h2);
      if (tmask & 8) attn_body<64, 2, 64, 64, NP, 1024, u16>((const u16*)(ws + QK_DQ) + (bh * S + qb * 256) * 64, (const u16*)(ws + QK_DK) + bh * S * 64,
                                                (const u16*)(ws + O_P) + (long)b * S * NP + C_DV + (h2 >> 1) * 128,
                                                (u16*)(ws + OO_DO) + ((long)(b * S + qb * 256)) * 1024 + h2 * 128, S, smem);
      continue;
    }
    it -= N_DIFF;
    if (tmask & 2) s5_item(p, l, it, smem);
  }
}

__device__ __forceinline__ void phase6(const P& p, int l) {
  const int TIDX = opaque_tid();
  const int BIDX = opaque_bid();
  char* ws = p.ws;
  const u16* __restrict__ PB = (const u16*)(ws + O_P);
  const u16* __restrict__ YS0 = (const u16*)(ws + OO_YS); const u16* __restrict__ YS1 = YS0 + (long)T * 512;
  const u16* __restrict__ YR0 = (const u16*)(ws + OO_YR); const u16* __restrict__ YR1 = YR0 + (long)T * 512;
  const u16* __restrict__ DO_ = (const u16*)(ws + OO_DO); const u16* __restrict__ MO = (const u16*)(ws + OO_MO);
  const u16* __restrict__ RV = (const u16*)(ws + RW_V); const float* __restrict__ BON = (const float*)(ws + RW_BON);
  u16* __restrict__ BR = (u16*)(ws + O_BR); u16* __restrict__ GS5 = (u16*)(ws + O_GS5);
  const int wid = TIDX >> 6, lane = TIDX & 63, c0 = lane * 8;
  const float lam_init = 0.8f - 0.6f * expf(-0.3f * (float)l);
  const float* dl = p.in[I_DLAM] + l * 256;
  const float lam_full = expf(wsum(dl[lane] * dl[64 + lane])) - expf(wsum(dl[128 + lane] * dl[192 + lane])) + lam_init;
  const F8 dsk = ld8f(p.in[I_S5D] + l * 512 + c0);
  const F8 sub = ld8f(p.in[I_SUBLN] + l * 128 + (lane & 15) * 8);
  const F8 lng = ld8f(p.in[I_LNG] + l * 512 + c0), lnb = ld8f(p.in[I_LNB] + l * 512 + c0);
  const int hD = lane >> 4, eD = (lane & 15) * 8;
  for (int t = BIDX * 8 + wid; t < T; t += gridDim.x * 8) {
    const u16* pr = PB + (long)t * NP;
    u16* br = BR + (long)t * 2048;
    const F8 u = ld8bf(pr + C_S5U + c0), ys0 = ld8bf(YS0 + (long)t * 512 + c0), ys1 = ld8bf(YS1 + (long)t * 512 + c0);
    const F8 o1 = ld8bf(DO_ + (long)t * 1024 + (hD * 2) * 128 + eD), o2 = ld8bf(DO_ + (long)t * 1024 + (hD * 2 + 1) * 128 + eD);
    const F8 zd = ld8bf(pr + C_DZ + c0), zm = ld8bf(pr + C_MZ + c0), zr = ld8bf(pr + C_RZ + c0);
    const F8 mo = ld8bf(MO + (long)t * 512 + c0);
    const F8 y0 = ld8bf(YR0 + (long)t * 512 + c0), y1 = ld8bf(YR1 + (long)t * 512 + c0), rv = ld8bf(RV + (long)t * 512 + c0);
    const float bon = BON[(long)t * 8 + (lane >> 3)];
    {
      F8 g;
#pragma unroll
      for (int j = 0; j < 8; ++j) {
        const float y = dsk.v[j] * u.v[j] + ys0.v[j] + ys1.v[j];
        const float uu = 0.7978845608028654f * (y + 0.044715f * y * y * y);
        g.v[j] = y * sigmoidf_(2.f * uu);
      }
      st8bf(GS5 + (long)t * 512 + c0, g);
    }
    {
      F8 a; float ss = 0.f;
#pragma unroll
      for (int j = 0; j < 8; ++j) { a.v[j] = o1.v[j] - lam_full * o2.v[j]; ss += a.v[j] * a.v[j]; }
      ss = grp16sum(ss);
      const float sc = rsqrtf(ss * (1.f / 128.f) + 1e-6f) * (1.f - lam_init);
#pragma unroll
      for (int j = 0; j < 8; ++j) a.v[j] = siluf_(zd.v[j]) * a.v[j] * sc * sub.v[j];
      st8bf(br + 512 + c0, a);
    }
    {
      F8 a;
#pragma unroll
      for (int j = 0; j < 8; ++j) a.v[j] = siluf_(zm.v[j]) * mo.v[j];
      st8bf(br + 1024 + c0, a);
    }
    {
      F8 y; float sm = 0.f;
#pragma unroll
      for (int j = 0; j < 8; ++j) { y.v[j] = y0.v[j] + y1.v[j]; sm += y.v[j]; }
      const float mean = grp8sum(sm) * (1.f / 64.f);
      float sv = 0.f;
#pragma unroll
      for (int j = 0; j < 8; ++j) { y.v[j] -= mean; sv += y.v[j] * y.v[j]; }
      const float rs = rsqrtf(grp8sum(sv) * (1.f / 64.f) + 64e-5f);
#pragma unroll
      for (int j = 0; j < 8; ++j) { const float yn = y.v[j] * rs * lng.v[j] + lnb.v[j] + bon * rv.v[j]; y.v[j] = siluf_(zr.v[j]) * yn; }
      st8bf(br + 1536 + c0, y);
    }
  }
}

struct EpiGlu { u16* BR; const u16* GS5; const u16* PB; const float* gb; __device__ __forceinline__ void operator()(int row, int col, f32x4 v0, f32x4 v1) const {
  const f32x4 b0 = *reinterpret_cast<const f32x4*>(gb + col), b1 = *reinterpret_cast<const f32x4*>(gb + col + 4);
  const F8 g = ld8bf(GS5 + (long)row * 512 + col), z = ld8bf(PB + (long)row * NP + C_S5Z + col);
  F8 o;
#pragma unroll
  for (int j = 0; j < 4; ++j) { o.v[j] = siluf_(z.v[j]) * g.v[j] * sigmoidf_(v0[j] + b0[j]); o.v[4 + j] = siluf_(z.v[4 + j]) * g.v[4 + j] * sigmoidf_(v1[j] + b1[j]); }
  st8bf(BR + (long)row * 2048 + col, o); } };
__device__ __forceinline__ void phase7(const P& p, int l) {
  char* ws = p.ws;
  EpiGlu e{(u16*)(ws + O_BR), (const u16*)(ws + O_GS5), (const u16*)(ws + O_P), p.in[I_GLUB] + l * 512};
  fg::gemm_phase<EpiGlu, true>((LAS3 unsigned char*)smem, (const u16*)(ws + O_GS5), 512, (const u16*)(ws + O_GLU), 512, T, 512, 512, e);
}

constexpr size_t O_GATES = O_O;
__device__ __forceinline__ void phase8a(const P& p, int l) {
  char* ws = p.ws;
  EpiGate e{(u16*)(ws + O_GATES), p.in[I_GATEB] + (long)l * 4 * 1024};
  fg::gemm_phase<EpiGate, true>((LAS3 unsigned char*)smem, (const u16*)(ws + O_H), 1024, (const u16*)(ws + O_WIN) + (long)NP * 1024, 1024, T, 4096, 1024, e);
}
__device__ __forceinline__ void phase8(const P& p, int l) {
  const int TIDX = opaque_tid();
  const int BIDX = opaque_bid();
  char* ws = p.ws;
  const u16* BR = (const u16*)(ws + O_BR); u16* M = (u16*)(ws + O_M);
  const u16* WBR = (const u16*)(ws + O_WBR); const u16* GT = (const u16*)(ws + O_GATES);
  for (int ti = BIDX; ti < 8 * 64; ti += gridDim.x) {
    const int nt = ti & 7, mt = ti >> 3; const int m0 = mt * 256, n0 = nt * 128;
    f32x4 tot[4][4]; zero_acc<4>(tot);
#pragma unroll 1
    for (int nb = 0; nb < 4; ++nb) {
      f32x4 ap[4][4]; zero_acc<4>(ap);
      gemm_main<4>(BR + (long)m0 * 2048 + nb * 512, 2048, WBR + ((long)nb * 1024 + n0) * 512, 512, 512, ap, smem);
      EPI_LOOP(4, { tot[i][j][jj] += bf2f(GT[(long)m * 4096 + nb * 1024 + n]) * ap[i][j][jj]; });
    }
    EPI_LOOP(4, { M[(long)m * 1024 + n] = f2bf(tot[i][j][jj]); });
  }
}

__device__ __forceinline__ void phase9(const P& p, int l) {
  char* ws = p.ws;
  EpiOut e{p.out, (l == 0) ? p.in[I_X] : p.out};
  fg::gemm_phase((LAS3 unsigned char*)smem, (const u16*)(ws + O_M), 1024, (const u16*)(ws + O_WOUT), 1024, T, 1024, 1024, e);
}

#define XB_TMO      128
#define XB_XCNT(j)  (256  + 64 * (j))
#define XB_XSUB(j)  (1280 + 64 * (j))
#define XB_XGEN(j)  (2304 + 64 * (j))
#define XB_TOP      3328
#define XB_TOPGEN   3392
#define XB_SPIN_CAP (1u << 18)
__device__ __forceinline__ unsigned xb_ld(unsigned* p) { return __hip_atomic_load(p, __ATOMIC_RELAXED, __HIP_MEMORY_SCOPE_AGENT); }
__device__ __forceinline__ unsigned xb_add(unsigned* p, unsigned v) { return __hip_atomic_fetch_add(p, v, __ATOMIC_RELAXED, __HIP_MEMORY_SCOPE_AGENT); }
__device__ __forceinline__ unsigned xb_xcc_id() { return (unsigned)__builtin_amdgcn_s_getreg((3 << 11) | 20) & 0xFu; }
#define XB_SPIN(cond, bar) do { unsigned _sp = 0; while (cond) { __builtin_amdgcn_s_sleep(1); \
    if ((++_sp & 255u) == 0u) { if (xb_ld(&(bar)[XB_TMO])) break; if (_sp > XB_SPIN_CAP) { atomicAdd(&(bar)[XB_TMO], 1u); break; } } } } while (0)
struct XcdBarrier { unsigned* bar; unsigned x; volatile LAS3 unsigned* st; };
__device__ __forceinline__ XcdBarrier xcd_barrier_post(unsigned* bar, volatile LAS3 unsigned* st) {
  XcdBarrier b; b.bar = bar; b.x = xb_xcc_id(); b.st = st;
  if (threadIdx.x == 0) (void)xb_add(&bar[XB_XCNT(b.x)], 1u);
  return b;
}
__device__ __forceinline__ void xcd_barrier_complete(unsigned* bar, unsigned x, unsigned& nloc, unsigned& nx) {
  const unsigned G = gridDim.x * gridDim.y * gridDim.z;
  unsigned sum, cnt, mine, sp = 0u;
  for (;;) {
    sum = 0u; cnt = 0u; mine = 0u;
#pragma unroll
    for (unsigned j = 0; j < 16; ++j) { const unsigned c = xb_ld(&bar[XB_XCNT(j)]); sum += c; cnt += (c > 0u) ? 1u : 0u; mine = (j == x) ? c : mine; }
    if (sum == G) break;
    __builtin_amdgcn_s_sleep(1);
    if ((++sp & 255u) == 0u) { if (xb_ld(&bar[XB_TMO])) break; if (sp > XB_SPIN_CAP) { atomicAdd(&bar[XB_TMO], 1u); break; } }
  }
  nloc = mine > 0u ? mine : 1u; nx = cnt > 0u ? cnt : 1u;
}
__device__ __forceinline__ void xcd_barrier(const XcdBarrier& b) {
  asm volatile("s_waitcnt vmcnt(0)" ::: "memory");
  __syncthreads();
  if (threadIdx.x == 0) {
    unsigned* bar = b.bar;
    __builtin_amdgcn_s_waitcnt(0);
    unsigned nloc = b.st[0], nx = b.st[1];
    if (nloc == 0u) { xcd_barrier_complete(bar, b.x, nloc, nx); b.st[0] = nloc; b.st[1] = nx; }
    const unsigned old = xb_add(&bar[XB_XSUB(b.x)], 1u);
    const unsigned gen = old / nloc;
    if (old + 1u == (gen + 1u) * nloc) {
      __builtin_amdgcn_fence(__ATOMIC_RELEASE, "agent");
      asm volatile("s_waitcnt vmcnt(0)" ::: "memory");
      const unsigned og = xb_add(&bar[XB_TOP], 1u);
      const unsigned tg = og / nx;
      if (og + 1u == (tg + 1u) * nx) xb_add(&bar[XB_TOPGEN], 1u);
      else XB_SPIN(xb_ld(&bar[XB_TOPGEN]) == tg, bar);
      __builtin_amdgcn_fence(__ATOMIC_ACQUIRE, "agent");
      xb_add(&bar[XB_XGEN(b.x)], 1u);
      asm volatile("s_waitcnt vmcnt(0)" ::: "memory");
    } else {
      XB_SPIN(xb_ld(&bar[XB_XGEN(b.x)]) == gen, bar);
      __builtin_amdgcn_fence(__ATOMIC_ACQUIRE, "agent");
      asm volatile("s_waitcnt vmcnt(0)" ::: "memory");
    }
  }
  __syncthreads();
}

__device__ __forceinline__ void gsync_cg(cg::grid_group& grid) {
  asm volatile("s_waitcnt vmcnt(0) lgkmcnt(0)" ::: "memory");
  grid.sync();
  __builtin_amdgcn_fence(__ATOMIC_ACQUIRE, "agent");
  asm volatile("s_waitcnt vmcnt(0)" ::: "memory");
}
#define gsync(g_) xcd_barrier(xbar)
#ifdef DBG
template <typename TT> __device__ __forceinline__ bool badv(TT v);
template <> __device__ __forceinline__ bool badv<u16>(u16 v) { float f = bf2f(v); return !(fabsf(f) < 1e5f); }
template <> __device__ __forceinline__ bool badv<float>(float f) { return !(fabsf(f) < 1e5f); }
template <typename TT>
__device__ __forceinline__ void chk(const P& p, size_t off, size_t n, int code) {
  const TT* q = (const TT*)(p.ws + off);
  bool bad = false;
  const int TIDX = opaque_tid(); const int BIDX = opaque_bid();
  for (size_t i = (size_t)BIDX * 512 + TIDX; i < n; i += (size_t)gridDim.x * 512) bad |= badv<TT>(q[i]);
  if (bad) atomicMin((int*)(p.ws + O_FLAG), code);
}
__device__ __forceinline__ void chko(const P& p, int code) {
  bool bad = false;
  const int TIDX = opaque_tid(); const int BIDX = opaque_bid();
  for (size_t i = (size_t)BIDX * 512 + TIDX; i < (size_t)T * 1024; i += (size_t)gridDim.x * 512) bad |= badv<float>(p.out[i]);
  if (bad) atomicMin((int*)(p.ws + O_FLAG), code);
}
#define CHK(...) do { if (l == 0) { __VA_ARGS__ } } while (0)
#else
#define CHK(...) do {} while (0)
#endif
__global__ void __launch_bounds__(512) mega(P p) {
  cg::grid_group grid = cg::this_grid();
  __shared__ uint4 xb_words;
  if (threadIdx.x == 0) xb_words = make_uint4(0u, 0u, 0u, 0u);
  __syncthreads();
  XcdBarrier xbar = xcd_barrier_post((unsigned*)(p.ws + O_BAR), (volatile LAS3 unsigned*)&xb_words);
  gsync_cg(grid);
#ifdef DBG
  if (blockIdx.x == 0 && threadIdx.x == 0) *(int*)(p.ws + O_FLAG) = 9999;
#endif
  for (int l = 0; l < NL; ++l) {
#ifndef ONLY
#define ONLY -1
#endif
#ifndef REPMASK
#define REPMASK 0
#endif
#define RUNP(k, call) do { call; gsync(grid); if (REPMASK & (1 << (k))) { call; gsync(grid); } } while (0)
    RUNP(0, phase0(p, l));
    CHK(chk<u16>(p, O_H, (size_t)T * 1024, 10); chk<u16>(p, O_WIN, (size_t)NIN * 1024, 11););
    RUNP(1, phase1(p));
    RUNP(2, phase2(p, l));
    RUNP(3, phase3(p));
    RUNP(4, phase4(p, l));
    phase5(p, l, 0); gsync(grid);
#ifndef REP5MASK
#define REP5MASK 15
#endif
    if (REPMASK & (1 << 5)) { phase5(p, l, 4, REP5MASK); gsync(grid); }
    RUNP(6, phase6(p, l));
    RUNP(7, phase7(p, l); phase8a(p, l));
    RUNP(9, phase8(p, l));
    phase9(p, l); gsync(grid);
    if (REPMASK & (1 << 10)) { gsync(grid); gsync(grid); gsync(grid); gsync(grid); gsync(grid); }
#ifdef DBG
    if (l > 0) chko(p, 90 + l);
#endif
  }
#ifdef DBG
  gsync(grid);
  {
    const int flag = *(volatile int*)(p.ws + O_FLAG);
    if (flag < 9999) {
      const int TIDX = opaque_tid(); const int BIDX = opaque_bid();
      for (size_t i = (size_t)BIDX * 512 + TIDX; i < (size_t)T * 1024; i += (size_t)gridDim.x * 512)
        p.out[i] = (i == 0) ? (float)(flag * 10) : p.in[I_X][i];
    }
  }
#endif
}

extern "C" void kernel_launch(void* const* d_in, const int* in_sizes, int n_in,
                              void* d_out, int out_size, void* d_ws, size_t ws_size,
                              hipStream_t stream) {
  constexpr size_t kDynLds = 128 * 1024;
  static int grid_blocks = 0;
  if (!grid_blocks) {
    int dev = 0, cus = 0, per_cu = 0;
    (void)hipGetDevice(&dev);
    (void)hipDeviceGetAttribute(&cus, hipDeviceAttributeMultiprocessorCount, dev);
    (void)hipFuncSetAttribute((const void*)mega, hipFuncAttributeMaxDynamicSharedMemorySize, (int)kDynLds);
    (void)hipOccupancyMaxActiveBlocksPerMultiprocessor(&per_cu, mega, 512, kDynLds);
    if (per_cu < 1) per_cu = 1;
    if (per_cu > 1) per_cu = 1;
    grid_blocks = cus * per_cu;
  }
  if (n_in < 36 || ws_size < O_BAR + BAR_BYTES) { fprintf(stderr, "bad args: n_in %d ws %zu need %zu\n", n_in, ws_size, (size_t)O_END); return; }
  P p{};
  for (int i = 0; i < 36; ++i) p.in[i] = (const float*)d_in[i];
  p.out = (float*)d_out; p.ws = (char*)d_ws;
  (void)hipMemsetAsync((char*)d_ws + O_BAR, 0, BAR_BYTES, stream);
  void* args[] = {&p};
  hipError_t e = hipLaunchCooperativeKernel((void*)mega, dim3(grid_blocks), dim3(512), args, kDynLds, stream);
  if (e != hipSuccess) fprintf(stderr, "coop launch failed: %s\n", hipGetErrorString(e));
}
```
